# Optimizing an MI355X kernel written in HIP

```python
import math
import jax, jax.numpy as jnp
from jax import lax
import numpy as np

D_MODEL = 1024
BATCH = 8
SEQ = 2048
DEPTH = 1
DEC_BATCH = 128
DEC_SEQ = 8
PAST_LEN = 16384
PAGE_SIZE = 128

D_MIX = 2 * D_MODEL
SSD_WIDTH = D_MIX // 2
SSD_HEADDIM = 64
SSD_HEADS = SSD_WIDTH // SSD_HEADDIM
SSD_GROUPS = 2
SSD_STATE = 128
SSD_CONV_DIM = SSD_WIDTH + 2 * SSD_GROUPS * SSD_STATE
GDN_WIDTH = D_MIX - SSD_WIDTH
GDN_HEAD_DIM = 128
GDN_HEADS = GDN_WIDTH // GDN_HEAD_DIM
GDN_KEY_DIM = 128
GDN_QK_WIDTH = GDN_HEADS * GDN_KEY_DIM
GDN_CONV_DIM = 2 * GDN_QK_WIDTH + GDN_WIDTH
CONV_WIDTH = 4
CHUNK = 64
D_FF = -(-8 * D_MODEL // (3 * 256)) * 256
IN_SIZES = (SSD_WIDTH, SSD_CONV_DIM, SSD_HEADS, GDN_CONV_DIM, GDN_WIDTH, GDN_HEADS, GDN_HEADS)
IN_DIM = sum(IN_SIZES)
NORM_EPS = 1e-6
L2_EPS = 1e-6

kernel_name = "hymba_ssd_gdn_step"


def _rms_norm(x, w):
    xf = x.astype(jnp.float32)
    y = xf * lax.rsqrt(jnp.mean(xf * xf, axis=-1, keepdims=True) + NORM_EPS)
    return (y * w.astype(jnp.float32)).astype(x.dtype)


def _l2norm(x):
    xf = x.astype(jnp.float32)
    return xf * lax.rsqrt(jnp.sum(xf * xf, axis=-1, keepdims=True) + L2_EPS)


def _causal_dwconv(x, buf, w, b=None):
    xx = jnp.concatenate([buf.astype(x.dtype), x], axis=1)
    y = lax.conv_general_dilated(xx, w[:, None, :].astype(x.dtype), (1,), "VALID",
                                 dimension_numbers=("NWC", "WIO", "NWC"),
                                 feature_group_count=x.shape[-1])
    if b is not None:
        y = y + b.astype(y.dtype)
    return y, xx[:, xx.shape[1] - (CONV_WIDTH - 1):].astype(buf.dtype)


def _pad_time(a, pad):
    return jnp.pad(a, [(0, 0), (0, pad)] + [(0, 0)] * (a.ndim - 2))


def _ssd_chunked(x, dt, A, Bm, Cm, h0):
    b, L, H, P = x.shape
    G, N = Bm.shape[2], Bm.shape[3]
    R = H // G
    cs = min(CHUNK, L)
    nc = -(-L // cs)
    pad = nc * cs - L
    x, dt, Bm, Cm = (_pad_time(t, pad) for t in (x, dt, Bm, Cm))
    xc = x.reshape(b, nc, cs, G, R, P)
    dtc = dt.reshape(b, nc, cs, G, R)
    Bc = Bm.reshape(b, nc, cs, G, N)
    Cc = Cm.reshape(b, nc, cs, G, N)
    acs = jnp.cumsum(dtc * A.reshape(G, R), axis=2)
    xdt = xc * dtc[..., None]
    causal = jnp.tril(jnp.ones((cs, cs), bool))[:, :, None, None]
    seg = acs[:, :, :, None] - acs[:, :, None, :]
    decay_ls = jnp.exp(jnp.where(causal, seg, -jnp.inf))
    cb = jnp.einsum("bclgn,bcsgn->bclsg", Cc, Bc)
    y_diag = jnp.einsum("bclsgr,bcsgrp->bclgrp", cb[..., None] * decay_ls, xdt)
    decay_end = jnp.exp(acs[:, :, -1:] - acs)
    chunk_states = jnp.einsum("bclgn,bclgrp->bcgrpn", Bc, xdt * decay_end[..., None])
    chunk_decay = jnp.exp(acs[:, :, -1])

    def step(h, inp):
        st, dec = inp
        return h * dec[..., None, None] + st, h

    h_last, h_in = lax.scan(step, h0.reshape(b, G, R, P, N),
                            (jnp.moveaxis(chunk_states, 1, 0), jnp.moveaxis(chunk_decay, 1, 0)))
    h_in = jnp.moveaxis(h_in, 0, 1)
    y_off = jnp.einsum("bclgn,bcgrpn->bclgrp", Cc, h_in) * jnp.exp(acs)[..., None]
    y = (y_diag + y_off).reshape(b, nc * cs, H, P)[:, :L]
    return y, h_last.reshape(b, H, P, N)


def _gdn_chunked(q, k, v, g, beta, S0):
    b, L, H, Dk = q.shape
    cs = min(CHUNK, L)
    nc = -(-L // cs)
    pad = nc * cs - L
    q, k, v, g, beta = (_pad_time(t, pad) for t in (q, k, v, g, beta))

    def heads_first(t):
        return jnp.moveaxis(t.reshape((b, nc, cs) + t.shape[2:]), 3, 1)

    q, k, v, g, beta = (heads_first(t) for t in (q, k, v, g, beta))
    gc = jnp.cumsum(g, axis=-1)
    incl = jnp.tril(jnp.ones((cs, cs), bool))
    strict = jnp.tril(jnp.ones((cs, cs), bool), k=-1)
    decay = jnp.exp(jnp.where(incl, gc[..., :, None] - gc[..., None, :], -jnp.inf))
    kb = k * beta[..., None]
    lower = jnp.einsum("bhcld,bhcsd->bhcls", kb, k) * jnp.where(strict, decay, 0.0)
    tri = lower + jnp.eye(cs, dtype=lower.dtype)
    U = lax.linalg.triangular_solve(tri, v * beta[..., None], left_side=True, lower=True, unit_diagonal=True)
    W = lax.linalg.triangular_solve(tri, kb * jnp.exp(gc)[..., None], left_side=True, lower=True, unit_diagonal=True)
    attn = jnp.einsum("bhcld,bhcsd->bhcls", q, k) * decay
    q_in = q * jnp.exp(gc)[..., None]
    k_out = k * jnp.exp(gc[..., -1:] - gc)[..., None]
    g_end = jnp.exp(gc[..., -1])

    def step(S, inp):
        Uc, Wc, attn_c, q_c, k_c, ge = inp
        v_new = Uc - jnp.einsum("bhld,bhde->bhle", Wc, S)
        o = jnp.einsum("bhld,bhde->bhle", q_c, S) + jnp.einsum("bhls,bhse->bhle", attn_c, v_new)
        S = S * ge[..., None, None] + jnp.einsum("bhld,bhle->bhde", k_c, v_new)
        return S, o

    xs = tuple(jnp.moveaxis(t, 2, 0) for t in (U, W, attn, q_in, k_out, g_end))
    S_last, o = lax.scan(step, S0, xs)
    o = jnp.moveaxis(o, 0, 2).reshape(b, H, nc * cs, -1)
    o = jnp.moveaxis(o, 1, 2)[:, :L]
    return o, S_last


def _mixer(h, ssd_h0, ssd_conv_buf, gdn_S0, gdn_conv_buf, w_in, ssd_conv_w, ssd_conv_b, ssd_dt_bias,
           ssd_A_log, ssd_D, ssd_norm_w, gdn_conv_w, gdn_dt_bias, gdn_A_log, gdn_norm_w, w_out):
    f32 = jnp.float32
    b, L, _ = h.shape
    proj = h @ w_in
    z, xbc, dt_raw, qkv, gate, beta_raw, alpha_raw = jnp.split(proj, list(np.cumsum(IN_SIZES)[:-1]), axis=-1)
    xbc, ssd_conv_new = _causal_dwconv(xbc, ssd_conv_buf, ssd_conv_w, ssd_conv_b)
    xbc = jax.nn.silu(xbc.astype(f32))
    xs, Bm, Cm = jnp.split(xbc, [SSD_WIDTH, SSD_WIDTH + SSD_GROUPS * SSD_STATE], axis=-1)
    xs = xs.reshape(b, L, SSD_HEADS, SSD_HEADDIM)
    dt = jax.nn.softplus(dt_raw.astype(f32) + ssd_dt_bias.astype(f32))
    A = -jnp.exp(ssd_A_log.astype(f32))
    y, ssd_h = _ssd_chunked(xs, dt, A, Bm.reshape(b, L, SSD_GROUPS, SSD_STATE),
                            Cm.reshape(b, L, SSD_GROUPS, SSD_STATE), ssd_h0.astype(f32))
    y = y + ssd_D.astype(f32)[:, None] * xs
    gsz = SSD_WIDTH // SSD_GROUPS
    y = y.reshape(b, L, SSD_GROUPS, gsz) * jax.nn.silu(z.astype(f32)).reshape(b, L, SSD_GROUPS, gsz)
    y = _rms_norm(y, ssd_norm_w.reshape(SSD_GROUPS, gsz)).reshape(b, L, SSD_WIDTH)
    qkv, gdn_conv_new = _causal_dwconv(qkv, gdn_conv_buf, gdn_conv_w)
    qkv = jax.nn.silu(qkv.astype(f32))
    q, k, v = jnp.split(qkv, [GDN_QK_WIDTH, 2 * GDN_QK_WIDTH], axis=-1)
    q = _l2norm(q.reshape(b, L, GDN_HEADS, GDN_KEY_DIM)) * (GDN_KEY_DIM ** -0.5)
    k = _l2norm(k.reshape(b, L, GDN_HEADS, GDN_KEY_DIM))
    v = v.reshape(b, L, GDN_HEADS, GDN_HEAD_DIM)
    beta = jax.nn.sigmoid(beta_raw.astype(f32))
    g = -jnp.exp(gdn_A_log.astype(f32)) * jax.nn.softplus(alpha_raw.astype(f32) + gdn_dt_bias.astype(f32))
    o, gdn_S = _gdn_chunked(q, k, v, g, beta, gdn_S0.astype(f32))
    o = _rms_norm(o, gdn_norm_w) * jax.nn.silu(gate.astype(f32)).reshape(b, L, GDN_HEADS, GDN_HEAD_DIM)
    mixed = jnp.concatenate([y, o.reshape(b, L, GDN_WIDTH)], axis=-1).astype(h.dtype)
    return (mixed @ w_out, ssd_h.astype(ssd_h0.dtype), ssd_conv_new,
            gdn_S.astype(gdn_S0.dtype), gdn_conv_new)


def _layer(x, c, ssd_h0, ssd_conv_buf, gdn_S0, gdn_conv_buf, w_ada, b_ada, norm_mix_pre, norm_mix_post,
           norm_ffn_pre, norm_ffn_post, w_in, ssd_conv_w, ssd_conv_b, ssd_dt_bias, ssd_A_log, ssd_D,
           ssd_norm_w, gdn_conv_w, gdn_dt_bias, gdn_A_log, gdn_norm_w, w_out, w_gate_up, w_down):
    mod = jax.nn.silu(c) @ w_ada + b_ada
    sh1, sc1, g1, sh2, sc2, g2 = jnp.split(mod[:, None, :], 6, axis=-1)
    h = _rms_norm(x, norm_mix_pre) * (1 + sc1) + sh1
    m, ssd_h, ssd_conv, gdn_S, gdn_conv = _mixer(
        h, ssd_h0, ssd_conv_buf, gdn_S0, gdn_conv_buf, w_in, ssd_conv_w, ssd_conv_b, ssd_dt_bias,
        ssd_A_log, ssd_D, ssd_norm_w, gdn_conv_w, gdn_dt_bias, gdn_A_log, gdn_norm_w, w_out)
    x = x + g1 * _rms_norm(m, norm_mix_post)
    h = _rms_norm(x, norm_ffn_pre) * (1 + sc2) + sh2
    gu = h @ w_gate_up
    f = (jax.nn.silu(gu[..., :D_FF]) * gu[..., D_FF:]) @ w_down
    x = x + g2 * _rms_norm(f, norm_ffn_post)
    return x, ssd_h, ssd_conv, gdn_S, gdn_conv


def setup_inputs(seed: int = 0) -> dict:
    key = jax.random.key(seed)
    ks = jax.random.split(key, 32)
    f32 = jnp.float32

    def nrm(k, shape, scale):
        return jax.random.normal(k, shape, f32) * scale

    def gain(k, shape):
        return 1.0 + 0.05 * jax.random.normal(k, shape, f32)

    def dt_bias(k, n):
        dt = jnp.exp(jax.random.uniform(k, (DEPTH, n), f32) * (math.log(0.1) - math.log(0.001)) + math.log(0.001))
        return dt + jnp.log(-jnp.expm1(-dt))

    def a_log(k, n):
        return jnp.log(jax.random.uniform(k, (DEPTH, n), f32, minval=1.0, maxval=16.0))

    return {
        "x_prompt": nrm(ks[0], (BATCH, SEQ, D_MODEL), 1.0),
        "x_sample": nrm(ks[1], (DEC_BATCH, DEC_SEQ, D_MODEL), 1.0),
        "c_prompt": nrm(ks[2], (BATCH, D_MODEL), 1.0),
        "c_sample": nrm(ks[3], (DEC_BATCH, D_MODEL), 1.0),
        "state_ssd": nrm(ks[4], (DEPTH, DEC_BATCH, SSD_HEADS, SSD_HEADDIM, SSD_STATE), 0.1),
        "state_ssd_conv": nrm(ks[5], (DEPTH, DEC_BATCH, CONV_WIDTH - 1, SSD_CONV_DIM), 1.0),
        "state_gdn": nrm(ks[6], (DEPTH, DEC_BATCH, GDN_HEADS, GDN_KEY_DIM, GDN_HEAD_DIM), 0.1),
        "state_gdn_conv": nrm(ks[7], (DEPTH, DEC_BATCH, CONV_WIDTH - 1, GDN_CONV_DIM), 1.0),
        "w_ada": nrm(ks[8], (DEPTH, D_MODEL, 6 * D_MODEL), 0.5 * D_MODEL ** -0.5),
        "b_ada": nrm(ks[9], (DEPTH, 6 * D_MODEL), 0.02),
        "norm_mix_pre": gain(ks[10], (DEPTH, D_MODEL)),
        "norm_mix_post": gain(ks[11], (DEPTH, D_MODEL)),
        "norm_ffn_pre": gain(ks[12], (DEPTH, D_MODEL)),
        "norm_ffn_post": gain(ks[13], (DEPTH, D_MODEL)),
        "w_in": nrm(ks[14], (DEPTH, D_MODEL, IN_DIM), D_MODEL ** -0.5),
        "ssd_conv_w": nrm(ks[15], (DEPTH, CONV_WIDTH, SSD_CONV_DIM), CONV_WIDTH ** -0.5),
        "ssd_conv_b": nrm(ks[16], (DEPTH, SSD_CONV_DIM), 0.02),
        "ssd_dt_bias": dt_bias(ks[17], SSD_HEADS),
        "ssd_A_log": a_log(ks[18], SSD_HEADS),
        "ssd_D": gain(ks[19], (DEPTH, SSD_HEADS)),
        "ssd_norm_w": gain(ks[20], (DEPTH, SSD_WIDTH)),
        "gdn_conv_w": nrm(ks[21], (DEPTH, CONV_WIDTH, GDN_CONV_DIM), CONV_WIDTH ** -0.5),
        "gdn_dt_bias": dt_bias(ks[22], GDN_HEADS),
        "gdn_A_log": a_log(ks[23], GDN_HEADS),
        "gdn_norm_w": gain(ks[24], (DEPTH, GDN_HEAD_DIM)),
        "w_out": nrm(ks[25], (DEPTH, D_MIX, D_MODEL), D_MIX ** -0.5),
        "w_gate_up": nrm(ks[26], (DEPTH, D_MODEL, 2 * D_FF), D_MODEL ** -0.5),
        "w_down": nrm(ks[27], (DEPTH, D_FF, D_MODEL), D_FF ** -0.5),
    }


def reference(x_prompt, x_sample, c_prompt, c_sample, state_ssd, state_ssd_conv, state_gdn, state_gdn_conv,
              w_ada, b_ada, norm_mix_pre, norm_mix_post, norm_ffn_pre, norm_ffn_post, w_in, ssd_conv_w,
              ssd_conv_b, ssd_dt_bias, ssd_A_log, ssd_D, ssd_norm_w, gdn_conv_w, gdn_dt_bias, gdn_A_log,
              gdn_norm_w, w_out, w_gate_up, w_down):
    bp = x_prompt.shape[0]
    yp, ys = x_prompt, x_sample
    p_ssd, p_ssd_conv, p_gdn, p_gdn_conv = [], [], [], []
    s_ssd, s_ssd_conv, s_gdn, s_gdn_conv = [], [], [], []
    for l in range(DEPTH):
        lp = (w_ada[l], b_ada[l], norm_mix_pre[l], norm_mix_post[l], norm_ffn_pre[l], norm_ffn_post[l],
              w_in[l], ssd_conv_w[l], ssd_conv_b[l], ssd_dt_bias[l], ssd_A_log[l], ssd_D[l], ssd_norm_w[l],
              gdn_conv_w[l], gdn_dt_bias[l], gdn_A_log[l], gdn_norm_w[l], w_out[l], w_gate_up[l], w_down[l])
        yp, a0, a1, a2, a3 = _layer(
            yp, c_prompt,
            jnp.zeros((bp,) + state_ssd.shape[2:], state_ssd.dtype),
            jnp.zeros((bp,) + state_ssd_conv.shape[2:], state_ssd_conv.dtype),
            jnp.zeros((bp,) + state_gdn.shape[2:], state_gdn.dtype),
            jnp.zeros((bp,) + state_gdn_conv.shape[2:], state_gdn_conv.dtype),
            *lp)
        p_ssd.append(a0); p_ssd_conv.append(a1); p_gdn.append(a2); p_gdn_conv.append(a3)
        ys, b0, b1, b2, b3 = _layer(ys, c_sample, state_ssd[l], state_ssd_conv[l], state_gdn[l],
                                    state_gdn_conv[l], *lp)
        s_ssd.append(b0); s_ssd_conv.append(b1); s_gdn.append(b2); s_gdn_conv.append(b3)
    return (yp, ys, jnp.stack(p_ssd), jnp.stack(p_ssd_conv), jnp.stack(p_gdn), jnp.stack(p_gdn_conv),
            jnp.stack(s_ssd), jnp.stack(s_ssd_conv), jnp.stack(s_gdn), jnp.stack(s_gdn_conv))
```

```cpp
#include <hip/hip_runtime.h>
#include <cstdio>
#include <cstdint>
#define MK_N_LAUNCHES 10
namespace pg8 {
#define PG8_LAS __attribute__((address_space(3)))
typedef unsigned short bf16_t;
typedef short bf16x8 __attribute__((ext_vector_type(8)));
typedef float f32x4 __attribute__((ext_vector_type(4)));
typedef unsigned u32x4 __attribute__((ext_vector_type(4)));
constexpr int BM = 256, BK = 64, HALF = 128, HTB = HALF * BK * 2  , STAGE_BYTES = 8 * HTB, NXCD = 8, WGM = 8;

__host__ __device__ __forceinline__ int lds_byte(int r, int c) { const int st = (r >> 4) * 2 + (c >> 5), rr = r & 15, cc = c & 31, ob = rr * 64 + cc * 2; return st * 1024 + (ob ^ (((ob >> 9) & 1) << 5)); }
__host__ __device__ __forceinline__ void stage_rc(int b, int& R, int& C) { const int st = b / 1024, sb = b % 1024, swz = sb ^ (((sb >> 9) & 1) << 5); R = (st >> 1) * 16 + swz / 64; C = (st & 1) * 32 + (swz % 64) / 2; }
__host__ __device__ __forceinline__ int perm32(int rho) { const int n = rho >> 4, i = rho & 15; return 8 * (i >> 2) + 4 * n + (i & 3); }

struct Unit { int pm, pn; };
struct Gemm { const bf16_t* A; const bf16_t* Bt; int M, N, K; };

struct StaticOrder {
    int nM, nN, nwg, G, c;
    __host__ __device__ void init(int M, int N, int G_, int c_) { nM = M / BM; nN = N / BM; nwg = nM * nN; G = G_; c = c_; }
    __host__ __device__ bool next(int i, Unit& u) const {
        const long L = (long)i * G + c; if (L >= nwg) return false;
        int wgid = (int)L; { const int q = nwg / NXCD, r = nwg % NXCD, xcd = wgid % NXCD, off = wgid / NXCD; wgid = (xcd < r ? xcd * (q + 1) : r * (q + 1) + (xcd - r) * q) + off; }
        const int nig = WGM * nN, gid = wgid / nig, fm = gid * WGM, gsz = (nM - fm) < WGM ? (nM - fm) : WGM;
        u.pm = fm + ((wgid % nig) % gsz); u.pn = (wgid % nig) / gsz; return true;
    }
    __device__ __forceinline__ void a_ready(const Unit&) const {}
    __device__ __forceinline__ void done(const Unit&) const {}
};

__device__ __forceinline__ unsigned cvt_pk_bf16(float lo, float hi) { unsigned r; asm volatile("v_cvt_pk_bf16_f32 %0, %1, %2" : "=v"(r) : "v"(lo), "v"(hi)); return r; }
typedef float f32x2 __attribute__((ext_vector_type(2)));
__device__ __forceinline__ float silu_fast(float x) { return x * __builtin_amdgcn_rcpf(1.f + __expf(-x)); }
struct EpiBf16Clip {
    static constexpr bool PERM = true, AFTER_DRAIN = false;
    bf16_t* O; int ldc; int ncols;
    __device__ __forceinline__ void operator()(const f32x4 (&acc)[2][2][4][2], const Unit& u, int wr, int wc, int fr, int fq) const {
        const int row0 = u.pm * BM + wr * 64 + fr; const int col0 = u.pn * BM + wc * 32 + 8 * fq;
#pragma unroll
        for (int ai = 0; ai < 2; ++ai)
#pragma unroll
            for (int m = 0; m < 4; ++m) { bf16_t* rowp = O + (size_t)(row0 + ai * HALF + m * 16) * ldc + col0;
#pragma unroll
                for (int bj = 0; bj < 2; ++bj) { if (col0 + bj * HALF < ncols) { const f32x4 v0 = acc[ai][bj][m][0], v1 = acc[ai][bj][m][1];
                    u32x4 w; w.x = cvt_pk_bf16(v0[0], v0[1]); w.y = cvt_pk_bf16(v0[2], v0[3]); w.z = cvt_pk_bf16(v1[0], v1[1]); w.w = cvt_pk_bf16(v1[2], v1[3]);
                    *(u32x4*)(rowp + bj * HALF) = w; } } }
    }
};
struct EpiF32 {
    static constexpr bool PERM = false, AFTER_DRAIN = false;
    float* O; int ldc;
    __device__ __forceinline__ void operator()(const f32x4 (&acc)[2][2][4][2], const Unit& u, int wr, int wc, int fr, int fq) const {
        const int row0 = u.pm * BM + wr * 64 + fr; const int col0 = u.pn * BM + wc * 32 + 4 * fq;
#pragma unroll
        for (int ai = 0; ai < 2; ++ai)
#pragma unroll
            for (int m = 0; m < 4; ++m) { float* rowp = O + (size_t)(row0 + ai * HALF + m * 16) * ldc + col0;
#pragma unroll
                for (int bj = 0; bj < 2; ++bj)
#pragma unroll
                    for (int n = 0; n < 2; ++n) *(f32x4*)(rowp + bj * HALF + n * 16) = acc[ai][bj][m][n]; }
    }
};
struct EpiSwiGLU {
    static constexpr bool PERM = true, AFTER_DRAIN = false;
    bf16_t* O; int ldc;
    __device__ __forceinline__ void operator()(const f32x4 (&acc)[2][2][4][2], const Unit& u, int wr, int wc, int fr, int fq) const {
        const int row0 = u.pm * BM + wr * 64 + fr; const int col0 = u.pn * HALF + wc * 32 + 8 * fq;
#pragma unroll
        for (int ai = 0; ai < 2; ++ai)
#pragma unroll
            for (int m = 0; m < 4; ++m) { bf16_t* rowp = O + (size_t)(row0 + ai * HALF + m * 16) * ldc + col0;
                f32x4 v[2];
#pragma unroll
                for (int n = 0; n < 2; ++n) { const f32x4 g = acc[ai][0][m][n], up = acc[ai][1][m][n];
                    v[n] = (f32x4){silu_fast(g[0]) * up[0], silu_fast(g[1]) * up[1], silu_fast(g[2]) * up[2], silu_fast(g[3]) * up[3]}; }
                u32x4 w; w.x = cvt_pk_bf16(v[0][0], v[0][1]); w.y = cvt_pk_bf16(v[0][2], v[0][3]); w.z = cvt_pk_bf16(v[1][0], v[1][1]); w.w = cvt_pk_bf16(v[1][2], v[1][3]);
                *(u32x4*)rowp = w; }
    }
};
template <class Epi, class Sched, bool ALIGN_EPI = false, bool SP2 = false>
__device__ __forceinline__ void gemm_phase(PG8_LAS unsigned char* lds, const Gemm g, const Sched& S, const Epi& E) {
    const int tid = threadIdx.x, wid = __builtin_amdgcn_readfirstlane(tid >> 6), lane = tid & 63, wr = wid >> 2, wc = wid & 3, fr = lane & 15, fq = lane >> 4;
    const int K = g.K, nt = K / BK;
    unsigned voffA[2], voffB[2];
#pragma unroll
    for (int i = 0; i < 2; ++i) { int R, C; stage_rc(tid * 16 + i * 8192, R, C); const int Rb = Epi::PERM ? ((R & ~31) + perm32(R & 31)) : R;
        voffA[i] = (unsigned)(R * K + C) * 2u; voffB[i] = (unsigned)(Rb * K + C) * 2u; }
    const size_t kstep = (size_t)(BK * 2);
    const size_t hstep = (size_t)HALF * K * 2;
    const size_t tstep = 2 * hstep;
    const unsigned ldsw = (unsigned)wid * 1024u;
    const int aoff = lds_byte(wr * 64 + fr, fq * 8), boff = lds_byte(wc * 32 + fr, fq * 8);
#define PG8_SA(b, h) (((b) * 2 + (h)) * HTB)
#define PG8_SB(b, h) ((4 + (b) * 2 + (h)) * HTB)
#define PG8_STAGE(bufoff, gbase, voff) do { _Pragma("unroll") for (int _i = 0; _i < 2; ++_i) \
        __builtin_amdgcn_global_load_lds((const unsigned*)((const char*)(gbase) + (voff)[_i]), (PG8_LAS unsigned*)(lds + (bufoff) + ldsw + _i * 8192), 16, 0, 0); } while (0)
#define PG8_LDA(dst, b, h) do { _Pragma("unroll") for (int m = 0; m < 4; ++m) _Pragma("unroll") for (int k = 0; k < 2; ++k) dst[m][k] = *(const PG8_LAS bf16x8*)(lds + PG8_SA(b, h) + aoff + m * 2048 + k * 1024); } while (0)
#define PG8_LDB(dst, b, h) do { _Pragma("unroll") for (int n = 0; n < 2; ++n) _Pragma("unroll") for (int k = 0; k < 2; ++k) dst[n][k] = *(const PG8_LAS bf16x8*)(lds + PG8_SB(b, h) + boff + n * 2048 + k * 1024); } while (0)
#define PG8_MMA(ai, bj, At, Bt) do { __builtin_amdgcn_s_setprio(1); _Pragma("unroll") for (int m = 0; m < 4; ++m) _Pragma("unroll") for (int n = 0; n < 2; ++n) _Pragma("unroll") for (int k = 0; k < 2; ++k) \
        acc[ai][bj][m][n] = __builtin_amdgcn_mfma_f32_16x16x32_bf16(Bt[n][k], At[m][k], acc[ai][bj][m][n], 0, 0, 0); __builtin_amdgcn_s_setprio(0); } while (0)
#define PG8_WAIT_V(n) asm volatile("s_waitcnt vmcnt(" #n ")" ::: "memory")
#define PG8_WAIT_L(n) asm volatile("s_waitcnt lgkmcnt(" #n ")" ::: "memory")
#define PG8_BAR __builtin_amdgcn_s_barrier()
#define PG8_SCHED __builtin_amdgcn_sched_barrier(0)
    Unit cur, nxt; int ui = 0;
    if (!S.next(0, cur)) return;
    f32x4 acc[2][2][4][2];
#pragma unroll
    for (int a = 0; a < 2; ++a)
#pragma unroll
        for (int b = 0; b < 2; ++b)
#pragma unroll
            for (int m = 0; m < 4; ++m)
#pragma unroll
                for (int n = 0; n < 2; ++n) acc[a][b][m][n] = (f32x4){0.f, 0.f, 0.f, 0.f};
    bf16x8 At[4][2], B0[2][2], B1[2][2];
    const char* cA = (const char*)g.A + (size_t)cur.pm * tstep; const char* cB = (const char*)g.Bt + (size_t)cur.pn * tstep;
    S.a_ready(cur);
    if constexpr (SP2) {
        PG8_STAGE(PG8_SB(0, 0), cB, voffB); PG8_STAGE(PG8_SB(0, 1), cB + hstep, voffB); PG8_STAGE(PG8_SA(0, 0), cA, voffA); PG8_STAGE(PG8_SA(0, 1), cA + hstep, voffA);
        if (wr == 1) PG8_BAR;
        PG8_WAIT_V(2); PG8_BAR;
        PG8_STAGE(PG8_SB(1, 0), cB + kstep, voffB); PG8_STAGE(PG8_SA(1, 0), cA + kstep, voffA); PG8_STAGE(PG8_SB(1, 1), cB + hstep + kstep, voffB);
        PG8_WAIT_V(6); PG8_BAR;
    } else {
        PG8_STAGE(PG8_SB(0, 0), cB, voffB); PG8_STAGE(PG8_SA(0, 0), cA, voffA); PG8_STAGE(PG8_SB(0, 1), cB + hstep, voffB); PG8_STAGE(PG8_SA(0, 1), cA + hstep, voffA);
        if (wr == 1) PG8_BAR;
        PG8_WAIT_V(4); PG8_BAR;
        PG8_STAGE(PG8_SB(1, 0), cB + kstep, voffB); PG8_STAGE(PG8_SA(1, 0), cA + kstep, voffA); PG8_STAGE(PG8_SB(1, 1), cB + hstep + kstep, voffB);
        PG8_WAIT_V(6); PG8_BAR;
    }
    for (;;) {
        const bool has_next = S.next(ui + 1, nxt);
        const char* nA = has_next ? (const char*)g.A + (size_t)nxt.pm * tstep : cA; const char* nB = has_next ? (const char*)g.Bt + (size_t)nxt.pn * tstep : cB;
        for (int t = 0; t < nt; t += 2) {
            const bool last = (t == nt - 2);
            const char* a1 = cA + (size_t)(t + 1) * kstep;
            const char* a2 = last ? nA : cA + (size_t)(t + 2) * kstep; const char* b2 = last ? nB : cB + (size_t)(t + 2) * kstep;
            const char* a3 = a2 + kstep; const char* b3 = b2 + kstep;
            if (last && has_next) S.a_ready(nxt);
            if constexpr (SP2) {
            PG8_LDB(B0, 0, 0); PG8_LDB(B1, 0, 1); PG8_SCHED; PG8_LDA(At, 0, 0); PG8_STAGE(PG8_SA(1, 1), a1 + hstep, voffA);
            PG8_WAIT_V(8); PG8_WAIT_L(0); PG8_BAR; PG8_MMA(0, 0, At, B0); PG8_MMA(0, 1, At, B1); PG8_BAR; PG8_SCHED;
            PG8_LDA(At, 0, 1); PG8_STAGE(PG8_SB(0, 0), b2, voffB); PG8_STAGE(PG8_SB(0, 1), b2 + hstep, voffB); PG8_STAGE(PG8_SA(0, 0), a2, voffA);
            PG8_WAIT_V(8); PG8_WAIT_L(0); PG8_BAR; PG8_MMA(1, 0, At, B0); PG8_MMA(1, 1, At, B1); PG8_BAR; PG8_SCHED;
            PG8_LDB(B0, 1, 0); PG8_LDB(B1, 1, 1); PG8_SCHED; PG8_LDA(At, 1, 0); PG8_STAGE(PG8_SA(0, 1), a2 + hstep, voffA);
            PG8_WAIT_V(8); PG8_WAIT_L(0); PG8_BAR; PG8_MMA(0, 0, At, B0); PG8_MMA(0, 1, At, B1); PG8_BAR; PG8_SCHED;
            PG8_LDA(At, 1, 1); PG8_STAGE(PG8_SB(1, 0), b3, voffB); PG8_STAGE(PG8_SB(1, 1), b3 + hstep, voffB); PG8_STAGE(PG8_SA(1, 0), a3, voffA);
            PG8_WAIT_V(8); PG8_WAIT_L(0); PG8_BAR; PG8_MMA(1, 0, At, B0); PG8_MMA(1, 1, At, B1); PG8_BAR; PG8_SCHED;
            } else {
            PG8_LDB(B0, 0, 0); PG8_SCHED; PG8_LDA(At, 0, 0); PG8_STAGE(PG8_SA(1, 1), a1 + hstep, voffA);
            PG8_WAIT_L(8); PG8_BAR; PG8_WAIT_L(0); PG8_MMA(0, 0, At, B0); PG8_BAR; PG8_SCHED;
            PG8_LDB(B1, 0, 1); PG8_STAGE(PG8_SB(0, 0), b2, voffB);
            PG8_BAR; PG8_WAIT_L(0); PG8_MMA(0, 1, At, B1); PG8_BAR;
            PG8_LDA(At, 0, 1); PG8_STAGE(PG8_SA(0, 0), a2, voffA);
            PG8_BAR; PG8_WAIT_L(0); PG8_MMA(1, 0, At, B0); PG8_BAR; PG8_SCHED;
            PG8_STAGE(PG8_SB(0, 1), b2 + hstep, voffB);
            PG8_WAIT_V(6); PG8_BAR; PG8_MMA(1, 1, At, B1); PG8_BAR;
            PG8_LDB(B0, 1, 0); PG8_SCHED; PG8_LDA(At, 1, 0); PG8_STAGE(PG8_SA(0, 1), a2 + hstep, voffA);
            PG8_WAIT_L(8); PG8_BAR; PG8_WAIT_L(0); PG8_MMA(0, 0, At, B0); PG8_BAR; PG8_SCHED;
            PG8_LDB(B1, 1, 1); PG8_STAGE(PG8_SB(1, 0), b3, voffB);
            PG8_BAR; PG8_WAIT_L(0); PG8_MMA(0, 1, At, B1); PG8_BAR;
            PG8_LDA(At, 1, 1); PG8_STAGE(PG8_SA(1, 0), a3, voffA);
            PG8_BAR; PG8_WAIT_L(0); PG8_MMA(1, 0, At, B0); PG8_BAR; PG8_SCHED;
            PG8_STAGE(PG8_SB(1, 1), b3 + hstep, voffB);
            PG8_WAIT_V(6); PG8_BAR; PG8_MMA(1, 1, At, B1); PG8_BAR;
            }
        }
        if constexpr (ALIGN_EPI) { if (wr == 0) PG8_BAR; }
        if constexpr (!Epi::AFTER_DRAIN) { E(acc, cur, wr, wc, fr, fq); S.done(cur); }
        if (!has_next) break;
#pragma unroll
        for (int a = 0; a < 2; ++a)
#pragma unroll
            for (int b = 0; b < 2; ++b)
#pragma unroll
                for (int m = 0; m < 4; ++m)
#pragma unroll
                    for (int n = 0; n < 2; ++n) acc[a][b][m][n] = (f32x4){0.f, 0.f, 0.f, 0.f};
        cur = nxt; cA = nA; cB = nB; ++ui;
        if constexpr (ALIGN_EPI) { if (wr == 1) PG8_BAR; }
    }
    PG8_WAIT_V(0);
    if constexpr (!ALIGN_EPI) { if (wr == 0) PG8_BAR; }
    PG8_BAR;
    if constexpr (Epi::AFTER_DRAIN) { E.fused(acc, cur, wr, wc, fr, fq, lds, wid, lane); S.done(cur); }
#undef PG8_SA
#undef PG8_SB
#undef PG8_STAGE
#undef PG8_LDA
#undef PG8_LDB
#undef PG8_MMA
#undef PG8_WAIT_V
#undef PG8_WAIT_L
#undef PG8_BAR
#undef PG8_SCHED
}
}
#define GAS __attribute__((address_space(1)))
#define LAS __attribute__((address_space(3)))
typedef unsigned short bf16;
typedef unsigned v4u __attribute__((ext_vector_type(4)));
typedef float f32x4 __attribute__((ext_vector_type(4)));
typedef short bf16x8 __attribute__((ext_vector_type(8)));
typedef GAS unsigned gu32;
typedef GAS unsigned long long gu64;
#define RLX_AGENT __ATOMIC_RELAXED, __HIP_MEMORY_SCOPE_AGENT
#define LDS_WAIT() asm volatile("s_waitcnt lgkmcnt(0)" ::: "memory")
#define VM_WAIT() asm volatile("s_waitcnt vmcnt(0)" ::: "memory")
__device__ __forceinline__ unsigned long long rt() { return __builtin_amdgcn_s_memrealtime(); }
__device__ __forceinline__ unsigned f2bf(float f) { unsigned u = __builtin_bit_cast(unsigned, f); return (u + 0x7fffu + ((u >> 16) & 1u)) >> 16; }
__device__ __forceinline__ unsigned pk2(float lo, float hi) { return f2bf(lo) | (f2bf(hi) << 16); }

#define XB_TMO      128
#define XB_XCNT(j)  (256  + 64 * (j))
#define XB_XSUB(j)  (1280 + 64 * (j))
#define XB_XGEN(j)  (2304 + 64 * (j))
#define XB_TOP      3328
#define XB_TOPGEN   3392
#define XCD_BAR_WORDS 3456
#define XB_SPIN_CAP (1u << 18)

__device__ __forceinline__ unsigned xb_ld(unsigned* p)              { return __hip_atomic_load(p, __ATOMIC_RELAXED, __HIP_MEMORY_SCOPE_AGENT); }
__device__ __forceinline__ unsigned xb_add(unsigned* p, unsigned v) { return __hip_atomic_fetch_add(p, v, __ATOMIC_RELAXED, __HIP_MEMORY_SCOPE_AGENT); }
__device__ __forceinline__ unsigned xb_xcc_id() { return (unsigned)__builtin_amdgcn_s_getreg((3 << 11) | 20) & 0xFu; }
#define XB_SPIN(cond, bar) do { unsigned _sp = 0; while (cond) { __builtin_amdgcn_s_sleep(1); \
    if ((++_sp & 255u) == 0u) { if (xb_ld(&(bar)[XB_TMO])) break; if (_sp > XB_SPIN_CAP) { atomicAdd(&(bar)[XB_TMO], 1u); break; } } } } while (0)

struct XcdBarrier {
    unsigned* bar; unsigned x;
    volatile LAS unsigned* st;
};

__device__ __forceinline__ XcdBarrier xcd_barrier_post(unsigned* bar, volatile LAS unsigned* st) {
    XcdBarrier b; b.bar = bar; b.x = xb_xcc_id(); b.st = st;
    if (threadIdx.x == 0) (void)xb_add(&bar[XB_XCNT(b.x)], 1u);
    return b;
}
__device__ __forceinline__ void xcd_barrier_complete(unsigned* bar, unsigned x, unsigned& nloc, unsigned& nx) {
    const unsigned G = gridDim.x * gridDim.y * gridDim.z;
    unsigned sum, cnt, mine, sp = 0u;
    for (;;) {
        sum = 0u; cnt = 0u; mine = 0u;
#pragma unroll
        for (unsigned j = 0; j < 16; ++j) { const unsigned c = xb_ld(&bar[XB_XCNT(j)]); sum += c; cnt += (c > 0u) ? 1u : 0u; mine = (j == x) ? c : mine; }
        if (sum == G) break;
        __builtin_amdgcn_s_sleep(1);
        if ((++sp & 255u) == 0u) { if (xb_ld(&bar[XB_TMO])) break; if (sp > XB_SPIN_CAP) { atomicAdd(&bar[XB_TMO], 1u); break; } }
    }
    nloc = mine > 0u ? mine : 1u; nx = cnt > 0u ? cnt : 1u;
}

__device__ __forceinline__ void xcd_barrier(const XcdBarrier& b) {
    asm volatile("s_waitcnt vmcnt(0)" ::: "memory");
    __syncthreads();
    if (threadIdx.x == 0) {
        unsigned* bar = b.bar;
        __builtin_amdgcn_s_waitcnt(0);
        unsigned nloc = b.st[0], nx = b.st[1];
        if (nloc == 0u) { xcd_barrier_complete(bar, b.x, nloc, nx); b.st[0] = nloc; b.st[1] = nx; }
        const unsigned old = xb_add(&bar[XB_XSUB(b.x)], 1u);
        const unsigned gen = old / nloc;
        if (old + 1u == (gen + 1u) * nloc) {
            __builtin_amdgcn_fence(__ATOMIC_RELEASE, "agent");
            asm volatile("s_waitcnt vmcnt(0)" ::: "memory");
            const unsigned og = xb_add(&bar[XB_TOP], 1u);
            const unsigned tg = og / nx;
            if (og + 1u == (tg + 1u) * nx) xb_add(&bar[XB_TOPGEN], 1u);
            else XB_SPIN(xb_ld(&bar[XB_TOPGEN]) == tg, bar);
            __builtin_amdgcn_fence(__ATOMIC_ACQUIRE, "agent");
            xb_add(&bar[XB_XGEN(b.x)], 1u);
            asm volatile("s_waitcnt vmcnt(0)" ::: "memory");
        } else {
            XB_SPIN(xb_ld(&bar[XB_XGEN(b.x)]) == gen, bar);
            __builtin_amdgcn_fence(__ATOMIC_ACQUIRE, "agent");
            asm volatile("s_waitcnt vmcnt(0)" ::: "memory");
        }
    }
    __syncthreads();
}
constexpr int NWAVES = 8, NT = NWAVES * 64;
constexpr int DM = 1024, NB_P = 8, SEQ = 2048, NB_S = 128, LS = 8;
constexpr int MP = NB_P * SEQ, MS = NB_S * LS, M = MP + MS;
constexpr int NSEQ = NB_P + NB_S;
constexpr int IN_DIM = 6688, IN_PAD = 6912, PITCH = IN_DIM;
constexpr int PC_Z = 0, PC_XBC = 1024, PC_QKV = 2560, PC_GATE = 5632, PC_DT = 6656, PC_BETA = 6672, PC_ALPHA = 6680;
constexpr int DMIX = 2048, DFF = 2816, NGU = 2 * DFF, NMOD = 6 * DM;
constexpr int SSD_H = 16, SSD_P = 64, SSD_N = 128, SSD_CONV = 1536, GDN_H = 8, GDN_D = 128, GDN_CONV = 3072;
constexpr float EPS = 1e-6f;
constexpr size_t OFF_Y = 0, OFF_SSD_P = (size_t)M * DM, OFF_SSDC_P = OFF_SSD_P + (size_t)NB_P * SSD_H * SSD_P * SSD_N, OFF_GDN_P = OFF_SSDC_P + (size_t)NB_P * 3 * SSD_CONV,
                 OFF_GDNC_P = OFF_GDN_P + (size_t)NB_P * GDN_H * GDN_D * GDN_D, OFF_SSD_S = OFF_GDNC_P + (size_t)NB_P * 3 * GDN_CONV, OFF_SSDC_S = OFF_SSD_S + (size_t)NB_S * SSD_H * SSD_P * SSD_N,
                 OFF_GDN_S = OFF_SSDC_S + (size_t)NB_S * 3 * SSD_CONV, OFF_GDNC_S = OFF_GDN_S + (size_t)NB_S * GDN_H * GDN_D * GDN_D, OUT_TOTAL = OFF_GDNC_S + (size_t)NB_S * 3 * GDN_CONV;
static_assert(OUT_TOTAL == 55357440, "output size");
constexpr size_t MiB = 1u << 20;
constexpr size_t WS_CTL = 0, CTL_ZERO_BYTES = 1 * MiB;
constexpr size_t WS_WOUT = 1 * MiB, WS_WGU = 5 * MiB, WS_WDN = 16 * MiB, WS_MOD = 22 * MiB, WS_SSQ = 26 * MiB, WS_PROJ = 28 * MiB;
constexpr size_t PROJ_BYTES = (size_t)M * PITCH * 2;
constexpr size_t WS_T1 = WS_PROJ, WS_XN2 = WS_PROJ + 68 * MiB, WS_ACT = WS_PROJ + 102 * MiB, WS_T2 = WS_PROJ;
constexpr size_t WS_END = 251 * MiB;
static_assert(WS_WOUT + (size_t)DM * DMIX * 2 <= WS_WGU && WS_WGU + (size_t)NGU * DM * 2 <= WS_WDN && WS_WDN + (size_t)DM * DFF * 2 <= WS_MOD && WS_MOD + (size_t)NSEQ * NMOD * 4 <= WS_SSQ && WS_SSQ + (size_t)M * 16 * 4 <= WS_PROJ, "ws map");
static_assert(WS_PROJ + PROJ_BYTES <= WS_END && (size_t)M * DM * 4 <= 68 * MiB && (size_t)M * DM * 2 <= 34 * MiB && WS_ACT + (size_t)M * DFF * 2 <= WS_PROJ + PROJ_BYTES, "ws overlays");
static_assert((size_t)IN_PAD * DM * 2 <= (size_t)NB_S * SSD_H * SSD_P * SSD_N * 4 && (size_t)M * DM * 2 <= (size_t)NB_S * GDN_H * GDN_D * GDN_D * 4 && (size_t)M * DMIX * 2 == (size_t)M * DM * 4, "d_out scratch");
constexpr int CW_TMO = 0, CW_CODE = 1, CW_QUEUE = 64, CW_BAR = 4096;
constexpr int RING_OFF = 0, RING_BYTES = 131072, LDSCTL_OFF = RING_BYTES, MISC_OFF = LDSCTL_OFF + 320, LDS_BYTES = 147456;
struct Args { const float* in[28]; float* out; unsigned char* ws; int ph_lo, ph_hi, li, pad; };
enum { I_XP = 0, I_XS, I_CP, I_CS, I_SSD, I_SSDC, I_GDN, I_GDNC, I_WADA, I_BADA, I_NMPRE, I_NMPOST, I_NFPRE, I_NFPOST, I_WIN, I_SCW, I_SCB, I_SDTB, I_SALOG, I_SD, I_SNW, I_GCW, I_GDTB, I_GALOG, I_GNW, I_WOUT, I_WGU, I_WDN };
__device__ __forceinline__ float bf2f(unsigned v) { return __uint_as_float(v << 16); }
__device__ __forceinline__ float silu_acc(float x) { return x / (1.f + expf(-x)); }
__device__ __forceinline__ float softplus_acc(float x) { return fmaxf(x, 0.f) + log1pf(expf(-fabsf(x))); }
__device__ __forceinline__ float wave_sum(float v) {
#pragma unroll
    for (int o = 1; o < 64; o <<= 1) v += __shfl_xor(v, o);
    return v;
}
__device__ __forceinline__ bf16* ws_bf(const Args& a, size_t off) { return (bf16*)(a.ws + off); }
__device__ __forceinline__ float* ws_f(const Args& a, size_t off) { return (float*)(a.ws + off); }
__device__ __forceinline__ bf16* win_t(const Args& a) { return (bf16*)(a.out + OFF_SSD_S); }
__device__ __forceinline__ bf16* xn_buf(const Args& a) { return (bf16*)(a.out + OFF_GDN_S); }
__device__ __forceinline__ bf16* mixed_buf(const Args& a) { return (bf16*)(a.out + OFF_Y); }
__device__ __forceinline__ const float* x_row(const Args& a, int row) { return row < MP ? a.in[I_XP] + (size_t)row * DM : a.in[I_XS] + (size_t)(row - MP) * DM; }
__device__ __forceinline__ int seq_of_row(int row) { return row < MP ? (row >> 11) : NB_P + ((row - MP) >> 3); }

__device__ __forceinline__ int dest_row(int which, int n) {
    if (which == 1) { if (n < 2560) return n; if (n < 2576) return PC_DT + (n - 2560); if (n < 6672) return n - 16; return n; }
    if (which == 2) { const int j = n < DFF ? n : n - DFF; return 256 * (j >> 7) + (n < DFF ? 0 : 128) + (j & 127); }
    return n;
}
__device__ __forceinline__ void p0_transpose_item(const float* W, int K, int N, bf16* WT, int which, LAS float* scr, int item, int lane) {
    const int nblk = N / 32, kb = item / nblk, nb = item % nblk, k0 = 64 * kb, n0 = 32 * nb;
#pragma unroll 8
    for (int i = 0; i < 32; ++i) { const int kk = 2 * i + (lane >> 5); scr[kk * 33 + (lane & 31)] = W[(size_t)(k0 + kk) * N + n0 + (lane & 31)]; }
    LDS_WAIT(); asm volatile("" ::: "memory");
    const int c = lane & 7;
#pragma unroll
    for (int j = 0; j < 4; ++j) { const int n = (lane >> 3) + 8 * j; const LAS float* s = scr + (8 * c) * 33 + n;
        v4u o; o.x = pk2(s[0 * 33], s[1 * 33]); o.y = pk2(s[2 * 33], s[3 * 33]); o.z = pk2(s[4 * 33], s[5 * 33]); o.w = pk2(s[6 * 33], s[7 * 33]);
        *(GAS v4u*)(WT + (size_t)dest_row(which, n0 + n) * K + k0 + 8 * c) = o; }
    LDS_WAIT(); asm volatile("" ::: "memory");
}
constexpr int TI_IN = (DM / 64) * (IN_DIM / 32), TI_OUT = (DMIX / 64) * (DM / 32), TI_GU = (DM / 64) * (NGU / 32), TI_DN = (DFF / 64) * (DM / 32), TI_PAD = IN_PAD - IN_DIM;
constexpr int TI_ALL = TI_IN + TI_OUT + TI_GU + TI_DN + TI_PAD;
constexpr int ADA_RB = 17, ADA_ITEMS = (NSEQ / ADA_RB) * (NMOD / 512);
static_assert(NSEQ % ADA_RB == 0 && IN_DIM % 32 == 0 && NGU % 32 == 0 && DFF % 64 == 0, "P0 tiling");
__device__ __forceinline__ void p0_ada_item(const Args& a, LAS unsigned char* lds, int it, int tid, int wave, int lane) {
    LAS float* cs = (LAS float*)lds;
    const int rb = it / (NMOD / 512), cb = it % (NMOD / 512);
    for (int idx = tid; idx < ADA_RB * DM; idx += NT) { const int r = idx >> 10, k = idx & 1023, row = ADA_RB * rb + r;
        const float c = row < NB_P ? a.in[I_CP][row * DM + k] : a.in[I_CS][(row - NB_P) * DM + k]; cs[idx] = silu_acc(c); }
    __syncthreads();
    const int n = 512 * cb + 64 * wave + lane;
    const float* wp = a.in[I_WADA] + n;
    float acc[ADA_RB];
#pragma unroll
    for (int r = 0; r < ADA_RB; ++r) acc[r] = 0.f;
    for (int k = 0; k < DM; k += 4) {
        const float w0 = wp[(size_t)(k + 0) * NMOD], w1 = wp[(size_t)(k + 1) * NMOD], w2 = wp[(size_t)(k + 2) * NMOD], w3 = wp[(size_t)(k + 3) * NMOD];
#pragma unroll
        for (int r = 0; r < ADA_RB; ++r) { const f32x4 c4 = *(const LAS f32x4*)(cs + r * DM + k); acc[r] += c4.x * w0; acc[r] += c4.y * w1; acc[r] += c4.z * w2; acc[r] += c4.w * w3; }
    }
    float* mod = ws_f(a, WS_MOD); const float b = a.in[I_BADA][n];
#pragma unroll
    for (int r = 0; r < ADA_RB; ++r) mod[(size_t)(ADA_RB * rb + r) * NMOD + n] = acc[r] + b;
    __syncthreads();
}
__device__ __forceinline__ void p0_prologue(const Args& a, LAS unsigned char* lds, int bid, int G, int tid, int wave, int lane) {
    const bool split = G > 128;
    const int ada_lo = 0, ada_G = split ? ADA_ITEMS : G;
    if (!split || bid < ADA_ITEMS) for (int it = bid - ada_lo; it < ADA_ITEMS; it += ada_G) p0_ada_item(a, lds, it, tid, wave, lane);
    if (!split || bid >= ADA_ITEMS) {
        LAS float* scr = (LAS float*)(lds + wave * 16384);
        const int gw = (split ? bid - ADA_ITEMS : bid) * NWAVES + wave, NGW = (split ? G - ADA_ITEMS : G) * NWAVES;
        for (int it = gw; it < TI_ALL; it += NGW) {
            int r = it;
            if (r < TI_IN) { p0_transpose_item(a.in[I_WIN], DM, IN_DIM, win_t(a), 1, scr, r, lane); continue; } r -= TI_IN;
            if (r < TI_OUT) { p0_transpose_item(a.in[I_WOUT], DMIX, DM, ws_bf(a, WS_WOUT), 0, scr, r, lane); continue; } r -= TI_OUT;
            if (r < TI_GU) { p0_transpose_item(a.in[I_WGU], DM, NGU, ws_bf(a, WS_WGU), 2, scr, r, lane); continue; } r -= TI_GU;
            if (r < TI_DN) { p0_transpose_item(a.in[I_WDN], DFF, DM, ws_bf(a, WS_WDN), 0, scr, r, lane); continue; } r -= TI_DN;
            { GAS v4u* o = (GAS v4u*)(win_t(a) + (size_t)(IN_DIM + r) * DM) + lane; o[0] = (v4u){0u, 0u, 0u, 0u}; o[64] = (v4u){0u, 0u, 0u, 0u}; }
        }
    }
}
__device__ __forceinline__ void p1_xn(const Args& a, int gw, int NGW, int lane) {
    const float* mod = ws_f(a, WS_MOD); bf16* XN = xn_buf(a); const float* nw = a.in[I_NMPRE];
    for (int row = gw; row < M; row += NGW) {
        const f32x4* xr = (const f32x4*)x_row(a, row) + lane; const float* mr = mod + (size_t)seq_of_row(row) * NMOD;
        f32x4 v[4]; float s = 0.f;
#pragma unroll
        for (int j = 0; j < 4; ++j) { v[j] = xr[64 * j]; s += (v[j].x * v[j].x + v[j].y * v[j].y) + (v[j].z * v[j].z + v[j].w * v[j].w); }
        const float rs = 1.f / sqrtf(wave_sum(s) * (1.f / DM) + EPS);
        unsigned long long* o8 = (unsigned long long*)(XN + (size_t)row * DM) + lane;
#pragma unroll
        for (int j = 0; j < 4; ++j) { const int c = 4 * lane + 256 * j; const f32x4 w = *(const f32x4*)(nw + c), sh = *(const f32x4*)(mr + c), sc = *(const f32x4*)(mr + DM + c);
            const f32x4 h = v[j] * rs * w * (sc + 1.f) + sh;
            o8[64 * j] = (unsigned long long)pk2(h.x, h.y) | ((unsigned long long)pk2(h.z, h.w) << 32); }
    }
}
constexpr int TB = 16;
__device__ __forceinline__ void ssd_item(const Args& a, LAS unsigned char* lds, int s, int h, int tid, int wave, int lane) {
    const bool prompt = s < NB_P; const int L = prompt ? SEQ : LS; const int row0 = prompt ? s * SEQ : MP + (s - NB_P) * LS; const int g = h >> 3;
    LAS float* raw = (LAS float*)lds;
    LAS float* xs = raw + (TB + 3) * 320; LAS float* Bs = xs + TB * 64; LAS float* Cs = Bs + TB * 128; LAS float* dts = Cs + TB * 128; LAS float* ys = dts + TB;
    const bf16* proj = ws_bf(a, WS_PROJ); bf16* mixed = mixed_buf(a); float* ssq = ws_f(a, WS_SSQ);
    const float A = -expf(a.in[I_SALOG][h]), Dh = a.in[I_SD][h], dtb = a.in[I_SDTB][h];
    const int p = 8 * wave + (lane >> 3), nc = lane & 7;
    float hs[16];
    if (prompt) {
#pragma unroll
        for (int i = 0; i < 16; ++i) hs[i] = 0.f;
    } else { const f32x4* sp = (const f32x4*)(a.in[I_SSD] + ((size_t)(s - NB_P) * SSD_H + h) * (SSD_P * SSD_N) + p * SSD_N + 16 * nc);
#pragma unroll
        for (int q = 0; q < 4; ++q) { const f32x4 v = sp[q]; hs[4 * q] = v.x; hs[4 * q + 1] = v.y; hs[4 * q + 2] = v.z; hs[4 * q + 3] = v.w; } }
    for (int t0 = 0; t0 < L; t0 += TB) {
        const int nb = (L - t0) < TB ? (L - t0) : TB;
        for (int idx = tid; idx < (nb + 3) * 320; idx += NT) { const int i = idx / 320, c = idx - i * 320, tt = t0 - 3 + i;
            const int ch = c < 64 ? h * 64 + c : (c < 192 ? 1024 + g * 128 + (c - 64) : 1280 + g * 128 + (c - 192));
            float v;
            if (tt >= 0) v = bf2f(proj[(size_t)(row0 + tt) * PITCH + PC_XBC + ch]);
            else v = prompt ? 0.f : a.in[I_SSDC][((size_t)(s - NB_P) * 3 + (3 + tt)) * SSD_CONV + ch];
            raw[idx] = v; }
        __syncthreads();
        for (int idx = tid; idx < nb * 320; idx += NT) { const int t = idx / 320, c = idx - t * 320;
            const int ch = c < 64 ? h * 64 + c : (c < 192 ? 1024 + g * 128 + (c - 64) : 1280 + g * 128 + (c - 192));
            float acc = a.in[I_SCB][ch];
#pragma unroll
            for (int j = 0; j < 4; ++j) acc += a.in[I_SCW][j * SSD_CONV + ch] * raw[(t + j) * 320 + c];
            acc = silu_acc(acc);
            if (c < 64) xs[t * 64 + c] = acc; else if (c < 192) Bs[t * 128 + (c - 64)] = acc; else Cs[t * 128 + (c - 192)] = acc; }
        if (tid < nb) dts[tid] = softplus_acc(bf2f(proj[(size_t)(row0 + t0 + tid) * PITCH + PC_DT + h]) + dtb);
        __syncthreads();
        for (int t = 0; t < nb; ++t) {
            const float xv = xs[t * 64 + p], dtv = dts[t], dA = __expf(dtv * A), dx = dtv * xv;
            const LAS f32x4* Bp = (const LAS f32x4*)(Bs + t * 128 + 16 * nc); const LAS f32x4* Cp = (const LAS f32x4*)(Cs + t * 128 + 16 * nc);
            float part = 0.f;
#pragma unroll
            for (int q = 0; q < 4; ++q) { const f32x4 b = Bp[q], c = Cp[q];
#pragma unroll
                for (int e = 0; e < 4; ++e) { hs[4 * q + e] = hs[4 * q + e] * dA + dx * b[e]; part += c[e] * hs[4 * q + e]; } }
            part += __shfl_xor(part, 1); part += __shfl_xor(part, 2); part += __shfl_xor(part, 4);
            if (nc == 0) ys[t * 64 + p] = part + Dh * xv;
        }
        __syncthreads();
        { const int t = tid >> 5, pp = tid & 31; float sq = 0.f; const int row = row0 + t0 + t;
            if (t < nb) { const unsigned zz = *(const unsigned*)(proj + (size_t)row * PITCH + PC_Z + h * 64 + 2 * pp);
                const float y0 = ys[t * 64 + 2 * pp] * silu_acc(bf2f(zz & 0xffffu)), y1 = ys[t * 64 + 2 * pp + 1] * silu_acc(bf2f(zz >> 16));
                *(unsigned*)(mixed + (size_t)row * DMIX + h * 64 + 2 * pp) = pk2(y0, y1); sq = y0 * y0 + y1 * y1; }
            sq += __shfl_xor(sq, 1); sq += __shfl_xor(sq, 2); sq += __shfl_xor(sq, 4); sq += __shfl_xor(sq, 8); sq += __shfl_xor(sq, 16);
            if (t < nb && pp == 0) ssq[(size_t)row * 16 + h] = sq; }
    }
    float* so = a.out + (prompt ? OFF_SSD_P + ((size_t)s * SSD_H + h) * (SSD_P * SSD_N) : OFF_SSD_S + ((size_t)(s - NB_P) * SSD_H + h) * (SSD_P * SSD_N)) + p * SSD_N + 16 * nc;
#pragma unroll
    for (int q = 0; q < 4; ++q) ((f32x4*)so)[q] = (f32x4){hs[4 * q], hs[4 * q + 1], hs[4 * q + 2], hs[4 * q + 3]};
    __syncthreads();
}
__device__ __forceinline__ void gdn_item(const Args& a, LAS unsigned char* lds, int s, int h, int tid, int wave, int lane) {
    const bool prompt = s < NB_P; const int L = prompt ? SEQ : LS; const int row0 = prompt ? s * SEQ : MP + (s - NB_P) * LS;
    LAS float* raw = (LAS float*)lds;
    LAS float* qs = raw + (TB + 3) * 384; LAS float* ks = qs + TB * 128; LAS float* vs = ks + TB * 128; LAS float* gs = vs + TB * 128; LAS float* bs = gs + TB; LAS float* os = bs + TB;
    const bf16* proj = ws_bf(a, WS_PROJ); bf16* mixed = mixed_buf(a);
    const float Ag = -expf(a.in[I_GALOG][h]), dtb = a.in[I_GDTB][h];
    const int dv = 16 * wave + (lane & 15), dkc = lane >> 4;
    float Ss[32];
    const size_t sbase = (size_t)(32 * dkc) * GDN_D + dv;
    if (prompt) {
#pragma unroll
        for (int i = 0; i < 32; ++i) Ss[i] = 0.f;
    } else { const float* sp = a.in[I_GDN] + ((size_t)(s - NB_P) * GDN_H + h) * (GDN_D * GDN_D) + sbase;
#pragma unroll
        for (int i = 0; i < 32; ++i) Ss[i] = sp[(size_t)i * GDN_D]; }
    for (int t0 = 0; t0 < L; t0 += TB) {
        const int nb = (L - t0) < TB ? (L - t0) : TB;
        for (int idx = tid; idx < (nb + 3) * 384; idx += NT) { const int i = idx / 384, c = idx - i * 384, tt = t0 - 3 + i;
            const int ch = (c >> 7) * 1024 + h * 128 + (c & 127);
            float v;
            if (tt >= 0) v = bf2f(proj[(size_t)(row0 + tt) * PITCH + PC_QKV + ch]);
            else v = prompt ? 0.f : a.in[I_GDNC][((size_t)(s - NB_P) * 3 + (3 + tt)) * GDN_CONV + ch];
            raw[idx] = v; }
        __syncthreads();
        for (int idx = tid; idx < nb * 384; idx += NT) { const int t = idx / 384, c = idx - t * 384; const int ch = (c >> 7) * 1024 + h * 128 + (c & 127);
            float acc = 0.f;
#pragma unroll
            for (int j = 0; j < 4; ++j) acc += a.in[I_GCW][j * GDN_CONV + ch] * raw[(t + j) * 384 + c];
            acc = silu_acc(acc);
            if (c < 128) qs[t * 128 + c] = acc; else if (c < 256) ks[t * 128 + (c - 128)] = acc; else vs[t * 128 + (c - 256)] = acc; }
        if (tid < nb) { const size_t r = (size_t)(row0 + t0 + tid) * PITCH;
            gs[tid] = Ag * softplus_acc(bf2f(proj[r + PC_ALPHA + h]) + dtb); bs[tid] = 1.f / (1.f + expf(-bf2f(proj[r + PC_BETA + h]))); }
        __syncthreads();
        {
            const int grp = tid >> 4, j = tid & 15, t = grp >> 1; LAS float* vp = ((grp & 1) ? ks : qs) + t * 128 + 8 * j;
            float sq = 0.f; float e[8];
            if (t < nb) {
#pragma unroll
                for (int i = 0; i < 8; ++i) { e[i] = vp[i]; sq += e[i] * e[i]; } }
            sq += __shfl_xor(sq, 1); sq += __shfl_xor(sq, 2); sq += __shfl_xor(sq, 4); sq += __shfl_xor(sq, 8);
            const float sc = (1.f / sqrtf(sq + 1e-6f)) * ((grp & 1) ? 1.f : 0.08838834764831845f);
            if (t < nb) {
#pragma unroll
                for (int i = 0; i < 8; ++i) vp[i] = e[i] * sc; } }
        __syncthreads();
        for (int t = 0; t < nb; ++t) {
            const float eg = __expf(gs[t]), bt = bs[t];
            const LAS f32x4* kp = (const LAS f32x4*)(ks + t * 128 + 32 * dkc); const LAS f32x4* qp = (const LAS f32x4*)(qs + t * 128 + 32 * dkc);
            f32x4 kk[8]; float u = 0.f;
#pragma unroll
            for (int q = 0; q < 8; ++q) { kk[q] = kp[q];
#pragma unroll
                for (int e = 0; e < 4; ++e) u += kk[q][e] * Ss[4 * q + e]; }
            u += __shfl_xor(u, 16); u += __shfl_xor(u, 32);
            const float wv = bt * (vs[t * 128 + dv] - eg * u);
            float o = 0.f;
#pragma unroll
            for (int q = 0; q < 8; ++q) { const f32x4 qq = qp[q];
#pragma unroll
                for (int e = 0; e < 4; ++e) { Ss[4 * q + e] = eg * Ss[4 * q + e] + kk[q][e] * wv; o += qq[e] * Ss[4 * q + e]; } }
            o += __shfl_xor(o, 16); o += __shfl_xor(o, 32);
            if (dkc == 0) os[t * 128 + dv] = o;
        }
        __syncthreads();
        { const int t = tid >> 5, j = tid & 31; const int row = row0 + t0 + t; float sq = 0.f; f32x4 o4 = (f32x4){0.f, 0.f, 0.f, 0.f};
            if (t < nb) { o4 = *(const LAS f32x4*)(os + t * 128 + 4 * j); sq = (o4.x * o4.x + o4.y * o4.y) + (o4.z * o4.z + o4.w * o4.w); }
            sq += __shfl_xor(sq, 1); sq += __shfl_xor(sq, 2); sq += __shfl_xor(sq, 4); sq += __shfl_xor(sq, 8); sq += __shfl_xor(sq, 16);
            if (t < nb) { const float rs = 1.f / sqrtf(sq * (1.f / GDN_D) + EPS); const f32x4 w = *(const f32x4*)(a.in[I_GNW] + 4 * j);
                const unsigned long long gg = *(const unsigned long long*)(proj + (size_t)row * PITCH + PC_GATE + h * 128 + 4 * j);
                const float g0 = silu_acc(bf2f((unsigned)gg & 0xffffu)), g1 = silu_acc(bf2f(((unsigned)gg) >> 16)), g2 = silu_acc(bf2f((unsigned)(gg >> 32) & 0xffffu)), g3 = silu_acc(bf2f((unsigned)(gg >> 48)));
                *(unsigned long long*)(mixed + (size_t)row * DMIX + DM + h * 128 + 4 * j) =
                    (unsigned long long)pk2(o4.x * rs * w.x * g0, o4.y * rs * w.y * g1) | ((unsigned long long)pk2(o4.z * rs * w.z * g2, o4.w * rs * w.w * g3) << 32); } }
    }
    float* so = a.out + (prompt ? OFF_GDN_P + ((size_t)s * GDN_H + h) * (GDN_D * GDN_D) : OFF_GDN_S + ((size_t)(s - NB_P) * GDN_H + h) * (GDN_D * GDN_D)) + sbase;
#pragma unroll
    for (int i = 0; i < 32; ++i) so[(size_t)i * GDN_D] = Ss[i];
    __syncthreads();
}
__device__ __forceinline__ void convstate_item(const Args& a, int s, int tid) {
    const bool prompt = s < NB_P; const int L = prompt ? SEQ : LS; const int row0 = prompt ? s * SEQ : MP + (s - NB_P) * LS; const bf16* proj = ws_bf(a, WS_PROJ);
    float* o1 = a.out + (prompt ? OFF_SSDC_P + (size_t)s * 3 * SSD_CONV : OFF_SSDC_S + (size_t)(s - NB_P) * 3 * SSD_CONV);
    float* o2 = a.out + (prompt ? OFF_GDNC_P + (size_t)s * 3 * GDN_CONV : OFF_GDNC_S + (size_t)(s - NB_P) * 3 * GDN_CONV);
    for (int idx = tid; idx < 3 * SSD_CONV; idx += NT) { const int j = idx / SSD_CONV, c = idx - j * SSD_CONV; o1[idx] = bf2f(proj[(size_t)(row0 + L - 3 + j) * PITCH + PC_XBC + c]); }
    for (int idx = tid; idx < 3 * GDN_CONV; idx += NT) { const int j = idx / GDN_CONV, c = idx - j * GDN_CONV; o2[idx] = bf2f(proj[(size_t)(row0 + L - 3 + j) * PITCH + PC_QKV + c]); }
}
constexpr int Q_GP = NB_P * GDN_H, Q_SP = Q_GP + NB_P * SSD_H, Q_GS = Q_SP + NB_S * GDN_H, Q_SS = Q_GS + NB_S * SSD_H, Q_ALL = Q_SS + NSEQ;
__device__ __forceinline__ void p3_mixers(const Args& a, LAS unsigned char* lds, volatile LAS unsigned* misc, int tid, int wave, int lane) {
    unsigned* qctr = (unsigned*)(a.ws + WS_CTL) + CW_QUEUE;
    for (;;) {
        if (tid == 0) misc[0] = __hip_atomic_fetch_add(qctr, 1u, __ATOMIC_RELAXED, __HIP_MEMORY_SCOPE_AGENT);
        __syncthreads();
        const int it = (int)misc[0];
        __syncthreads();
        if (it >= Q_ALL) break;
        if (it < Q_GP) gdn_item(a, lds, it >> 3, it & 7, tid, wave, lane);
        else if (it < Q_SP) ssd_item(a, lds, (it - Q_GP) >> 4, (it - Q_GP) & 15, tid, wave, lane);
        else if (it < Q_GS) gdn_item(a, lds, NB_P + ((it - Q_SP) >> 3), (it - Q_SP) & 7, tid, wave, lane);
        else if (it < Q_SS) ssd_item(a, lds, NB_P + ((it - Q_GS) >> 4), (it - Q_GS) & 15, tid, wave, lane);
        else convstate_item(a, it - Q_SS, tid);
    }
}
__device__ __forceinline__ void p3b_ssdnorm(const Args& a, int gw, int NGW, int lane) {
    bf16* mixed = mixed_buf(a); const float* ssq = ws_f(a, WS_SSQ); const float* nw = a.in[I_SNW] + 16 * lane;
    for (int row = gw; row < M; row += NGW) {
        const f32x4* sp = (const f32x4*)(ssq + (size_t)row * 16 + 8 * (lane >> 5)); const f32x4 s0 = sp[0], s1 = sp[1];
        const float rs = 1.f / sqrtf(((s0.x + s0.y) + (s0.z + s0.w) + (s1.x + s1.y) + (s1.z + s1.w)) * (1.f / 512.f) + EPS);
        v4u* mp = (v4u*)(mixed + (size_t)row * DMIX + 16 * lane);
#pragma unroll
        for (int q = 0; q < 2; ++q) { v4u v = mp[q]; const f32x4 w0 = *(const f32x4*)(nw + 8 * q), w1 = *(const f32x4*)(nw + 8 * q + 4);
            v.x = pk2(bf2f(v.x & 0xffffu) * rs * w0.x, bf2f(v.x >> 16) * rs * w0.y); v.y = pk2(bf2f(v.y & 0xffffu) * rs * w0.z, bf2f(v.y >> 16) * rs * w0.w);
            v.z = pk2(bf2f(v.z & 0xffffu) * rs * w1.x, bf2f(v.z >> 16) * rs * w1.y); v.w = pk2(bf2f(v.w & 0xffffu) * rs * w1.z, bf2f(v.w >> 16) * rs * w1.w);
            mp[q] = v; }
    }
}
__device__ __forceinline__ void p5_mid(const Args& a, int gw, int NGW, int lane) {
    const float* mod = ws_f(a, WS_MOD); const float* T1 = ws_f(a, WS_T1); bf16* XN2 = ws_bf(a, WS_XN2); const float* wpost = a.in[I_NMPOST]; const float* wpre = a.in[I_NFPRE];
    for (int row = gw; row < M; row += NGW) {
        const f32x4* tr = (const f32x4*)(T1 + (size_t)row * DM) + lane; const f32x4* xr = (const f32x4*)x_row(a, row) + lane; const float* mr = mod + (size_t)seq_of_row(row) * NMOD;
        f32x4 v[4]; float s = 0.f;
#pragma unroll
        for (int j = 0; j < 4; ++j) { v[j] = tr[64 * j]; s += (v[j].x * v[j].x + v[j].y * v[j].y) + (v[j].z * v[j].z + v[j].w * v[j].w); }
        const float rs = 1.f / sqrtf(wave_sum(s) * (1.f / DM) + EPS);
        float s2 = 0.f; f32x4* yo = (f32x4*)(a.out + OFF_Y + (size_t)row * DM) + lane;
#pragma unroll
        for (int j = 0; j < 4; ++j) { const int c = 4 * lane + 256 * j; const f32x4 w = *(const f32x4*)(wpost + c), g1 = *(const f32x4*)(mr + 2 * DM + c);
            v[j] = xr[64 * j] + g1 * (v[j] * rs * w); yo[64 * j] = v[j]; s2 += (v[j].x * v[j].x + v[j].y * v[j].y) + (v[j].z * v[j].z + v[j].w * v[j].w); }
        const float rs2 = 1.f / sqrtf(wave_sum(s2) * (1.f / DM) + EPS);
        unsigned long long* o8 = (unsigned long long*)(XN2 + (size_t)row * DM) + lane;
#pragma unroll
        for (int j = 0; j < 4; ++j) { const int c = 4 * lane + 256 * j; const f32x4 w = *(const f32x4*)(wpre + c), sh = *(const f32x4*)(mr + 3 * DM + c), sc = *(const f32x4*)(mr + 4 * DM + c);
            const f32x4 h = v[j] * rs2 * w * (sc + 1.f) + sh;
            o8[64 * j] = (unsigned long long)pk2(h.x, h.y) | ((unsigned long long)pk2(h.z, h.w) << 32); }
    }
}
__device__ __forceinline__ void p8_final(const Args& a, int gw, int NGW, int lane) {
    const float* mod = ws_f(a, WS_MOD); const float* T2 = ws_f(a, WS_T2); const float* wpost = a.in[I_NFPOST];
    for (int row = gw; row < M; row += NGW) {
        const f32x4* tr = (const f32x4*)(T2 + (size_t)row * DM) + lane; const float* mr = mod + (size_t)seq_of_row(row) * NMOD;
        f32x4 v[4]; float s = 0.f;
#pragma unroll
        for (int j = 0; j < 4; ++j) { v[j] = tr[64 * j]; s += (v[j].x * v[j].x + v[j].y * v[j].y) + (v[j].z * v[j].z + v[j].w * v[j].w); }
        const float rs = 1.f / sqrtf(wave_sum(s) * (1.f / DM) + EPS);
        f32x4* yo = (f32x4*)(a.out + OFF_Y + (size_t)row * DM) + lane;
#pragma unroll
        for (int j = 0; j < 4; ++j) { const int c = 4 * lane + 256 * j; const f32x4 w = *(const f32x4*)(wpost + c), g2 = *(const f32x4*)(mr + 5 * DM + c);
            yo[64 * j] = yo[64 * j] + g2 * (v[j] * rs * w); }
    }
}
#ifndef MK_N_LAUNCHES
#define MK_N_LAUNCHES 1
#endif
constexpr int NPH = 10;
constexpr int N_LAUNCHES = MK_N_LAUNCHES;
static_assert(N_LAUNCHES == 1 || N_LAUNCHES == NPH, "MK_N_LAUNCHES is 1 or 10");
#ifndef PG8_SP2
#define PG8_SP2 true
#endif
#ifndef PG8_ALIGN
#define PG8_ALIGN true
#endif
__global__ void __launch_bounds__(NT, 2) hymba_fwd(Args args) {
    extern __shared__ __attribute__((aligned(16))) unsigned char lds_[];
    LAS unsigned char* lds = (LAS unsigned char*)lds_;
    volatile LAS unsigned* MISC = (volatile LAS unsigned*)(lds + MISC_OFF);
    const int tid = threadIdx.x, lane = tid & 63, wave = __builtin_amdgcn_readfirstlane(tid >> 6);
    const int G = gridDim.x, bid = blockIdx.x;
    const int gw = bid * NWAVES + wave, NGW = G * NWAVES;
    gu32* ctl = (gu32*)(args.ws + WS_CTL);
    for (int u = tid; u < (LDS_BYTES - LDSCTL_OFF) / 4; u += NT) ((LAS unsigned*)(lds + LDSCTL_OFF))[u] = 0u;
    __syncthreads();
    XcdBarrier bar; bar.bar = (unsigned*)(ctl + CW_BAR); bar.x = 0; bar.st = nullptr;
    if (N_LAUNCHES == 1) bar = xcd_barrier_post((unsigned*)(ctl + CW_BAR), MISC + 8);
#define GRID_BAR(seam) do { if (N_LAUNCHES != 1) { if (tid == 0) __hip_atomic_store(ctl + CW_TMO, 0xBADBA0u | (unsigned)(seam), RLX_AGENT); } else { xcd_barrier(bar); } } while (0)
    const int lo = args.ph_lo, hi = args.ph_hi;
#define IN(k) (lo <= (k) && (k) < hi)
#define BOTH(k) (IN(k) && IN((k) + 1))
    if (IN(0)) { p0_prologue(args, lds, bid, G, tid, wave, lane); if (BOTH(0)) GRID_BAR(0); }
    if (IN(1)) { p1_xn(args, gw, NGW, lane); if (BOTH(1)) GRID_BAR(1); }
    if (IN(2)) {
        pg8::Gemm g{xn_buf(args), win_t(args), M, IN_PAD, DM}; pg8::StaticOrder S; S.init(M, IN_PAD, G, bid);
        pg8::EpiBf16Clip E{ws_bf(args, WS_PROJ), PITCH, IN_DIM};
        pg8::gemm_phase<pg8::EpiBf16Clip, pg8::StaticOrder, PG8_ALIGN, PG8_SP2>(lds + RING_OFF, g, S, E);
        if (BOTH(2)) GRID_BAR(2);
    }
    if (IN(3)) { p3_mixers(args, lds, MISC, tid, wave, lane); if (BOTH(3)) GRID_BAR(3); }
    if (IN(4)) { p3b_ssdnorm(args, gw, NGW, lane); if (BOTH(4)) GRID_BAR(4); }
    if (IN(5)) {
        pg8::Gemm g{mixed_buf(args), ws_bf(args, WS_WOUT), M, DM, DMIX}; pg8::StaticOrder S; S.init(M, DM, G, bid);
        pg8::EpiF32 E{ws_f(args, WS_T1), DM};
        pg8::gemm_phase<pg8::EpiF32, pg8::StaticOrder, PG8_ALIGN, PG8_SP2>(lds + RING_OFF, g, S, E);
        if (BOTH(5)) GRID_BAR(5);
    }
    if (IN(6)) { p5_mid(args, gw, NGW, lane); if (BOTH(6)) GRID_BAR(6); }
    if (IN(7)) {
        pg8::Gemm g{ws_bf(args, WS_XN2), ws_bf(args, WS_WGU), M, NGU, DM}; pg8::StaticOrder S; S.init(M, NGU, G, bid);
        pg8::EpiSwiGLU E{ws_bf(args, WS_ACT), DFF};
        pg8::gemm_phase<pg8::EpiSwiGLU, pg8::StaticOrder, PG8_ALIGN, PG8_SP2>(lds + RING_OFF, g, S, E);
        if (BOTH(7)) GRID_BAR(7);
    }
    if (IN(8)) {
        pg8::Gemm g{ws_bf(args, WS_ACT), ws_bf(args, WS_WDN), M, DM, DFF}; pg8::StaticOrder S; S.init(M, DM, G, bid);
        pg8::EpiF32 E{ws_f(args, WS_T2), DM};
        pg8::gemm_phase<pg8::EpiF32, pg8::StaticOrder, PG8_ALIGN, PG8_SP2>(lds + RING_OFF, g, S, E);
        if (BOTH(8)) GRID_BAR(8);
    }
    if (IN(9)) { p8_final(args, gw, NGW, lane); }
#undef IN
#undef BOTH
}
extern "C" void kernel_launch(void* const* d_in, const int* in_sizes, int n_in, void* d_out, int out_size, void* d_ws, size_t ws_size, hipStream_t stream) {
    static int grid = 0;
    if (grid == 0) {
        if (n_in != 28 || in_sizes[0] != MP * DM || (size_t)out_size != OUT_TOTAL || ws_size < WS_END) {
            fprintf(stderr, "kernel_launch: shape/workspace mismatch: n_in %d in0 %d out %d ws %zu (need %zu); nothing launched\n", n_in, n_in > 0 ? in_sizes[0] : -1, out_size, ws_size, (size_t)WS_END); grid = -1; return; }
        int dev = 0, cus = 0, per_cu = 0;
        if (hipGetDevice(&dev) != hipSuccess || hipDeviceGetAttribute(&cus, hipDeviceAttributeMultiprocessorCount, dev) != hipSuccess) { fprintf(stderr, "kernel_launch: device query failed\n"); grid = -1; return; }
        if (hipFuncSetAttribute((const void*)hymba_fwd, hipFuncAttributeMaxDynamicSharedMemorySize, LDS_BYTES) != hipSuccess) { fprintf(stderr, "kernel_launch: hipFuncSetAttribute failed\n"); grid = -1; return; }
        if (hipOccupancyMaxActiveBlocksPerMultiprocessor(&per_cu, (const void*)hymba_fwd, NT, LDS_BYTES) != hipSuccess || per_cu < 1)
            fprintf(stderr, "kernel_launch: note: occupancy query reports %d workgroups per CU\n", per_cu);
        (void)hipGetLastError();
        grid = cus;
    }
    if (grid < 0) return;
    if (hipMemsetAsync((char*)d_ws + WS_CTL, 0, CTL_ZERO_BYTES, stream) != hipSuccess) { fprintf(stderr, "kernel_launch: memset failed\n"); return; }
    Args a{};
    for (int i = 0; i < 28; ++i) a.in[i] = (const float*)d_in[i];
    a.out = (float*)d_out; a.ws = (unsigned char*)d_ws;
    for (int li = 0; li < N_LAUNCHES; ++li) {
        a.ph_lo = (N_LAUNCHES == 1) ? 0 : li; a.ph_hi = (N_LAUNCHES == 1) ? NPH : li + 1; a.li = li;
        hipLaunchKernelGGL(hymba_fwd, dim3(grid), dim3(NT), LDS_BYTES, stream, a);
        const hipError_t le = hipPeekAtLastError();
        if (le != hipSuccess) { fprintf(stderr, "kernel_launch: launch %d failed: %s\n", li, hipGetErrorName(le)); break; }
    }
}
```

```cpp
#include <hip/hip_runtime.h>
#include <cstdio>
#include <cstdint>
namespace pg8 {
#define PG8_LAS __attribute__((address_space(3)))
typedef unsigned short bf16_t;
typedef short bf16x8 __attribute__((ext_vector_type(8)));
typedef float f32x4 __attribute__((ext_vector_type(4)));
typedef unsigned u32x4 __attribute__((ext_vector_type(4)));
constexpr int BM = 256, BK = 64, HALF = 128, HTB = HALF * BK * 2  , STAGE_BYTES = 8 * HTB, NXCD = 8, WGM = 8;

__host__ __device__ __forceinline__ int lds_byte(int r, int c) { const int st = (r >> 4) * 2 + (c >> 5), rr = r & 15, cc = c & 31, ob = rr * 64 + cc * 2; return st * 1024 + (ob ^ (((ob >> 9) & 1) << 5)); }
__host__ __device__ __forceinline__ void stage_rc(int b, int& R, int& C) { const int st = b / 1024, sb = b % 1024, swz = sb ^ (((sb >> 9) & 1) << 5); R = (st >> 1) * 16 + swz / 64; C = (st & 1) * 32 + (swz % 64) / 2; }
__host__ __device__ __forceinline__ int perm32(int rho) { const int n = rho >> 4, i = rho & 15; return 8 * (i >> 2) + 4 * n + (i & 3); }

struct Unit { int pm, pn; };
struct Gemm { const bf16_t* A; const bf16_t* Bt; int M, N, K; };

struct StaticOrder {
    int nM, nN, nwg, G, c;
    __host__ __device__ void init(int M, int N, int G_, int c_) { nM = M / BM; nN = N / BM; nwg = nM * nN; G = G_; c = c_; }
    __host__ __device__ bool next(int i, Unit& u) const {
        const long L = (long)i * G + c; if (L >= nwg) return false;
        int wgid = (int)L; { const int q = nwg / NXCD, r = nwg % NXCD, xcd = wgid % NXCD, off = wgid / NXCD; wgid = (xcd < r ? xcd * (q + 1) : r * (q + 1) + (xcd - r) * q) + off; }
        const int nig = WGM * nN, gid = wgid / nig, fm = gid * WGM, gsz = (nM - fm) < WGM ? (nM - fm) : WGM;
        u.pm = fm + ((wgid % nig) % gsz); u.pn = (wgid % nig) / gsz; return true;
    }
    __device__ __forceinline__ void a_ready(const Unit&) const {}
    __device__ __forceinline__ void done(const Unit&) const {}
};

__device__ __forceinline__ unsigned cvt_pk_bf16(float lo, float hi) { unsigned r; asm volatile("v_cvt_pk_bf16_f32 %0, %1, %2" : "=v"(r) : "v"(lo), "v"(hi)); return r; }
typedef float f32x2 __attribute__((ext_vector_type(2)));
__device__ __forceinline__ float silu_fast(float x) { return x * __builtin_amdgcn_rcpf(1.f + __expf(-x)); }
struct EpiBf16Clip {
    static constexpr bool PERM = true, AFTER_DRAIN = false;
    bf16_t* O; int ldc; int ncols;
    __device__ __forceinline__ void operator()(const f32x4 (&acc)[2][2][4][2], const Unit& u, int wr, int wc, int fr, int fq) const {
        const int row0 = u.pm * BM + wr * 64 + fr; const int col0 = u.pn * BM + wc * 32 + 8 * fq;
#pragma unroll
        for (int ai = 0; ai < 2; ++ai)
#pragma unroll
            for (int m = 0; m < 4; ++m) { bf16_t* rowp = O + (size_t)(row0 + ai * HALF + m * 16) * ldc + col0;
#pragma unroll
                for (int bj = 0; bj < 2; ++bj) { if (col0 + bj * HALF < ncols) { const f32x4 v0 = acc[ai][bj][m][0], v1 = acc[ai][bj][m][1];
                    u32x4 w; w.x = cvt_pk_bf16(v0[0], v0[1]); w.y = cvt_pk_bf16(v0[2], v0[3]); w.z = cvt_pk_bf16(v1[0], v1[1]); w.w = cvt_pk_bf16(v1[2], v1[3]);
                    *(u32x4*)(rowp + bj * HALF) = w; } } }
    }
};
struct EpiF32 {
    static constexpr bool PERM = false, AFTER_DRAIN = false;
    float* O; int ldc;
    __device__ __forceinline__ void operator()(const f32x4 (&acc)[2][2][4][2], const Unit& u, int wr, int wc, int fr, int fq) const {
        const int row0 = u.pm * BM + wr * 64 + fr; const int col0 = u.pn * BM + wc * 32 + 4 * fq;
#pragma unroll
        for (int ai = 0; ai < 2; ++ai)
#pragma unroll
            for (int m = 0; m < 4; ++m) { float* rowp = O + (size_t)(row0 + ai * HALF + m * 16) * ldc + col0;
#pragma unroll
                for (int bj = 0; bj < 2; ++bj)
#pragma unroll
                    for (int n = 0; n < 2; ++n) *(f32x4*)(rowp + bj * HALF + n * 16) = acc[ai][bj][m][n]; }
    }
};
struct EpiSwiGLU {
    static constexpr bool PERM = true, AFTER_DRAIN = false;
    bf16_t* O; int ldc;
    __device__ __forceinline__ void operator()(const f32x4 (&acc)[2][2][4][2], const Unit& u, int wr, int wc, int fr, int fq) const {
        const int row0 = u.pm * BM + wr * 64 + fr; const int col0 = u.pn * HALF + wc * 32 + 8 * fq;
#pragma unroll
        for (int ai = 0; ai < 2; ++ai)
#pragma unroll
            for (int m = 0; m < 4; ++m) { bf16_t* rowp = O + (size_t)(row0 + ai * HALF + m * 16) * ldc + col0;
                f32x4 v[2];
#pragma unroll
                for (int n = 0; n < 2; ++n) { const f32x4 g = acc[ai][0][m][n], up = acc[ai][1][m][n];
                    v[n] = (f32x4){silu_fast(g[0]) * up[0], silu_fast(g[1]) * up[1], silu_fast(g[2]) * up[2], silu_fast(g[3]) * up[3]}; }
                u32x4 w; w.x = cvt_pk_bf16(v[0][0], v[0][1]); w.y = cvt_pk_bf16(v[0][2], v[0][3]); w.z = cvt_pk_bf16(v[1][0], v[1][1]); w.w = cvt_pk_bf16(v[1][2], v[1][3]);
                *(u32x4*)rowp = w; }
    }
};
template <class Epi, class Sched, bool ALIGN_EPI = false, bool SP2 = false>
__device__ __forceinline__ void gemm_phase(PG8_LAS unsigned char* lds, const Gemm g, const Sched& S, const Epi& E) {
    const int tid = threadIdx.x, wid = __builtin_amdgcn_readfirstlane(tid >> 6), lane = tid & 63, wr = wid >> 2, wc = wid & 3, fr = lane & 15, fq = lane >> 4;
    const int K = g.K, nt = K / BK;
    unsigned voffA[2], voffB[2];
#pragma unroll
    for (int i = 0; i < 2; ++i) { int R, C; stage_rc(tid * 16 + i * 8192, R, C); const int Rb = Epi::PERM ? ((R & ~31) + perm32(R & 31)) : R;
        voffA[i] = (unsigned)(R * K + C) * 2u; voffB[i] = (unsigned)(Rb * K + C) * 2u; }
    const size_t kstep = (size_t)(BK * 2);
    const size_t hstep = (size_t)HALF * K * 2;
    const size_t tstep = 2 * hstep;
    const unsigned ldsw = (unsigned)wid * 1024u;
    const int aoff = lds_byte(wr * 64 + fr, fq * 8), boff = lds_byte(wc * 32 + fr, fq * 8);
#define PG8_SA(b, h) (((b) * 2 + (h)) * HTB)
#define PG8_SB(b, h) ((4 + (b) * 2 + (h)) * HTB)
#define PG8_STAGE(bufoff, gbase, voff) do { _Pragma("unroll") for (int _i = 0; _i < 2; ++_i) \
        __builtin_amdgcn_global_load_lds((const unsigned*)((const char*)(gbase) + (voff)[_i]), (PG8_LAS unsigned*)(lds + (bufoff) + ldsw + _i * 8192), 16, 0, 0); } while (0)
#define PG8_LDA(dst, b, h) do { _Pragma("unroll") for (int m = 0; m < 4; ++m) _Pragma("unroll") for (int k = 0; k < 2; ++k) dst[m][k] = *(const PG8_LAS bf16x8*)(lds + PG8_SA(b, h) + aoff + m * 2048 + k * 1024); } while (0)
#define PG8_LDB(dst, b, h) do { _Pragma("unroll") for (int n = 0; n < 2; ++n) _Pragma("unroll") for (int k = 0; k < 2; ++k) dst[n][k] = *(const PG8_LAS bf16x8*)(lds + PG8_SB(b, h) + boff + n * 2048 + k * 1024); } while (0)
#define PG8_MMA(ai, bj, At, Bt) do { __builtin_amdgcn_s_setprio(1); _Pragma("unroll") for (int m = 0; m < 4; ++m) _Pragma("unroll") for (int n = 0; n < 2; ++n) _Pragma("unroll") for (int k = 0; k < 2; ++k) \
        acc[ai][bj][m][n] = __builtin_amdgcn_mfma_f32_16x16x32_bf16(Bt[n][k], At[m][k], acc[ai][bj][m][n], 0, 0, 0); __builtin_amdgcn_s_setprio(0); } while (0)
#define PG8_WAIT_V(n) asm volatile("s_waitcnt vmcnt(" #n ")" ::: "memory")
#define PG8_WAIT_L(n) asm volatile("s_waitcnt lgkmcnt(" #n ")" ::: "memory")
#define PG8_BAR __builtin_amdgcn_s_barrier()
#define PG8_SCHED __builtin_amdgcn_sched_barrier(0)
    Unit cur, nxt; int ui = 0;
    if (!S.next(0, cur)) return;
    f32x4 acc[2][2][4][2];
#pragma unroll
    for (int a = 0; a < 2; ++a)
#pragma unroll
        for (int b = 0; b < 2; ++b)
#pragma unroll
            for (int m = 0; m < 4; ++m)
#pragma unroll
                for (int n = 0; n < 2; ++n) acc[a][b][m][n] = (f32x4){0.f, 0.f, 0.f, 0.f};
    bf16x8 At[4][2], B0[2][2], B1[2][2];
    const char* cA = (const char*)g.A + (size_t)cur.pm * tstep; const char* cB = (const char*)g.Bt + (size_t)cur.pn * tstep;
    S.a_ready(cur);
    if constexpr (SP2) {
        PG8_STAGE(PG8_SB(0, 0), cB, voffB); PG8_STAGE(PG8_SB(0, 1), cB + hstep, voffB); PG8_STAGE(PG8_SA(0, 0), cA, voffA); PG8_STAGE(PG8_SA(0, 1), cA + hstep, voffA);
        if (wr == 1) PG8_BAR;
        PG8_WAIT_V(2); PG8_BAR;
        PG8_STAGE(PG8_SB(1, 0), cB + kstep, voffB); PG8_STAGE(PG8_SA(1, 0), cA + kstep, voffA); PG8_STAGE(PG8_SB(1, 1), cB + hstep + kstep, voffB);
        PG8_WAIT_V(6); PG8_BAR;
    } else {
        PG8_STAGE(PG8_SB(0, 0), cB, voffB); PG8_STAGE(PG8_SA(0, 0), cA, voffA); PG8_STAGE(PG8_SB(0, 1), cB + hstep, voffB); PG8_STAGE(PG8_SA(0, 1), cA + hstep, voffA);
        if (wr == 1) PG8_BAR;
        PG8_WAIT_V(4); PG8_BAR;
        PG8_STAGE(PG8_SB(1, 0), cB + kstep, voffB); PG8_STAGE(PG8_SA(1, 0), cA + kstep, voffA); PG8_STAGE(PG8_SB(1, 1), cB + hstep + kstep, voffB);
        PG8_WAIT_V(6); PG8_BAR;
    }
    for (;;) {
        const bool has_next = S.next(ui + 1, nxt);
        const char* nA = has_next ? (const char*)g.A + (size_t)nxt.pm * tstep : cA; const char* nB = has_next ? (const char*)g.Bt + (size_t)nxt.pn * tstep : cB;
        for (int t = 0; t < nt; t += 2) {
            const bool last = (t == nt - 2);
            const char* a1 = cA + (size_t)(t + 1) * kstep;
            const char* a2 = last ? nA : cA + (size_t)(t + 2) * kstep; const char* b2 = last ? nB : cB + (size_t)(t + 2) * kstep;
            const char* a3 = a2 + kstep; const char* b3 = b2 + kstep;
            if (last && has_next) S.a_ready(nxt);
            if constexpr (SP2) {
            PG8_LDB(B0, 0, 0); PG8_LDB(B1, 0, 1); PG8_SCHED; PG8_LDA(At, 0, 0); PG8_STAGE(PG8_SA(1, 1), a1 + hstep, voffA);
            PG8_WAIT_V(8); PG8_WAIT_L(0); PG8_BAR; PG8_MMA(0, 0, At, B0); PG8_MMA(0, 1, At, B1); PG8_BAR; PG8_SCHED;
            PG8_LDA(At, 0, 1); PG8_STAGE(PG8_SB(0, 0), b2, voffB); PG8_STAGE(PG8_SB(0, 1), b2 + hstep, voffB); PG8_STAGE(PG8_SA(0, 0), a2, voffA);
            PG8_WAIT_V(8); PG8_WAIT_L(0); PG8_BAR; PG8_MMA(1, 0, At, B0); PG8_MMA(1, 1, At, B1); PG8_BAR; PG8_SCHED;
            PG8_LDB(B0, 1, 0); PG8_LDB(B1, 1, 1); PG8_SCHED; PG8_LDA(At, 1, 0); PG8_STAGE(PG8_SA(0, 1), a2 + hstep, voffA);
            PG8_WAIT_V(8); PG8_WAIT_L(0); PG8_BAR; PG8_MMA(0, 0, At, B0); PG8_MMA(0, 1, At, B1); PG8_BAR; PG8_SCHED;
            PG8_LDA(At, 1, 1); PG8_STAGE(PG8_SB(1, 0), b3, voffB); PG8_STAGE(PG8_SB(1, 1), b3 + hstep, voffB); PG8_STAGE(PG8_SA(1, 0), a3, voffA);
            PG8_WAIT_V(8); PG8_WAIT_L(0); PG8_BAR; PG8_MMA(1, 0, At, B0); PG8_MMA(1, 1, At, B1); PG8_BAR; PG8_SCHED;
            } else {
            PG8_LDB(B0, 0, 0); PG8_SCHED; PG8_LDA(At, 0, 0); PG8_STAGE(PG8_SA(1, 1), a1 + hstep, voffA);
            PG8_WAIT_L(8); PG8_BAR; PG8_WAIT_L(0); PG8_MMA(0, 0, At, B0); PG8_BAR; PG8_SCHED;
            PG8_LDB(B1, 0, 1); PG8_STAGE(PG8_SB(0, 0), b2, voffB);
            PG8_BAR; PG8_WAIT_L(0); PG8_MMA(0, 1, At, B1); PG8_BAR;
            PG8_LDA(At, 0, 1); PG8_STAGE(PG8_SA(0, 0), a2, voffA);
            PG8_BAR; PG8_WAIT_L(0); PG8_MMA(1, 0, At, B0); PG8_BAR; PG8_SCHED;
            PG8_STAGE(PG8_SB(0, 1), b2 + hstep, voffB);
            PG8_WAIT_V(6); PG8_BAR; PG8_MMA(1, 1, At, B1); PG8_BAR;
            PG8_LDB(B0, 1, 0); PG8_SCHED; PG8_LDA(At, 1, 0); PG8_STAGE(PG8_SA(0, 1), a2 + hstep, voffA);
            PG8_WAIT_L(8); PG8_BAR; PG8_WAIT_L(0); PG8_MMA(0, 0, At, B0); PG8_BAR; PG8_SCHED;
            PG8_LDB(B1, 1, 1); PG8_STAGE(PG8_SB(1, 0), b3, voffB);
            PG8_BAR; PG8_WAIT_L(0); PG8_MMA(0, 1, At, B1); PG8_BAR;
            PG8_LDA(At, 1, 1); PG8_STAGE(PG8_SA(1, 0), a3, voffA);
            PG8_BAR; PG8_WAIT_L(0); PG8_MMA(1, 0, At, B0); PG8_BAR; PG8_SCHED;
            PG8_STAGE(PG8_SB(1, 1), b3 + hstep, voffB);
            PG8_WAIT_V(6); PG8_BAR; PG8_MMA(1, 1, At, B1); PG8_BAR;
            }
        }
        if constexpr (ALIGN_EPI) { if (wr == 0) PG8_BAR; }
        if constexpr (!Epi::AFTER_DRAIN) { E(acc, cur, wr, wc, fr, fq); S.done(cur); }
        if (!has_next) break;
#pragma unroll
        for (int a = 0; a < 2; ++a)
#pragma unroll
            for (int b = 0; b < 2; ++b)
#pragma unroll
                for (int m = 0; m < 4; ++m)
#pragma unroll
                    for (int n = 0; n < 2; ++n) acc[a][b][m][n] = (f32x4){0.f, 0.f, 0.f, 0.f};
        cur = nxt; cA = nA; cB = nB; ++ui;
        if constexpr (ALIGN_EPI) { if (wr == 1) PG8_BAR; }
    }
    PG8_WAIT_V(0);
    if constexpr (!ALIGN_EPI) { if (wr == 0) PG8_BAR; }
    PG8_BAR;
    if constexpr (Epi::AFTER_DRAIN) { E.fused(acc, cur, wr, wc, fr, fq, lds, wid, lane); S.done(cur); }
#undef PG8_SA
#undef PG8_SB
#undef PG8_STAGE
#undef PG8_LDA
#undef PG8_LDB
#undef PG8_MMA
#undef PG8_WAIT_V
#undef PG8_WAIT_L
#undef PG8_BAR
#undef PG8_SCHED
}
}
#define GAS __attribute__((address_space(1)))
#define LAS __attribute__((address_space(3)))
typedef unsigned short bf16;
typedef unsigned v4u __attribute__((ext_vector_type(4)));
typedef float f32x4 __attribute__((ext_vector_type(4)));
typedef short bf16x8 __attribute__((ext_vector_type(8)));
typedef GAS unsigned gu32;
typedef GAS unsigned long long gu64;
#define RLX_AGENT __ATOMIC_RELAXED, __HIP_MEMORY_SCOPE_AGENT
#define LDS_WAIT() asm volatile("s_waitcnt lgkmcnt(0)" ::: "memory")
#define VM_WAIT() asm volatile("s_waitcnt vmcnt(0)" ::: "memory")
__device__ __forceinline__ unsigned long long rt() { return __builtin_amdgcn_s_memrealtime(); }
__device__ __forceinline__ unsigned f2bf(float f) { unsigned u = __builtin_bit_cast(unsigned, f); return (u + 0x7fffu + ((u >> 16) & 1u)) >> 16; }
__device__ __forceinline__ unsigned pk2(float lo, float hi) { return f2bf(lo) | (f2bf(hi) << 16); }

#define XB_TMO      128
#define XB_XCNT(j)  (256  + 64 * (j))
#define XB_XSUB(j)  (1280 + 64 * (j))
#define XB_XGEN(j)  (2304 + 64 * (j))
#define XB_TOP      3328
#define XB_TOPGEN   3392
#define XCD_BAR_WORDS 3456
#define XB_SPIN_CAP (1u << 18)

__device__ __forceinline__ unsigned xb_ld(unsigned* p)              { return __hip_atomic_load(p, __ATOMIC_RELAXED, __HIP_MEMORY_SCOPE_AGENT); }
__device__ __forceinline__ unsigned xb_add(unsigned* p, unsigned v) { return __hip_atomic_fetch_add(p, v, __ATOMIC_RELAXED, __HIP_MEMORY_SCOPE_AGENT); }
__device__ __forceinline__ unsigned xb_xcc_id() { return (unsigned)__builtin_amdgcn_s_getreg((3 << 11) | 20) & 0xFu; }
#define XB_SPIN(cond, bar) do { unsigned _sp = 0; while (cond) { __builtin_amdgcn_s_sleep(1); \
    if ((++_sp & 255u) == 0u) { if (xb_ld(&(bar)[XB_TMO])) break; if (_sp > XB_SPIN_CAP) { atomicAdd(&(bar)[XB_TMO], 1u); break; } } } } while (0)

struct XcdBarrier {
    unsigned* bar; unsigned x;
    volatile LAS unsigned* st;
};

__device__ __forceinline__ XcdBarrier xcd_barrier_post(unsigned* bar, volatile LAS unsigned* st) {
    XcdBarrier b; b.bar = bar; b.x = xb_xcc_id(); b.st = st;
    if (threadIdx.x == 0) (void)xb_add(&bar[XB_XCNT(b.x)], 1u);
    return b;
}
__device__ __forceinline__ void xcd_barrier_complete(unsigned* bar, unsigned x, unsigned& nloc, unsigned& nx) {
    const unsigned G = gridDim.x * gridDim.y * gridDim.z;
    unsigned sum, cnt, mine, sp = 0u;
    for (;;) {
        sum = 0u; cnt = 0u; mine = 0u;
#pragma unroll
        for (unsigned j = 0; j < 16; ++j) { const unsigned c = xb_ld(&bar[XB_XCNT(j)]); sum += c; cnt += (c > 0u) ? 1u : 0u; mine = (j == x) ? c : mine; }
        if (sum == G) break;
        __builtin_amdgcn_s_sleep(1);
        if ((++sp & 255u) == 0u) { if (xb_ld(&bar[XB_TMO])) break; if (sp > XB_SPIN_CAP) { atomicAdd(&bar[XB_TMO], 1u); break; } }
    }
    nloc = mine > 0u ? mine : 1u; nx = cnt > 0u ? cnt : 1u;
}

__device__ __forceinline__ void xcd_barrier(const XcdBarrier& b) {
    asm volatile("s_waitcnt vmcnt(0)" ::: "memory");
    __syncthreads();
    if (threadIdx.x == 0) {
        unsigned* bar = b.bar;
        __builtin_amdgcn_s_waitcnt(0);
        unsigned nloc = b.st[0], nx = b.st[1];
        if (nloc == 0u) { xcd_barrier_complete(bar, b.x, nloc, nx); b.st[0] = nloc; b.st[1] = nx; }
        const unsigned old = xb_add(&bar[XB_XSUB(b.x)], 1u);
        const unsigned gen = old / nloc;
        if (old + 1u == (gen + 1u) * nloc) {
            __builtin_amdgcn_fence(__ATOMIC_RELEASE, "agent");
            asm volatile("s_waitcnt vmcnt(0)" ::: "memory");
            const unsigned og = xb_add(&bar[XB_TOP], 1u);
            const unsigned tg = og / nx;
            if (og + 1u == (tg + 1u) * nx) xb_add(&bar[XB_TOPGEN], 1u);
            else XB_SPIN(xb_ld(&bar[XB_TOPGEN]) == tg, bar);
            __builtin_amdgcn_fence(__ATOMIC_ACQUIRE, "agent");
            xb_add(&bar[XB_XGEN(b.x)], 1u);
            asm volatile("s_waitcnt vmcnt(0)" ::: "memory");
        } else {
            XB_SPIN(xb_ld(&bar[XB_XGEN(b.x)]) == gen, bar);
            __builtin_amdgcn_fence(__ATOMIC_ACQUIRE, "agent");
            asm volatile("s_waitcnt vmcnt(0)" ::: "memory");
        }
    }
    __syncthreads();
}
constexpr int NWAVES = 8, NT = NWAVES * 64;
constexpr int DM = 1024, NB_P = 8, SEQ = 2048, NB_S = 128, LS = 8;
constexpr int MP = NB_P * SEQ, MS = NB_S * LS, M = MP + MS;
constexpr int NSEQ = NB_P + NB_S;
constexpr int IN_DIM = 6688, IN_PAD = 6912, PITCH = IN_DIM;
constexpr int PC_Z = 0, PC_XBC = 1024, PC_QKV = 2560, PC_GATE = 5632, PC_DT = 6656, PC_BETA = 6672, PC_ALPHA = 6680;
constexpr int DMIX = 2048, DFF = 2816, NGU = 2 * DFF, NMOD = 6 * DM;
constexpr int SSD_H = 16, SSD_P = 64, SSD_N = 128, SSD_CONV = 1536, GDN_H = 8, GDN_D = 128, GDN_CONV = 3072;
constexpr float EPS = 1e-6f;
constexpr size_t OFF_Y = 0, OFF_SSD_P = (size_t)M * DM, OFF_SSDC_P = OFF_SSD_P + (size_t)NB_P * SSD_H * SSD_P * SSD_N, OFF_GDN_P = OFF_SSDC_P + (size_t)NB_P * 3 * SSD_CONV,
                 OFF_GDNC_P = OFF_GDN_P + (size_t)NB_P * GDN_H * GDN_D * GDN_D, OFF_SSD_S = OFF_GDNC_P + (size_t)NB_P * 3 * GDN_CONV, OFF_SSDC_S = OFF_SSD_S + (size_t)NB_S * SSD_H * SSD_P * SSD_N,
                 OFF_GDN_S = OFF_SSDC_S + (size_t)NB_S * 3 * SSD_CONV, OFF_GDNC_S = OFF_GDN_S + (size_t)NB_S * GDN_H * GDN_D * GDN_D, OUT_TOTAL = OFF_GDNC_S + (size_t)NB_S * 3 * GDN_CONV;
static_assert(OUT_TOTAL == 55357440, "output size");
constexpr size_t MiB = 1u << 20;
constexpr size_t WS_CTL = 0, CTL_ZERO_BYTES = 1 * MiB;
constexpr size_t WS_WOUT = 1 * MiB, WS_WGU = 5 * MiB, WS_WDN = 16 * MiB, WS_MOD = 22 * MiB, WS_SSQ = 26 * MiB, WS_PROJ = 28 * MiB;
constexpr size_t PROJ_BYTES = (size_t)M * PITCH * 2;
constexpr size_t WS_T1 = WS_PROJ, WS_XN2 = WS_PROJ + 68 * MiB, WS_ACT = WS_PROJ + 102 * MiB, WS_T2 = WS_PROJ;
constexpr size_t WS_END = 251 * MiB;
static_assert(WS_WOUT + (size_t)DM * DMIX * 2 <= WS_WGU && WS_WGU + (size_t)NGU * DM * 2 <= WS_WDN && WS_WDN + (size_t)DM * DFF * 2 <= WS_MOD && WS_MOD + (size_t)NSEQ * NMOD * 4 <= WS_SSQ && WS_SSQ + (size_t)M * 16 * 4 <= WS_PROJ, "ws map");
static_assert(WS_PROJ + PROJ_BYTES <= WS_END && (size_t)M * DM * 4 <= 68 * MiB && (size_t)M * DM * 2 <= 34 * MiB && WS_ACT + (size_t)M * DFF * 2 <= WS_PROJ + PROJ_BYTES, "ws overlays");
static_assert((size_t)IN_PAD * DM * 2 <= (size_t)NB_S * SSD_H * SSD_P * SSD_N * 4 && (size_t)M * DM * 2 <= (size_t)NB_S * GDN_H * GDN_D * GDN_D * 4 && (size_t)M * DMIX * 2 == (size_t)M * DM * 4, "d_out scratch");
constexpr int CW_TMO = 0, CW_CODE = 1, CW_QUEUE = 64, CW_BAR = 4096;
constexpr int RING_OFF = 0, RING_BYTES = 131072, LDSCTL_OFF = RING_BYTES, MISC_OFF = LDSCTL_OFF + 320, LDS_BYTES = 147456;
struct Args { const float* in[28]; float* out; unsigned char* ws; int ph_lo, ph_hi, li, pad; };
enum { I_XP = 0, I_XS, I_CP, I_CS, I_SSD, I_SSDC, I_GDN, I_GDNC, I_WADA, I_BADA, I_NMPRE, I_NMPOST, I_NFPRE, I_NFPOST, I_WIN, I_SCW, I_SCB, I_SDTB, I_SALOG, I_SD, I_SNW, I_GCW, I_GDTB, I_GALOG, I_GNW, I_WOUT, I_WGU, I_WDN };
__device__ __forceinline__ float bf2f(unsigned v) { return __uint_as_float(v << 16); }
__device__ __forceinline__ float silu_acc(float x) { return x / (1.f + expf(-x)); }
__device__ __forceinline__ float softplus_acc(float x) { return fmaxf(x, 0.f) + log1pf(expf(-fabsf(x))); }
__device__ __forceinline__ float wave_sum(float v) {
#pragma unroll
    for (int o = 1; o < 64; o <<= 1) v += __shfl_xor(v, o);
    return v;
}
__device__ __forceinline__ bf16* ws_bf(const Args& a, size_t off) { return (bf16*)(a.ws + off); }
__device__ __forceinline__ float* ws_f(const Args& a, size_t off) { return (float*)(a.ws + off); }
__device__ __forceinline__ bf16* win_t(const Args& a) { return (bf16*)(a.out + OFF_SSD_S); }
__device__ __forceinline__ bf16* xn_buf(const Args& a) { return (bf16*)(a.out + OFF_GDN_S); }
__device__ __forceinline__ bf16* mixed_buf(const Args& a) { return (bf16*)(a.out + OFF_Y); }
__device__ __forceinline__ const float* x_row(const Args& a, int row) { return row < MP ? a.in[I_XP] + (size_t)row * DM : a.in[I_XS] + (size_t)(row - MP) * DM; }
__device__ __forceinline__ int seq_of_row(int row) { return row < MP ? (row >> 11) : NB_P + ((row - MP) >> 3); }

__device__ __forceinline__ int dest_row(int which, int n) {
    if (which == 1) { if (n < 2560) return n; if (n < 2576) return PC_DT + (n - 2560); if (n < 6672) return n - 16; return n; }
    if (which == 2) { const int j = n < DFF ? n : n - DFF; return 256 * (j >> 7) + (n < DFF ? 0 : 128) + (j & 127); }
    return n;
}
__device__ __forceinline__ void p0_transpose_item(const float* W, int K, int N, bf16* WT, int which, LAS float* scr, int item, int lane) {
    const int nblk = N / 32, kb = item / nblk, nb = item % nblk, k0 = 64 * kb, n0 = 32 * nb;
#pragma unroll 8
    for (int i = 0; i < 32; ++i) { const int kk = 2 * i + (lane >> 5); scr[kk * 33 + (lane & 31)] = W[(size_t)(k0 + kk) * N + n0 + (lane & 31)]; }
    LDS_WAIT(); asm volatile("" ::: "memory");
    const int c = lane & 7;
#pragma unroll
    for (int j = 0; j < 4; ++j) { const int n = (lane >> 3) + 8 * j; const LAS float* s = scr + (8 * c) * 33 + n;
        v4u o; o.x = pk2(s[0 * 33], s[1 * 33]); o.y = pk2(s[2 * 33], s[3 * 33]); o.z = pk2(s[4 * 33], s[5 * 33]); o.w = pk2(s[6 * 33], s[7 * 33]);
        *(GAS v4u*)(WT + (size_t)dest_row(which, n0 + n) * K + k0 + 8 * c) = o; }
    LDS_WAIT(); asm volatile("" ::: "memory");
}
constexpr int TI_IN = (DM / 64) * (IN_DIM / 32), TI_OUT = (DMIX / 64) * (DM / 32), TI_GU = (DM / 64) * (NGU / 32), TI_DN = (DFF / 64) * (DM / 32), TI_PAD = IN_PAD - IN_DIM;
constexpr int TI_ALL = TI_IN + TI_OUT + TI_GU + TI_DN + TI_PAD;
constexpr int ADA_RB = 17, ADA_ITEMS = (NSEQ / ADA_RB) * (NMOD / 512);
static_assert(NSEQ % ADA_RB == 0 && IN_DIM % 32 == 0 && NGU % 32 == 0 && DFF % 64 == 0, "P0 tiling");
__device__ __forceinline__ void p0_ada_item(const Args& a, LAS unsigned char* lds, int it, int tid, int wave, int lane) {
    LAS float* cs = (LAS float*)lds;
    const int rb = it / (NMOD / 512), cb = it % (NMOD / 512);
    for (int idx = tid; idx < ADA_RB * DM; idx += NT) { const int r = idx >> 10, k = idx & 1023, row = ADA_RB * rb + r;
        const float c = row < NB_P ? a.in[I_CP][row * DM + k] : a.in[I_CS][(row - NB_P) * DM + k]; cs[idx] = silu_acc(c); }
    __syncthreads();
    const int n = 512 * cb + 64 * wave + lane;
    const float* wp = a.in[I_WADA] + n;
    float acc[ADA_RB];
#pragma unroll
    for (int r = 0; r < ADA_RB; ++r) acc[r] = 0.f;
    for (int k = 0; k < DM; k += 4) {
        const float w0 = wp[(size_t)(k + 0) * NMOD], w1 = wp[(size_t)(k + 1) * NMOD], w2 = wp[(size_t)(k + 2) * NMOD], w3 = wp[(size_t)(k + 3) * NMOD];
#pragma unroll
        for (int r = 0; r < ADA_RB; ++r) { const f32x4 c4 = *(const LAS f32x4*)(cs + r * DM + k); acc[r] += c4.x * w0; acc[r] += c4.y * w1; acc[r] += c4.z * w2; acc[r] += c4.w * w3; }
    }
    float* mod = ws_f(a, WS_MOD); const float b = a.in[I_BADA][n];
#pragma unroll
    for (int r = 0; r < ADA_RB; ++r) mod[(size_t)(ADA_RB * rb + r) * NMOD + n] = acc[r] + b;
    __syncthreads();
}
__device__ __forceinline__ void p0_prologue(const Args& a, LAS unsigned char* lds, int bid, int G, int tid, int wave, int lane) {
    const bool split = G > 128;
    const int ada_lo = 0, ada_G = split ? ADA_ITEMS : G;
    if (!split || bid < ADA_ITEMS) for (int it = bid - ada_lo; it < ADA_ITEMS; it += ada_G) p0_ada_item(a, lds, it, tid, wave, lane);
    if (!split || bid >= ADA_ITEMS) {
        LAS float* scr = (LAS float*)(lds + wave * 16384);
        const int gw = (split ? bid - ADA_ITEMS : bid) * NWAVES + wave, NGW = (split ? G - ADA_ITEMS : G) * NWAVES;
        for (int it = gw; it < TI_ALL; it += NGW) {
            int r = it;
            if (r < TI_IN) { p0_transpose_item(a.in[I_WIN], DM, IN_DIM, win_t(a), 1, scr, r, lane); continue; } r -= TI_IN;
            if (r < TI_OUT) { p0_transpose_item(a.in[I_WOUT], DMIX, DM, ws_bf(a, WS_WOUT), 0, scr, r, lane); continue; } r -= TI_OUT;
            if (r < TI_GU) { p0_transpose_item(a.in[I_WGU], DM, NGU, ws_bf(a, WS_WGU), 2, scr, r, lane); continue; } r -= TI_GU;
            if (r < TI_DN) { p0_transpose_item(a.in[I_WDN], DFF, DM, ws_bf(a, WS_WDN), 0, scr, r, lane); continue; } r -= TI_DN;
            { GAS v4u* o = (GAS v4u*)(win_t(a) + (size_t)(IN_DIM + r) * DM) + lane; o[0] = (v4u){0u, 0u, 0u, 0u}; o[64] = (v4u){0u, 0u, 0u, 0u}; }
        }
    }
}
__device__ __forceinline__ void p1_xn(const Args& a, int gw, int NGW, int lane) {
    const float* mod = ws_f(a, WS_MOD); bf16* XN = xn_buf(a); const float* nw = a.in[I_NMPRE];
    for (int row = gw; row < M; row += NGW) {
        const f32x4* xr = (const f32x4*)x_row(a, row) + lane; const float* mr = mod + (size_t)seq_of_row(row) * NMOD;
        f32x4 v[4]; float s = 0.f;
#pragma unroll
        for (int j = 0; j < 4; ++j) { v[j] = xr[64 * j]; s += (v[j].x * v[j].x + v[j].y * v[j].y) + (v[j].z * v[j].z + v[j].w * v[j].w); }
        const float rs = 1.f / sqrtf(wave_sum(s) * (1.f / DM) + EPS);
        unsigned long long* o8 = (unsigned long long*)(XN + (size_t)row * DM) + lane;
#pragma unroll
        for (int j = 0; j < 4; ++j) { const int c = 4 * lane + 256 * j; const f32x4 w = *(const f32x4*)(nw + c), sh = *(const f32x4*)(mr + c), sc = *(const f32x4*)(mr + DM + c);
            const f32x4 h = v[j] * rs * w * (sc + 1.f) + sh;
            o8[64 * j] = (unsigned long long)pk2(h.x, h.y) | ((unsigned long long)pk2(h.z, h.w) << 32); }
    }
}
constexpr int TB = 16;
__device__ __forceinline__ void ssd_item(const Args& a, LAS unsigned char* lds, int s, int h, int tid, int wave, int lane) {
    const bool prompt = s < NB_P; const int L = prompt ? SEQ : LS; const int row0 = prompt ? s * SEQ : MP + (s - NB_P) * LS; const int g = h >> 3;
    LAS float* raw = (LAS float*)lds;
    LAS float* xs = raw + (TB + 3) * 320; LAS float* Bs = xs + TB * 64; LAS float* Cs = Bs + TB * 128; LAS float* dts = Cs + TB * 128; LAS float* ys = dts + TB;
    const bf16* proj = ws_bf(a, WS_PROJ); bf16* mixed = mixed_buf(a); float* ssq = ws_f(a, WS_SSQ);
    const float A = -expf(a.in[I_SALOG][h]), Dh = a.in[I_SD][h], dtb = a.in[I_SDTB][h];
    const int p = 8 * wave + (lane >> 3), nc = lane & 7;
    float hs[16];
    if (prompt) {
#pragma unroll
        for (int i = 0; i < 16; ++i) hs[i] = 0.f;
    } else { const f32x4* sp = (const f32x4*)(a.in[I_SSD] + ((size_t)(s - NB_P) * SSD_H + h) * (SSD_P * SSD_N) + p * SSD_N + 16 * nc);
#pragma unroll
        for (int q = 0; q < 4; ++q) { const f32x4 v = sp[q]; hs[4 * q] = v.x; hs[4 * q + 1] = v.y; hs[4 * q + 2] = v.z; hs[4 * q + 3] = v.w; } }
    for (int t0 = 0; t0 < L; t0 += TB) {
        const int nb = (L - t0) < TB ? (L - t0) : TB;
        for (int idx = tid; idx < (nb + 3) * 320; idx += NT) { const int i = idx / 320, c = idx - i * 320, tt = t0 - 3 + i;
            const int ch = c < 64 ? h * 64 + c : (c < 192 ? 1024 + g * 128 + (c - 64) : 1280 + g * 128 + (c - 192));
            float v;
            if (tt >= 0) v = bf2f(proj[(size_t)(row0 + tt) * PITCH + PC_XBC + ch]);
            else v = prompt ? 0.f : a.in[I_SSDC][((size_t)(s - NB_P) * 3 + (3 + tt)) * SSD_CONV + ch];
            raw[idx] = v; }
        __syncthreads();
        for (int idx = tid; idx < nb * 320; idx += NT) { const int t = idx / 320, c = idx - t * 320;
            const int ch = c < 64 ? h * 64 + c : (c < 192 ? 1024 + g * 128 + (c - 64) : 1280 + g * 128 + (c - 192));
            float acc = a.in[I_SCB][ch];
#pragma unroll
            for (int j = 0; j < 4; ++j) acc += a.in[I_SCW][j * SSD_CONV + ch] * raw[(t + j) * 320 + c];
            acc = silu_acc(acc);
            if (c < 64) xs[t * 64 + c] = acc; else if (c < 192) Bs[t * 128 + (c - 64)] = acc; else Cs[t * 128 + (c - 192)] = acc; }
        if (tid < nb) dts[tid] = softplus_acc(bf2f(proj[(size_t)(row0 + t0 + tid) * PITCH + PC_DT + h]) + dtb);
        __syncthreads();
        for (int t = 0; t < nb; ++t) {
            const float xv = xs[t * 64 + p], dtv = dts[t], dA = __expf(dtv * A), dx = dtv * xv;
            const LAS f32x4* Bp = (const LAS f32x4*)(Bs + t * 128 + 16 * nc); const LAS f32x4* Cp = (const LAS f32x4*)(Cs + t * 128 + 16 * nc);
            float part = 0.f;
#pragma unroll
            for (int q = 0; q < 4; ++q) { const f32x4 b = Bp[q], c = Cp[q];
#pragma unroll
                for (int e = 0; e < 4; ++e) { hs[4 * q + e] = hs[4 * q + e] * dA + dx * b[e]; part += c[e] * hs[4 * q + e]; } }
            part += __shfl_xor(part, 1); part += __shfl_xor(part, 2); part += __shfl_xor(part, 4);
            if (nc == 0) ys[t * 64 + p] = part + Dh * xv;
        }
        __syncthreads();
        { const int t = tid >> 5, pp = tid & 31; float sq = 0.f; const int row = row0 + t0 + t;
            if (t < nb) { const unsigned zz = *(const unsigned*)(proj + (size_t)row * PITCH + PC_Z + h * 64 + 2 * pp);
                const float y0 = ys[t * 64 + 2 * pp] * silu_acc(bf2f(zz & 0xffffu)), y1 = ys[t * 64 + 2 * pp + 1] * silu_acc(bf2f(zz >> 16));
                *(unsigned*)(mixed + (size_t)row * DMIX + h * 64 + 2 * pp) = pk2(y0, y1); sq = y0 * y0 + y1 * y1; }
            sq += __shfl_xor(sq, 1); sq += __shfl_xor(sq, 2); sq += __shfl_xor(sq, 4); sq += __shfl_xor(sq, 8); sq += __shfl_xor(sq, 16);
            if (t < nb && pp == 0) ssq[(size_t)row * 16 + h] = sq; }
    }
    float* so = a.out + (prompt ? OFF_SSD_P + ((size_t)s * SSD_H + h) * (SSD_P * SSD_N) : OFF_SSD_S + ((size_t)(s - NB_P) * SSD_H + h) * (SSD_P * SSD_N)) + p * SSD_N + 16 * nc;
#pragma unroll
    for (int q = 0; q < 4; ++q) ((f32x4*)so)[q] = (f32x4){hs[4 * q], hs[4 * q + 1], hs[4 * q + 2], hs[4 * q + 3]};
    __syncthreads();
}
__device__ __forceinline__ void gdn_item(const Args& a, LAS unsigned char* lds, int s, int h, int tid, int wave, int lane) {
    const bool prompt = s < NB_P; const int L = prompt ? SEQ : LS; const int row0 = prompt ? s * SEQ : MP + (s - NB_P) * LS;
    LAS float* raw = (LAS float*)lds;
    LAS float* qs = raw + (TB + 3) * 384; LAS float* ks = qs + TB * 128; LAS float* vs = ks + TB * 128; LAS float* gs = vs + TB * 128; LAS float* bs = gs + TB; LAS float* os = bs + TB;
    const bf16* proj = ws_bf(a, WS_PROJ); bf16* mixed = mixed_buf(a);
    const float Ag = -expf(a.in[I_GALOG][h]), dtb = a.in[I_GDTB][h];
    const int dv = 16 * wave + (lane & 15), dkc = lane >> 4;
    float Ss[32];
    const size_t sbase = (size_t)(32 * dkc) * GDN_D + dv;
    if (prompt) {
#pragma unroll
        for (int i = 0; i < 32; ++i) Ss[i] = 0.f;
    } else { const float* sp = a.in[I_GDN] + ((size_t)(s - NB_P) * GDN_H + h) * (GDN_D * GDN_D) + sbase;
#pragma unroll
        for (int i = 0; i < 32; ++i) Ss[i] = sp[(size_t)i * GDN_D]; }
    for (int t0 = 0; t0 < L; t0 += TB) {
        const int nb = (L - t0) < TB ? (L - t0) : TB;
        for (int idx = tid; idx < (nb + 3) * 384; idx += NT) { const int i = idx / 384, c = idx - i * 384, tt = t0 - 3 + i;
            const int ch = (c >> 7) * 1024 + h * 128 + (c & 127);
            float v;
            if (tt >= 0) v = bf2f(proj[(size_t)(row0 + tt) * PITCH + PC_QKV + ch]);
            else v = prompt ? 0.f : a.in[I_GDNC][((size_t)(s - NB_P) * 3 + (3 + tt)) * GDN_CONV + ch];
            raw[idx] = v; }
        __syncthreads();
        for (int idx = tid; idx < nb * 384; idx += NT) { const int t = idx / 384, c = idx - t * 384; const int ch = (c >> 7) * 1024 + h * 128 + (c & 127);
            float acc = 0.f;
#pragma unroll
            for (int j = 0; j < 4; ++j) acc += a.in[I_GCW][j * GDN_CONV + ch] * raw[(t + j) * 384 + c];
            acc = silu_acc(acc);
            if (c < 128) qs[t * 128 + c] = acc; else if (c < 256) ks[t * 128 + (c - 128)] = acc; else vs[t * 128 + (c - 256)] = acc; }
        if (tid < nb) { const size_t r = (size_t)(row0 + t0 + tid) * PITCH;
            gs[tid] = Ag * softplus_acc(bf2f(proj[r + PC_ALPHA + h]) + dtb); bs[tid] = 1.f / (1.f + expf(-bf2f(proj[r + PC_BETA + h]))); }
        __syncthreads();
        {
            const int grp = tid >> 4, j = tid & 15, t = grp >> 1; LAS float* vp = ((grp & 1) ? ks : qs) + t * 128 + 8 * j;
            float sq = 0.f; float e[8];
            if (t < nb) {
#pragma unroll
                for (int i = 0; i < 8; ++i) { e[i] = vp[i]; sq += e[i] * e[i]; } }
            sq += __shfl_xor(sq, 1); sq += __shfl_xor(sq, 2); sq += __shfl_xor(sq, 4); sq += __shfl_xor(sq, 8);
            const float sc = (1.f / sqrtf(sq + 1e-6f)) * ((grp & 1) ? 1.f : 0.08838834764831845f);
            if (t < nb) {
#pragma unroll
                for (int i = 0; i < 8; ++i) vp[i] = e[i] * sc; } }
        __syncthreads();
        for (int t = 0; t < nb; ++t) {
            const float eg = __expf(gs[t]), bt = bs[t];
            const LAS f32x4* kp = (const LAS f32x4*)(ks + t * 128 + 32 * dkc); const LAS f32x4* qp = (const LAS f32x4*)(qs + t * 128 + 32 * dkc);
            f32x4 kk[8]; float u = 0.f;
#pragma unroll
            for (int q = 0; q < 8; ++q) { kk[q] = kp[q];
#pragma unroll
                for (int e = 0; e < 4; ++e) u += kk[q][e] * Ss[4 * q + e]; }
            u += __shfl_xor(u, 16); u += __shfl_xor(u, 32);
            const float wv = bt * (vs[t * 128 + dv] - eg * u);
            float o = 0.f;
#pragma unroll
            for (int q = 0; q < 8; ++q) { const f32x4 qq = qp[q];
#pragma unroll
                for (int e = 0; e < 4; ++e) { Ss[4 * q + e] = eg * Ss[4 * q + e] + kk[q][e] * wv; o += qq[e] * Ss[4 * q + e]; } }
            o += __shfl_xor(o, 16); o += __shfl_xor(o, 32);
            if (dkc == 0) os[t * 128 + dv] = o;
        }
        __syncthreads();
        { const int t = tid >> 5, j = tid & 31; const int row = row0 + t0 + t; float sq = 0.f; f32x4 o4 = (f32x4){0.f, 0.f, 0.f, 0.f};
            if (t < nb) { o4 = *(const LAS f32x4*)(os + t * 128 + 4 * j); sq = (o4.x * o4.x + o4.y * o4.y) + (o4.z * o4.z + o4.w * o4.w); }
            sq += __shfl_xor(sq, 1); sq += __shfl_xor(sq, 2); sq += __shfl_xor(sq, 4); sq += __shfl_xor(sq, 8); sq += __shfl_xor(sq, 16);
            if (t < nb) { const float rs = 1.f / sqrtf(sq * (1.f / GDN_D) + EPS); const f32x4 w = *(const f32x4*)(a.in[I_GNW] + 4 * j);
                const unsigned long long gg = *(const unsigned long long*)(proj + (size_t)row * PITCH + PC_GATE + h * 128 + 4 * j);
                const float g0 = silu_acc(bf2f((unsigned)gg & 0xffffu)), g1 = silu_acc(bf2f(((unsigned)gg) >> 16)), g2 = silu_acc(bf2f((unsigned)(gg >> 32) & 0xffffu)), g3 = silu_acc(bf2f((unsigned)(gg >> 48)));
                *(unsigned long long*)(mixed + (size_t)row * DMIX + DM + h * 128 + 4 * j) =
                    (unsigned long long)pk2(o4.x * rs * w.x * g0, o4.y * rs * w.y * g1) | ((unsigned long long)pk2(o4.z * rs * w.z * g2, o4.w * rs * w.w * g3) << 32); } }
    }
    float* so = a.out + (prompt ? OFF_GDN_P + ((size_t)s * GDN_H + h) * (GDN_D * GDN_D) : OFF_GDN_S + ((size_t)(s - NB_P) * GDN_H + h) * (GDN_D * GDN_D)) + sbase;
#pragma unroll
    for (int i = 0; i < 32; ++i) so[(size_t)i * GDN_D] = Ss[i];
    __syncthreads();
}
__device__ __forceinline__ void convstate_item(const Args& a, int s, int tid) {
    const bool prompt = s < NB_P; const int L = prompt ? SEQ : LS; const int row0 = prompt ? s * SEQ : MP + (s - NB_P) * LS; const bf16* proj = ws_bf(a, WS_PROJ);
    float* o1 = a.out + (prompt ? OFF_SSDC_P + (size_t)s * 3 * SSD_CONV : OFF_SSDC_S + (size_t)(s - NB_P) * 3 * SSD_CONV);
    float* o2 = a.out + (prompt ? OFF_GDNC_P + (size_t)s * 3 * GDN_CONV : OFF_GDNC_S + (size_t)(s - NB_P) * 3 * GDN_CONV);
    for (int idx = tid; idx < 3 * SSD_CONV; idx += NT) { const int j = idx / SSD_CONV, c = idx - j * SSD_CONV; o1[idx] = bf2f(proj[(size_t)(row0 + L - 3 + j) * PITCH + PC_XBC + c]); }
    for (int idx = tid; idx < 3 * GDN_CONV; idx += NT) { const int j = idx / GDN_CONV, c = idx - j * GDN_CONV; o2[idx] = bf2f(proj[(size_t)(row0 + L - 3 + j) * PITCH + PC_QKV + c]); }
}
constexpr int Q_GP = NB_P * GDN_H, Q_SP = Q_GP + NB_P * SSD_H, Q_GS = Q_SP + NB_S * GDN_H, Q_SS = Q_GS + NB_S * SSD_H, Q_ALL = Q_SS + NSEQ;
__device__ __forceinline__ void p3_mixers(const Args& a, LAS unsigned char* lds, volatile LAS unsigned* misc, int tid, int wave, int lane) {
    unsigned* qctr = (unsigned*)(a.ws + WS_CTL) + CW_QUEUE;
    for (;;) {
        if (tid == 0) misc[0] = __hip_atomic_fetch_add(qctr, 1u, __ATOMIC_RELAXED, __HIP_MEMORY_SCOPE_AGENT);
        __syncthreads();
        const int it = (int)misc[0];
        __syncthreads();
        if (it >= Q_ALL) break;
        if (it < Q_GP) gdn_item(a, lds, it >> 3, it & 7, tid, wave, lane);
        else if (it < Q_SP) ssd_item(a, lds, (it - Q_GP) >> 4, (it - Q_GP) & 15, tid, wave, lane);
        else if (it < Q_GS) gdn_item(a, lds, NB_P + ((it - Q_SP) >> 3), (it - Q_SP) & 7, tid, wave, lane);
        else if (it < Q_SS) ssd_item(a, lds, NB_P + ((it - Q_GS) >> 4), (it - Q_GS) & 15, tid, wave, lane);
        else convstate_item(a, it - Q_SS, tid);
    }
}
__device__ __forceinline__ void p3b_ssdnorm(const Args& a, int gw, int NGW, int lane) {
    bf16* mixed = mixed_buf(a); const float* ssq = ws_f(a, WS_SSQ); const float* nw = a.in[I_SNW] + 16 * lane;
    for (int row = gw; row < M; row += NGW) {
        const f32x4* sp = (const f32x4*)(ssq + (size_t)row * 16 + 8 * (lane >> 5)); const f32x4 s0 = sp[0], s1 = sp[1];
        const float rs = 1.f / sqrtf(((s0.x + s0.y) + (s0.z + s0.w) + (s1.x + s1.y) + (s1.z + s1.w)) * (1.f / 512.f) + EPS);
        v4u* mp = (v4u*)(mixed + (size_t)row * DMIX + 16 * lane);
#pragma unroll
        for (int q = 0; q < 2; ++q) { v4u v = mp[q]; const f32x4 w0 = *(const f32x4*)(nw + 8 * q), w1 = *(const f32x4*)(nw + 8 * q + 4);
            v.x = pk2(bf2f(v.x & 0xffffu) * rs * w0.x, bf2f(v.x >> 16) * rs * w0.y); v.y = pk2(bf2f(v.y & 0xffffu) * rs * w0.z, bf2f(v.y >> 16) * rs * w0.w);
            v.z = pk2(bf2f(v.z & 0xffffu) * rs * w1.x, bf2f(v.z >> 16) * rs * w1.y); v.w = pk2(bf2f(v.w & 0xffffu) * rs * w1.z, bf2f(v.w >> 16) * rs * w1.w);
            mp[q] = v; }
    }
}
__device__ __forceinline__ void p5_mid(const Args& a, int gw, int NGW, int lane) {
    const float* mod = ws_f(a, WS_MOD); const float* T1 = ws_f(a, WS_T1); bf16* XN2 = ws_bf(a, WS_XN2); const float* wpost = a.in[I_NMPOST]; const float* wpre = a.in[I_NFPRE];
    for (int row = gw; row < M; row += NGW) {
        const f32x4* tr = (const f32x4*)(T1 + (size_t)row * DM) + lane; const f32x4* xr = (const f32x4*)x_row(a, row) + lane; const float* mr = mod + (size_t)seq_of_row(row) * NMOD;
        f32x4 v[4]; float s = 0.f;
#pragma unroll
        for (int j = 0; j < 4; ++j) { v[j] = tr[64 * j]; s += (v[j].x * v[j].x + v[j].y * v[j].y) + (v[j].z * v[j].z + v[j].w * v[j].w); }
        const float rs = 1.f / sqrtf(wave_sum(s) * (1.f / DM) + EPS);
        float s2 = 0.f; f32x4* yo = (f32x4*)(a.out + OFF_Y + (size_t)row * DM) + lane;
#pragma unroll
        for (int j = 0; j < 4; ++j) { const int c = 4 * lane + 256 * j; const f32x4 w = *(const f32x4*)(wpost + c), g1 = *(const f32x4*)(mr + 2 * DM + c);
            v[j] = xr[64 * j] + g1 * (v[j] * rs * w); yo[64 * j] = v[j]; s2 += (v[j].x * v[j].x + v[j].y * v[j].y) + (v[j].z * v[j].z + v[j].w * v[j].w); }
        const float rs2 = 1.f / sqrtf(wave_sum(s2) * (1.f / DM) + EPS);
        unsigned long long* o8 = (unsigned long long*)(XN2 + (size_t)row * DM) + lane;
#pragma unroll
        for (int j = 0; j < 4; ++j) { const int c = 4 * lane + 256 * j; const f32x4 w = *(const f32x4*)(wpre + c), sh = *(const f32x4*)(mr + 3 * DM + c), sc = *(const f32x4*)(mr + 4 * DM + c);
            const f32x4 h = v[j] * rs2 * w * (sc + 1.f) + sh;
            o8[64 * j] = (unsigned long long)pk2(h.x, h.y) | ((unsigned long long)pk2(h.z, h.w) << 32); }
    }
}
__device__ __forceinline__ void p8_final(const Args& a, int gw, int NGW, int lane) {
    const float* mod = ws_f(a, WS_MOD); const float* T2 = ws_f(a, WS_T2); const float* wpost = a.in[I_NFPOST];
    for (int row = gw; row < M; row += NGW) {
        const f32x4* tr = (const f32x4*)(T2 + (size_t)row * DM) + lane; const float* mr = mod + (size_t)seq_of_row(row) * NMOD;
        f32x4 v[4]; float s = 0.f;
#pragma unroll
        for (int j = 0; j < 4; ++j) { v[j] = tr[64 * j]; s += (v[j].x * v[j].x + v[j].y * v[j].y) + (v[j].z * v[j].z + v[j].w * v[j].w); }
        const float rs = 1.f / sqrtf(wave_sum(s) * (1.f / DM) + EPS);
        f32x4* yo = (f32x4*)(a.out + OFF_Y + (size_t)row * DM) + lane;
#pragma unroll
        for (int j = 0; j < 4; ++j) { const int c = 4 * lane + 256 * j; const f32x4 w = *(const f32x4*)(wpost + c), g2 = *(const f32x4*)(mr + 5 * DM + c);
            yo[64 * j] = yo[64 * j] + g2 * (v[j] * rs * w); }
    }
}
#ifndef MK_N_LAUNCHES
#define MK_N_LAUNCHES 1
#endif
constexpr int NPH = 10;
constexpr int N_LAUNCHES = MK_N_LAUNCHES;
static_assert(N_LAUNCHES == 1 || N_LAUNCHES == NPH, "MK_N_LAUNCHES is 1 or 10");
#ifndef PG8_SP2
#define PG8_SP2 true
#endif
#ifndef PG8_ALIGN
#define PG8_ALIGN true
#endif
__global__ void __launch_bounds__(NT, 2) hymba_fwd(Args args) {
    extern __shared__ __attribute__((aligned(16))) unsigned char lds_[];
    LAS unsigned char* lds = (LAS unsigned char*)lds_;
    volatile LAS unsigned* MISC = (volatile LAS unsigned*)(lds + MISC_OFF);
    const int tid = threadIdx.x, lane = tid & 63, wave = __builtin_amdgcn_readfirstlane(tid >> 6);
    const int G = gridDim.x, bid = blockIdx.x;
    const int gw = bid * NWAVES + wave, NGW = G * NWAVES;
    gu32* ctl = (gu32*)(args.ws + WS_CTL);
    for (int u = tid; u < (LDS_BYTES - LDSCTL_OFF) / 4; u += NT) ((LAS unsigned*)(lds + LDSCTL_OFF))[u] = 0u;
    __syncthreads();
    XcdBarrier bar; bar.bar = (unsigned*)(ctl + CW_BAR); bar.x = 0; bar.st = nullptr;
    if (N_LAUNCHES == 1) bar = xcd_barrier_post((unsigned*)(ctl + CW_BAR), MISC + 8);
#define GRID_BAR(seam) do { if (N_LAUNCHES != 1) { if (tid == 0) __hip_atomic_store(ctl + CW_TMO, 0xBADBA0u | (unsigned)(seam), RLX_AGENT); } else { xcd_barrier(bar); } } while (0)
    const int lo = args.ph_lo, hi = args.ph_hi;
#define IN(k) (lo <= (k) && (k) < hi)
#define BOTH(k) (IN(k) && IN((k) + 1))
    if (IN(0)) { p0_prologue(args, lds, bid, G, tid, wave, lane); if (BOTH(0)) GRID_BAR(0); }
    if (IN(1)) { p1_xn(args, gw, NGW, lane); if (BOTH(1)) GRID_BAR(1); }
    if (IN(2)) {
        pg8::Gemm g{xn_buf(args), win_t(args), M, IN_PAD, DM}; pg8::StaticOrder S; S.init(M, IN_PAD, G, bid);
        pg8::EpiBf16Clip E{ws_bf(args, WS_PROJ), PITCH, IN_DIM};
        pg8::gemm_phase<pg8::EpiBf16Clip, pg8::StaticOrder, PG8_ALIGN, PG8_SP2>(lds + RING_OFF, g, S, E);
        if (BOTH(2)) GRID_BAR(2);
    }
    if (IN(3)) { p3_mixers(args, lds, MISC, tid, wave, lane); if (BOTH(3)) GRID_BAR(3); }
    if (IN(4)) { p3b_ssdnorm(args, gw, NGW, lane); if (BOTH(4)) GRID_BAR(4); }
    if (IN(5)) {
        pg8::Gemm g{mixed_buf(args), ws_bf(args, WS_WOUT), M, DM, DMIX}; pg8::StaticOrder S; S.init(M, DM, G, bid);
        pg8::EpiF32 E{ws_f(args, WS_T1), DM};
        pg8::gemm_phase<pg8::EpiF32, pg8::StaticOrder, PG8_ALIGN, PG8_SP2>(lds + RING_OFF, g, S, E);
        if (BOTH(5)) GRID_BAR(5);
    }
    if (IN(6)) { p5_mid(args, gw, NGW, lane); if (BOTH(6)) GRID_BAR(6); }
    if (IN(7)) {
        pg8::Gemm g{ws_bf(args, WS_XN2), ws_bf(args, WS_WGU), M, NGU, DM}; pg8::StaticOrder S; S.init(M, NGU, G, bid);
        pg8::EpiSwiGLU E{ws_bf(args, WS_ACT), DFF};
        pg8::gemm_phase<pg8::EpiSwiGLU, pg8::StaticOrder, PG8_ALIGN, PG8_SP2>(lds + RING_OFF, g, S, E);
        if (BOTH(7)) GRID_BAR(7);
    }
    if (IN(8)) {
        pg8::Gemm g{ws_bf(args, WS_ACT), ws_bf(args, WS_WDN), M, DM, DFF}; pg8::StaticOrder S; S.init(M, DM, G, bid);
        pg8::EpiF32 E{ws_f(args, WS_T2), DM};
        pg8::gemm_phase<pg8::EpiF32, pg8::StaticOrder, PG8_ALIGN, PG8_SP2>(lds + RING_OFF, g, S, E);
        if (BOTH(8)) GRID_BAR(8);
    }
    if (IN(9)) { p8_final(args, gw, NGW, lane); }
#undef IN
#undef BOTH
}
extern "C" void kernel_launch(void* const* d_in, const int* in_sizes, int n_in, void* d_out, int out_size, void* d_ws, size_t ws_size, hipStream_t stream) {
    static int grid = 0;
    if (grid == 0) {
        if (n_in != 28 || in_sizes[0] != MP * DM || (size_t)out_size != OUT_TOTAL || ws_size < WS_END) {
            fprintf(stderr, "kernel_launch: shape/workspace mismatch: n_in %d in0 %d out %d ws %zu (need %zu); nothing launched\n", n_in, n_in > 0 ? in_sizes[0] : -1, out_size, ws_size, (size_t)WS_END); grid = -1; return; }
        int dev = 0, cus = 0, per_cu = 0;
        if (hipGetDevice(&dev) != hipSuccess || hipDeviceGetAttribute(&cus, hipDeviceAttributeMultiprocessorCount, dev) != hipSuccess) { fprintf(stderr, "kernel_launch: device query failed\n"); grid = -1; return; }
        if (hipFuncSetAttribute((const void*)hymba_fwd, hipFuncAttributeMaxDynamicSharedMemorySize, LDS_BYTES) != hipSuccess) { fprintf(stderr, "kernel_launch: hipFuncSetAttribute failed\n"); grid = -1; return; }
        if (hipOccupancyMaxActiveBlocksPerMultiprocessor(&per_cu, (const void*)hymba_fwd, NT, LDS_BYTES) != hipSuccess || per_cu < 1)
            fprintf(stderr, "kernel_launch: note: occupancy query reports %d workgroups per CU\n", per_cu);
        (void)hipGetLastError();
        grid = cus;
    }
    if (grid < 0) return;
    if (hipMemsetAsync((char*)d_ws + WS_CTL, 0, CTL_ZERO_BYTES, stream) != hipSuccess) { fprintf(stderr, "kernel_launch: memset failed\n"); return; }
    Args a{};
    for (int i = 0; i < 28; ++i) a.in[i] = (const float*)d_in[i];
    a.out = (float*)d_out; a.ws = (unsigned char*)d_ws;
    for (int li = 0; li < N_LAUNCHES; ++li) {
        a.ph_lo = (N_LAUNCHES == 1) ? 0 : li; a.ph_hi = (N_LAUNCHES == 1) ? NPH : li + 1; a.li = li;
        hipLaunchKernelGGL(hymba_fwd, dim3(grid), dim3(NT), LDS_BYTES, stream, a);
        const hipError_t le = hipPeekAtLastError();
        if (le != hipSuccess) { fprintf(stderr, "kernel_launch: launch %d failed: %s\n", li, hipGetErrorName(le)); break; }
    }
}
```

```cpp
#include <hip/hip_runtime.h>
#include <cstdio>
#include <cstdint>
namespace pg8 {
#define PG8_LAS __attribute__((address_space(3)))
typedef unsigned short bf16_t;
typedef short bf16x8 __attribute__((ext_vector_type(8)));
typedef float f32x4 __attribute__((ext_vector_type(4)));
typedef unsigned u32x4 __attribute__((ext_vector_type(4)));
constexpr int BM = 256, BK = 64, HALF = 128, HTB = HALF * BK * 2  , STAGE_BYTES = 8 * HTB, NXCD = 8, WGM = 8;

__host__ __device__ __forceinline__ int lds_byte(int r, int c) { const int st = (r >> 4) * 2 + (c >> 5), rr = r & 15, cc = c & 31, ob = rr * 64 + cc * 2; return st * 1024 + (ob ^ (((ob >> 9) & 1) << 5)); }
__host__ __device__ __forceinline__ void stage_rc(int b, int& R, int& C) { const int st = b / 1024, sb = b % 1024, swz = sb ^ (((sb >> 9) & 1) << 5); R = (st >> 1) * 16 + swz / 64; C = (st & 1) * 32 + (swz % 64) / 2; }
__host__ __device__ __forceinline__ int perm32(int rho) { const int n = rho >> 4, i = rho & 15; return 8 * (i >> 2) + 4 * n + (i & 3); }

struct Unit { int pm, pn; };
struct Gemm { const bf16_t* A; const bf16_t* Bt; int M, N, K; };

struct StaticOrder {
    int nM, nN, nwg, G, c;
    __host__ __device__ void init(int M, int N, int G_, int c_) { nM = M / BM; nN = N / BM; nwg = nM * nN; G = G_; c = c_; }
    __host__ __device__ bool next(int i, Unit& u) const {
        const long L = (long)i * G + c; if (L >= nwg) return false;
        int wgid = (int)L; { const int q = nwg / NXCD, r = nwg % NXCD, xcd = wgid % NXCD, off = wgid / NXCD; wgid = (xcd < r ? xcd * (q + 1) : r * (q + 1) + (xcd - r) * q) + off; }
        const int nig = WGM * nN, gid = wgid / nig, fm = gid * WGM, gsz = (nM - fm) < WGM ? (nM - fm) : WGM;
        u.pm = fm + ((wgid % nig) % gsz); u.pn = (wgid % nig) / gsz; return true;
    }
    __device__ __forceinline__ void a_ready(const Unit&) const {}
    __device__ __forceinline__ void done(const Unit&) const {}
};

typedef float f32x2c __attribute__((ext_vector_type(2))); typedef __bf16 bf16x2c __attribute__((ext_vector_type(2)));
__device__ __forceinline__ unsigned cvt_pk_bf16(float lo, float hi) { f32x2c v = {lo, hi}; bf16x2c b = __builtin_convertvector(v, bf16x2c); return __builtin_bit_cast(unsigned, b); }
typedef float f32x2 __attribute__((ext_vector_type(2)));
__device__ __forceinline__ float silu_fast(float x) { return x * __builtin_amdgcn_rcpf(1.f + __expf(-x)); }
struct EpiBf16Clip {
    static constexpr bool PERM = true, AFTER_DRAIN = false;
    bf16_t* O; int ldc; int ncols;
    __device__ __forceinline__ void operator()(const f32x4 (&acc)[2][2][4][2], const Unit& u, int wr, int wc, int fr, int fq) const {
        const int row0 = u.pm * BM + wr * 64 + fr; const int col0 = u.pn * BM + wc * 32 + 8 * fq;
#pragma unroll
        for (int ai = 0; ai < 2; ++ai)
#pragma unroll
            for (int m = 0; m < 4; ++m) { bf16_t* rowp = O + (size_t)(row0 + ai * HALF + m * 16) * ldc + col0;
#pragma unroll
                for (int bj = 0; bj < 2; ++bj) { if (col0 + bj * HALF < ncols) { const f32x4 v0 = acc[ai][bj][m][0], v1 = acc[ai][bj][m][1];
                    u32x4 w; w.x = cvt_pk_bf16(v0[0], v0[1]); w.y = cvt_pk_bf16(v0[2], v0[3]); w.z = cvt_pk_bf16(v1[0], v1[1]); w.w = cvt_pk_bf16(v1[2], v1[3]);
                    *(u32x4*)(rowp + bj * HALF) = w; } } }
    }
};
struct EpiF32 {
    static constexpr bool PERM = false, AFTER_DRAIN = false;
    float* O; int ldc;
    __device__ __forceinline__ void operator()(const f32x4 (&acc)[2][2][4][2], const Unit& u, int wr, int wc, int fr, int fq) const {
        const int row0 = u.pm * BM + wr * 64 + fr; const int col0 = u.pn * BM + wc * 32 + 4 * fq;
#pragma unroll
        for (int ai = 0; ai < 2; ++ai)
#pragma unroll
            for (int m = 0; m < 4; ++m) { float* rowp = O + (size_t)(row0 + ai * HALF + m * 16) * ldc + col0;
#pragma unroll
                for (int bj = 0; bj < 2; ++bj)
#pragma unroll
                    for (int n = 0; n < 2; ++n) *(f32x4*)(rowp + bj * HALF + n * 16) = acc[ai][bj][m][n]; }
    }
};
struct EpiSwiGLU {
    static constexpr bool PERM = true, AFTER_DRAIN = false;
    bf16_t* O; int ldc;
    __device__ __forceinline__ void operator()(const f32x4 (&acc)[2][2][4][2], const Unit& u, int wr, int wc, int fr, int fq) const {
        const int row0 = u.pm * BM + wr * 64 + fr; const int col0 = u.pn * HALF + wc * 32 + 8 * fq;
#pragma unroll
        for (int ai = 0; ai < 2; ++ai)
#pragma unroll
            for (int m = 0; m < 4; ++m) { bf16_t* rowp = O + (size_t)(row0 + ai * HALF + m * 16) * ldc + col0;
                f32x4 v[2];
#pragma unroll
                for (int n = 0; n < 2; ++n) { const f32x4 g = acc[ai][0][m][n], up = acc[ai][1][m][n];
                    v[n] = (f32x4){silu_fast(g[0]) * up[0], silu_fast(g[1]) * up[1], silu_fast(g[2]) * up[2], silu_fast(g[3]) * up[3]}; }
                u32x4 w; w.x = cvt_pk_bf16(v[0][0], v[0][1]); w.y = cvt_pk_bf16(v[0][2], v[0][3]); w.z = cvt_pk_bf16(v[1][0], v[1][1]); w.w = cvt_pk_bf16(v[1][2], v[1][3]);
                *(u32x4*)rowp = w; }
    }
};
template <class Epi, class Sched, bool ALIGN_EPI = false, bool SP2 = false>
__device__ __forceinline__ void gemm_phase(PG8_LAS unsigned char* lds, const Gemm g, const Sched& S, const Epi& E) {
    const int tid = threadIdx.x, wid = __builtin_amdgcn_readfirstlane(tid >> 6), lane = tid & 63, wr = wid >> 2, wc = wid & 3, fr = lane & 15, fq = lane >> 4;
    const int K = g.K, nt = K / BK;
    unsigned voffA[2], voffB[2];
#pragma unroll
    for (int i = 0; i < 2; ++i) { int R, C; stage_rc(tid * 16 + i * 8192, R, C); const int Rb = Epi::PERM ? ((R & ~31) + perm32(R & 31)) : R;
        voffA[i] = (unsigned)(R * K + C) * 2u; voffB[i] = (unsigned)(Rb * K + C) * 2u; }
    const size_t kstep = (size_t)(BK * 2);
    const size_t hstep = (size_t)HALF * K * 2;
    const size_t tstep = 2 * hstep;
    const unsigned ldsw = (unsigned)wid * 1024u;
    const int aoff = lds_byte(wr * 64 + fr, fq * 8), boff = lds_byte(wc * 32 + fr, fq * 8);
#define PG8_SA(b, h) (((b) * 2 + (h)) * HTB)
#define PG8_SB(b, h) ((4 + (b) * 2 + (h)) * HTB)
#define PG8_STAGE(bufoff, gbase, voff) do { _Pragma("unroll") for (int _i = 0; _i < 2; ++_i) \
        __builtin_amdgcn_global_load_lds((const unsigned*)((const char*)(gbase) + (voff)[_i]), (PG8_LAS unsigned*)(lds + (bufoff) + ldsw + _i * 8192), 16, 0, 0); } while (0)
#define PG8_LDA(dst, b, h) do { _Pragma("unroll") for (int m = 0; m < 4; ++m) _Pragma("unroll") for (int k = 0; k < 2; ++k) dst[m][k] = *(const PG8_LAS bf16x8*)(lds + PG8_SA(b, h) + aoff + m * 2048 + k * 1024); } while (0)
#define PG8_LDB(dst, b, h) do { _Pragma("unroll") for (int n = 0; n < 2; ++n) _Pragma("unroll") for (int k = 0; k < 2; ++k) dst[n][k] = *(const PG8_LAS bf16x8*)(lds + PG8_SB(b, h) + boff + n * 2048 + k * 1024); } while (0)
#define PG8_MMA(ai, bj, At, Bt) do { __builtin_amdgcn_s_setprio(1); _Pragma("unroll") for (int m = 0; m < 4; ++m) _Pragma("unroll") for (int n = 0; n < 2; ++n) _Pragma("unroll") for (int k = 0; k < 2; ++k) \
        acc[ai][bj][m][n] = __builtin_amdgcn_mfma_f32_16x16x32_bf16(Bt[n][k], At[m][k], acc[ai][bj][m][n], 0, 0, 0); __builtin_amdgcn_s_setprio(0); } while (0)
#define PG8_WAIT_V(n) asm volatile("s_waitcnt vmcnt(" #n ")" ::: "memory")
#define PG8_WAIT_L(n) asm volatile("s_waitcnt lgkmcnt(" #n ")" ::: "memory")
#define PG8_BAR __builtin_amdgcn_s_barrier()
#define PG8_SCHED __builtin_amdgcn_sched_barrier(0)
    Unit cur, nxt; int ui = 0;
    if (!S.next(0, cur)) return;
    f32x4 acc[2][2][4][2];
#pragma unroll
    for (int a = 0; a < 2; ++a)
#pragma unroll
        for (int b = 0; b < 2; ++b)
#pragma unroll
            for (int m = 0; m < 4; ++m)
#pragma unroll
                for (int n = 0; n < 2; ++n) acc[a][b][m][n] = (f32x4){0.f, 0.f, 0.f, 0.f};
    bf16x8 At[4][2], B0[2][2], B1[2][2];
    const char* cA = (const char*)g.A + (size_t)cur.pm * tstep; const char* cB = (const char*)g.Bt + (size_t)cur.pn * tstep;
    S.a_ready(cur);
    if constexpr (SP2) {
        PG8_STAGE(PG8_SB(0, 0), cB, voffB); PG8_STAGE(PG8_SB(0, 1), cB + hstep, voffB); PG8_STAGE(PG8_SA(0, 0), cA, voffA); PG8_STAGE(PG8_SA(0, 1), cA + hstep, voffA);
        if (wr == 1) PG8_BAR;
        PG8_WAIT_V(2); PG8_BAR;
        PG8_STAGE(PG8_SB(1, 0), cB + kstep, voffB); PG8_STAGE(PG8_SA(1, 0), cA + kstep, voffA); PG8_STAGE(PG8_SB(1, 1), cB + hstep + kstep, voffB);
        PG8_WAIT_V(6); PG8_BAR;
    } else {
        PG8_STAGE(PG8_SB(0, 0), cB, voffB); PG8_STAGE(PG8_SA(0, 0), cA, voffA); PG8_STAGE(PG8_SB(0, 1), cB + hstep, voffB); PG8_STAGE(PG8_SA(0, 1), cA + hstep, voffA);
        if (wr == 1) PG8_BAR;
        PG8_WAIT_V(4); PG8_BAR;
        PG8_STAGE(PG8_SB(1, 0), cB + kstep, voffB); PG8_STAGE(PG8_SA(1, 0), cA + kstep, voffA); PG8_STAGE(PG8_SB(1, 1), cB + hstep + kstep, voffB);
        PG8_WAIT_V(6); PG8_BAR;
    }
    for (;;) {
        const bool has_next = S.next(ui + 1, nxt);
        const char* nA = has_next ? (const char*)g.A + (size_t)nxt.pm * tstep : cA; const char* nB = has_next ? (const char*)g.Bt + (size_t)nxt.pn * tstep : cB;
        for (int t = 0; t < nt; t += 2) {
            const bool last = (t == nt - 2);
            const char* a1 = cA + (size_t)(t + 1) * kstep;
            const char* a2 = last ? nA : cA + (size_t)(t + 2) * kstep; const char* b2 = last ? nB : cB + (size_t)(t + 2) * kstep;
            const char* a3 = a2 + kstep; const char* b3 = b2 + kstep;
            if (last && has_next) S.a_ready(nxt);
            if constexpr (SP2) {
            PG8_LDB(B0, 0, 0); PG8_LDB(B1, 0, 1); PG8_SCHED; PG8_LDA(At, 0, 0); PG8_STAGE(PG8_SA(1, 1), a1 + hstep, voffA);
            PG8_WAIT_V(8); PG8_WAIT_L(0); PG8_BAR; PG8_MMA(0, 0, At, B0); PG8_MMA(0, 1, At, B1); PG8_BAR; PG8_SCHED;
            PG8_LDA(At, 0, 1); PG8_STAGE(PG8_SB(0, 0), b2, voffB); PG8_STAGE(PG8_SB(0, 1), b2 + hstep, voffB); PG8_STAGE(PG8_SA(0, 0), a2, voffA);
            PG8_WAIT_V(8); PG8_WAIT_L(0); PG8_BAR; PG8_MMA(1, 0, At, B0); PG8_MMA(1, 1, At, B1); PG8_BAR; PG8_SCHED;
            PG8_LDB(B0, 1, 0); PG8_LDB(B1, 1, 1); PG8_SCHED; PG8_LDA(At, 1, 0); PG8_STAGE(PG8_SA(0, 1), a2 + hstep, voffA);
            PG8_WAIT_V(8); PG8_WAIT_L(0); PG8_BAR; PG8_MMA(0, 0, At, B0); PG8_MMA(0, 1, At, B1); PG8_BAR; PG8_SCHED;
            PG8_LDA(At, 1, 1); PG8_STAGE(PG8_SB(1, 0), b3, voffB); PG8_STAGE(PG8_SB(1, 1), b3 + hstep, voffB); PG8_STAGE(PG8_SA(1, 0), a3, voffA);
            PG8_WAIT_V(8); PG8_WAIT_L(0); PG8_BAR; PG8_MMA(1, 0, At, B0); PG8_MMA(1, 1, At, B1); PG8_BAR; PG8_SCHED;
            } else {
            PG8_LDB(B0, 0, 0); PG8_SCHED; PG8_LDA(At, 0, 0); PG8_STAGE(PG8_SA(1, 1), a1 + hstep, voffA);
            PG8_WAIT_L(8); PG8_BAR; PG8_WAIT_L(0); PG8_MMA(0, 0, At, B0); PG8_BAR; PG8_SCHED;
            PG8_LDB(B1, 0, 1); PG8_STAGE(PG8_SB(0, 0), b2, voffB);
            PG8_BAR; PG8_WAIT_L(0); PG8_MMA(0, 1, At, B1); PG8_BAR;
            PG8_LDA(At, 0, 1); PG8_STAGE(PG8_SA(0, 0), a2, voffA);
            PG8_BAR; PG8_WAIT_L(0); PG8_MMA(1, 0, At, B0); PG8_BAR; PG8_SCHED;
            PG8_STAGE(PG8_SB(0, 1), b2 + hstep, voffB);
            PG8_WAIT_V(6); PG8_BAR; PG8_MMA(1, 1, At, B1); PG8_BAR;
            PG8_LDB(B0, 1, 0); PG8_SCHED; PG8_LDA(At, 1, 0); PG8_STAGE(PG8_SA(0, 1), a2 + hstep, voffA);
            PG8_WAIT_L(8); PG8_BAR; PG8_WAIT_L(0); PG8_MMA(0, 0, At, B0); PG8_BAR; PG8_SCHED;
            PG8_LDB(B1, 1, 1); PG8_STAGE(PG8_SB(1, 0), b3, voffB);
            PG8_BAR; PG8_WAIT_L(0); PG8_MMA(0, 1, At, B1); PG8_BAR;
            PG8_LDA(At, 1, 1); PG8_STAGE(PG8_SA(1, 0), a3, voffA);
            PG8_BAR; PG8_WAIT_L(0); PG8_MMA(1, 0, At, B0); PG8_BAR; PG8_SCHED;
            PG8_STAGE(PG8_SB(1, 1), b3 + hstep, voffB);
            PG8_WAIT_V(6); PG8_BAR; PG8_MMA(1, 1, At, B1); PG8_BAR;
            }
        }
        if constexpr (ALIGN_EPI) { if (wr == 0) PG8_BAR; }
        if constexpr (!Epi::AFTER_DRAIN) { E(acc, cur, wr, wc, fr, fq); S.done(cur); }
        if (!has_next) break;
#pragma unroll
        for (int a = 0; a < 2; ++a)
#pragma unroll
            for (int b = 0; b < 2; ++b)
#pragma unroll
                for (int m = 0; m < 4; ++m)
#pragma unroll
                    for (int n = 0; n < 2; ++n) acc[a][b][m][n] = (f32x4){0.f, 0.f, 0.f, 0.f};
        cur = nxt; cA = nA; cB = nB; ++ui;
        if constexpr (ALIGN_EPI) { if (wr == 1) PG8_BAR; }
    }
    PG8_WAIT_V(0);
    if constexpr (!ALIGN_EPI) { if (wr == 0) PG8_BAR; }
    PG8_BAR;
    if constexpr (Epi::AFTER_DRAIN) { E.fused(acc, cur, wr, wc, fr, fq, lds, wid, lane); S.done(cur); }
#undef PG8_SA
#undef PG8_SB
#undef PG8_STAGE
#undef PG8_LDA
#undef PG8_LDB
#undef PG8_MMA
#undef PG8_WAIT_V
#undef PG8_WAIT_L
#undef PG8_BAR
#undef PG8_SCHED
}
}
#define GAS __attribute__((address_space(1)))
#define LAS __attribute__((address_space(3)))
typedef unsigned short bf16;
typedef unsigned v4u __attribute__((ext_vector_type(4)));
typedef float f32x4 __attribute__((ext_vector_type(4)));
typedef short bf16x8 __attribute__((ext_vector_type(8)));
typedef GAS unsigned gu32;
typedef GAS unsigned long long gu64;
#define RLX_AGENT __ATOMIC_RELAXED, __HIP_MEMORY_SCOPE_AGENT
#define LDS_WAIT() asm volatile("s_waitcnt lgkmcnt(0)" ::: "memory")
#define VM_WAIT() asm volatile("s_waitcnt vmcnt(0)" ::: "memory")
__device__ __forceinline__ unsigned long long rt() { return __builtin_amdgcn_s_memrealtime(); }
__device__ __forceinline__ unsigned f2bf(float f) { unsigned u = __builtin_bit_cast(unsigned, f); return (u + 0x7fffu + ((u >> 16) & 1u)) >> 16; }
__device__ __forceinline__ unsigned pk2(float lo, float hi) { return f2bf(lo) | (f2bf(hi) << 16); }

#define XB_TMO      128
#define XB_XCNT(j)  (256  + 64 * (j))
#define XB_XSUB(j)  (1280 + 64 * (j))
#define XB_XGEN(j)  (2304 + 64 * (j))
#define XB_TOP      3328
#define XB_TOPGEN   3392
#define XCD_BAR_WORDS 3456
#define XB_SPIN_CAP (1u << 18)

__device__ __forceinline__ unsigned xb_ld(unsigned* p)              { return __hip_atomic_load(p, __ATOMIC_RELAXED, __HIP_MEMORY_SCOPE_AGENT); }
__device__ __forceinline__ unsigned xb_add(unsigned* p, unsigned v) { return __hip_atomic_fetch_add(p, v, __ATOMIC_RELAXED, __HIP_MEMORY_SCOPE_AGENT); }
__device__ __forceinline__ unsigned xb_xcc_id() { return (unsigned)__builtin_amdgcn_s_getreg((3 << 11) | 20) & 0xFu; }
#define XB_SPIN(cond, bar) do { unsigned _sp = 0; while (cond) { __builtin_amdgcn_s_sleep(1); \
    if ((++_sp & 255u) == 0u) { if (xb_ld(&(bar)[XB_TMO])) break; if (_sp > XB_SPIN_CAP) { atomicAdd(&(bar)[XB_TMO], 1u); break; } } } } while (0)

struct XcdBarrier {
    unsigned* bar; unsigned x;
    volatile LAS unsigned* st;
};

__device__ __forceinline__ XcdBarrier xcd_barrier_post(unsigned* bar, volatile LAS unsigned* st) {
    XcdBarrier b; b.bar = bar; b.x = xb_xcc_id(); b.st = st;
    if (threadIdx.x == 0) (void)xb_add(&bar[XB_XCNT(b.x)], 1u);
    return b;
}
__device__ __forceinline__ void xcd_barrier_complete(unsigned* bar, unsigned x, unsigned& nloc, unsigned& nx) {
    const unsigned G = gridDim.x * gridDim.y * gridDim.z;
    unsigned sum, cnt, mine, sp = 0u;
    for (;;) {
        sum = 0u; cnt = 0u; mine = 0u;
#pragma unroll
        for (unsigned j = 0; j < 16; ++j) { const unsigned c = xb_ld(&bar[XB_XCNT(j)]); sum += c; cnt += (c > 0u) ? 1u : 0u; mine = (j == x) ? c : mine; }
        if (sum == G) break;
        __builtin_amdgcn_s_sleep(1);
        if ((++sp & 255u) == 0u) { if (xb_ld(&bar[XB_TMO])) break; if (sp > XB_SPIN_CAP) { atomicAdd(&bar[XB_TMO], 1u); break; } }
    }
    nloc = mine > 0u ? mine : 1u; nx = cnt > 0u ? cnt : 1u;
}

__device__ __forceinline__ void xcd_barrier(const XcdBarrier& b) {
    asm volatile("s_waitcnt vmcnt(0)" ::: "memory");
    __syncthreads();
    if (threadIdx.x == 0) {
        unsigned* bar = b.bar;
        __builtin_amdgcn_s_waitcnt(0);
        unsigned nloc = b.st[0], nx = b.st[1];
        if (nloc == 0u) { xcd_barrier_complete(bar, b.x, nloc, nx); b.st[0] = nloc; b.st[1] = nx; }
        const unsigned old = xb_add(&bar[XB_XSUB(b.x)], 1u);
        const unsigned gen = old / nloc;
        if (old + 1u == (gen + 1u) * nloc) {
            __builtin_amdgcn_fence(__ATOMIC_RELEASE, "agent");
            asm volatile("s_waitcnt vmcnt(0)" ::: "memory");
            const unsigned og = xb_add(&bar[XB_TOP], 1u);
            const unsigned tg = og / nx;
            if (og + 1u == (tg + 1u) * nx) xb_add(&bar[XB_TOPGEN], 1u);
            else XB_SPIN(xb_ld(&bar[XB_TOPGEN]) == tg, bar);
            __builtin_amdgcn_fence(__ATOMIC_ACQUIRE, "agent");
            xb_add(&bar[XB_XGEN(b.x)], 1u);
            asm volatile("s_waitcnt vmcnt(0)" ::: "memory");
        } else {
            XB_SPIN(xb_ld(&bar[XB_XGEN(b.x)]) == gen, bar);
            __builtin_amdgcn_fence(__ATOMIC_ACQUIRE, "agent");
            asm volatile("s_waitcnt vmcnt(0)" ::: "memory");
        }
    }
    __syncthreads();
}
constexpr int NWAVES = 8, NT = NWAVES * 64;
constexpr int DM = 1024, NB_P = 8, SEQ = 2048, NB_S = 128, LS = 8;
constexpr int MP = NB_P * SEQ, MS = NB_S * LS, M = MP + MS;
constexpr int NSEQ = NB_P + NB_S;
constexpr int IN_DIM = 6688, IN_PAD = 6912, PITCH = IN_DIM;
constexpr int PC_Z = 0, PC_XBC = 1024, PC_QKV = 2560, PC_GATE = 5632, PC_DT = 6656, PC_BETA = 6672, PC_ALPHA = 6680;
constexpr int DMIX = 2048, DFF = 2816, NGU = 2 * DFF, NMOD = 6 * DM;
constexpr int SSD_H = 16, SSD_P = 64, SSD_N = 128, SSD_CONV = 1536, GDN_H = 8, GDN_D = 128, GDN_CONV = 3072;
constexpr float EPS = 1e-6f;
constexpr size_t OFF_Y = 0, OFF_SSD_P = (size_t)M * DM, OFF_SSDC_P = OFF_SSD_P + (size_t)NB_P * SSD_H * SSD_P * SSD_N, OFF_GDN_P = OFF_SSDC_P + (size_t)NB_P * 3 * SSD_CONV,
                 OFF_GDNC_P = OFF_GDN_P + (size_t)NB_P * GDN_H * GDN_D * GDN_D, OFF_SSD_S = OFF_GDNC_P + (size_t)NB_P * 3 * GDN_CONV, OFF_SSDC_S = OFF_SSD_S + (size_t)NB_S * SSD_H * SSD_P * SSD_N,
                 OFF_GDN_S = OFF_SSDC_S + (size_t)NB_S * 3 * SSD_CONV, OFF_GDNC_S = OFF_GDN_S + (size_t)NB_S * GDN_H * GDN_D * GDN_D, OUT_TOTAL = OFF_GDNC_S + (size_t)NB_S * 3 * GDN_CONV;
static_assert(OUT_TOTAL == 55357440, "output size");
constexpr size_t MiB = 1u << 20;
constexpr size_t WS_CTL = 0, CTL_ZERO_BYTES = 1 * MiB;
constexpr size_t WS_WOUT = 1 * MiB, WS_WGU = 5 * MiB, WS_WDN = 16 * MiB, WS_MOD = 22 * MiB, WS_SSQ = 26 * MiB, WS_PROJ = 28 * MiB;
constexpr size_t PROJ_BYTES = (size_t)M * PITCH * 2;
constexpr size_t WS_T1 = WS_PROJ, WS_XN2 = WS_PROJ + 68 * MiB, WS_ACT = WS_PROJ + 102 * MiB, WS_T2 = WS_PROJ;
constexpr size_t WS_END = 251 * MiB;
static_assert(WS_WOUT + (size_t)DM * DMIX * 2 <= WS_WGU && WS_WGU + (size_t)NGU * DM * 2 <= WS_WDN && WS_WDN + (size_t)DM * DFF * 2 <= WS_MOD && WS_MOD + (size_t)NSEQ * NMOD * 4 <= WS_SSQ && WS_SSQ + (size_t)M * 16 * 4 <= WS_PROJ, "ws map");
static_assert(WS_PROJ + PROJ_BYTES <= WS_END && (size_t)M * DM * 4 <= 68 * MiB && (size_t)M * DM * 2 <= 34 * MiB && WS_ACT + (size_t)M * DFF * 2 <= WS_PROJ + PROJ_BYTES, "ws overlays");
static_assert((size_t)IN_PAD * DM * 2 <= (size_t)NB_S * SSD_H * SSD_P * SSD_N * 4 && (size_t)M * DM * 2 <= (size_t)NB_S * GDN_H * GDN_D * GDN_D * 4 && (size_t)M * DMIX * 2 == (size_t)M * DM * 4, "d_out scratch");
constexpr int CW_TMO = 0, CW_CODE = 1, CW_QUEUE = 64, CW_BAR = 4096;
constexpr int RING_OFF = 0, RING_BYTES = 131072, LDS_BYTES = 147456, LDSCTL_OFF = LDS_BYTES - 1024, MISC_OFF = LDSCTL_OFF + 320;
struct Args { const float* in[28]; float* out; unsigned char* ws; int ph_lo, ph_hi, li, pad; };
enum { I_XP = 0, I_XS, I_CP, I_CS, I_SSD, I_SSDC, I_GDN, I_GDNC, I_WADA, I_BADA, I_NMPRE, I_NMPOST, I_NFPRE, I_NFPOST, I_WIN, I_SCW, I_SCB, I_SDTB, I_SALOG, I_SD, I_SNW, I_GCW, I_GDTB, I_GALOG, I_GNW, I_WOUT, I_WGU, I_WDN };
__device__ __forceinline__ float bf2f(unsigned v) { return __uint_as_float(v << 16); }
__device__ __forceinline__ float silu_acc(float x) { return x / (1.f + expf(-x)); }
__device__ __forceinline__ float softplus_acc(float x) { return fmaxf(x, 0.f) + log1pf(expf(-fabsf(x))); }
__device__ __forceinline__ float wave_sum(float v) {
#pragma unroll
    for (int o = 1; o < 64; o <<= 1) v += __shfl_xor(v, o);
    return v;
}
__device__ __forceinline__ bf16* ws_bf(const Args& a, size_t off) { return (bf16*)(a.ws + off); }
__device__ __forceinline__ float* ws_f(const Args& a, size_t off) { return (float*)(a.ws + off); }
__device__ __forceinline__ bf16* win_t(const Args& a) { return (bf16*)(a.out + OFF_SSD_S); }
__device__ __forceinline__ bf16* xn_buf(const Args& a) { return (bf16*)(a.out + OFF_GDN_S); }
__device__ __forceinline__ bf16* mixed_buf(const Args& a) { return (bf16*)(a.out + OFF_Y); }
__device__ __forceinline__ const float* x_row(const Args& a, int row) { return row < MP ? a.in[I_XP] + (size_t)row * DM : a.in[I_XS] + (size_t)(row - MP) * DM; }
__device__ __forceinline__ int seq_of_row(int row) { return row < MP ? (row >> 11) : NB_P + ((row - MP) >> 3); }

__device__ __forceinline__ int dest_row(int which, int n) {
    if (which == 1) { if (n < 2560) return n; if (n < 2576) return PC_DT + (n - 2560); if (n < 6672) return n - 16; return n; }
    if (which == 2) { const int j = n < DFF ? n : n - DFF; return 256 * (j >> 7) + (n < DFF ? 0 : 128) + (j & 127); }
    return n;
}
__device__ __forceinline__ void p0_transpose_item(const float* W, int K, int N, bf16* WT, int which, LAS float* scr, int item, int lane) {
    const int nblk = N / 32, kb = item / nblk, nb = item % nblk, k0 = 64 * kb, n0 = 32 * nb;
#pragma unroll 8
    for (int i = 0; i < 32; ++i) { const int kk = 2 * i + (lane >> 5); scr[kk * 33 + (lane & 31)] = W[(size_t)(k0 + kk) * N + n0 + (lane & 31)]; }
    LDS_WAIT(); asm volatile("" ::: "memory");
    const int c = lane & 7;
#pragma unroll
    for (int j = 0; j < 4; ++j) { const int n = (lane >> 3) + 8 * j; const LAS float* s = scr + (8 * c) * 33 + n;
        v4u o; o.x = pk2(s[0 * 33], s[1 * 33]); o.y = pk2(s[2 * 33], s[3 * 33]); o.z = pk2(s[4 * 33], s[5 * 33]); o.w = pk2(s[6 * 33], s[7 * 33]);
        *(GAS v4u*)(WT + (size_t)dest_row(which, n0 + n) * K + k0 + 8 * c) = o; }
    LDS_WAIT(); asm volatile("" ::: "memory");
}
constexpr int TI_IN = (DM / 64) * (IN_DIM / 32), TI_OUT = (DMIX / 64) * (DM / 32), TI_GU = (DM / 64) * (NGU / 32), TI_DN = (DFF / 64) * (DM / 32), TI_PAD = IN_PAD - IN_DIM;
constexpr int TI_ALL = TI_IN + TI_OUT + TI_GU + TI_DN + TI_PAD;
constexpr int ADA_RB = 17, ADA_ITEMS = (NSEQ / ADA_RB) * (NMOD / 512);
static_assert(NSEQ % ADA_RB == 0 && IN_DIM % 32 == 0 && NGU % 32 == 0 && DFF % 64 == 0, "P0 tiling");
__device__ __forceinline__ void p0_ada_item(const Args& a, LAS unsigned char* lds, int it, int tid, int wave, int lane) {
    LAS float* cs = (LAS float*)lds;
    const int rb = it / (NMOD / 512), cb = it % (NMOD / 512);
    for (int idx = tid; idx < ADA_RB * DM; idx += NT) { const int r = idx >> 10, k = idx & 1023, row = ADA_RB * rb + r;
        const float c = row < NB_P ? a.in[I_CP][row * DM + k] : a.in[I_CS][(row - NB_P) * DM + k]; cs[idx] = silu_acc(c); }
    __syncthreads();
    const int n = 512 * cb + 64 * wave + lane;
    const float* wp = a.in[I_WADA] + n;
    float acc[ADA_RB];
#pragma unroll
    for (int r = 0; r < ADA_RB; ++r) acc[r] = 0.f;
    for (int k = 0; k < DM; k += 4) {
        const float w0 = wp[(size_t)(k + 0) * NMOD], w1 = wp[(size_t)(k + 1) * NMOD], w2 = wp[(size_t)(k + 2) * NMOD], w3 = wp[(size_t)(k + 3) * NMOD];
#pragma unroll
        for (int r = 0; r < ADA_RB; ++r) { const f32x4 c4 = *(const LAS f32x4*)(cs + r * DM + k); acc[r] += c4.x * w0; acc[r] += c4.y * w1; acc[r] += c4.z * w2; acc[r] += c4.w * w3; }
    }
    float* mod = ws_f(a, WS_MOD); const float b = a.in[I_BADA][n];
#pragma unroll
    for (int r = 0; r < ADA_RB; ++r) mod[(size_t)(ADA_RB * rb + r) * NMOD + n] = acc[r] + b;
    __syncthreads();
}
__device__ __forceinline__ void p0_prologue(const Args& a, LAS unsigned char* lds, int bid, int G, int tid, int wave, int lane) {
    const bool split = G > 128;
    const int ada_lo = 0, ada_G = split ? ADA_ITEMS : G;
    if (!split || bid < ADA_ITEMS) for (int it = bid - ada_lo; it < ADA_ITEMS; it += ada_G) p0_ada_item(a, lds, it, tid, wave, lane);
    if (!split || bid >= ADA_ITEMS) {
        LAS float* scr = (LAS float*)(lds + wave * 16384);
        const int gw = (split ? bid - ADA_ITEMS : bid) * NWAVES + wave, NGW = (split ? G - ADA_ITEMS : G) * NWAVES;
        for (int it = gw; it < TI_ALL; it += NGW) {
            int r = it;
            if (r < TI_IN) { p0_transpose_item(a.in[I_WIN], DM, IN_DIM, win_t(a), 1, scr, r, lane); continue; } r -= TI_IN;
            if (r < TI_OUT) { p0_transpose_item(a.in[I_WOUT], DMIX, DM, ws_bf(a, WS_WOUT), 0, scr, r, lane); continue; } r -= TI_OUT;
            if (r < TI_GU) { p0_transpose_item(a.in[I_WGU], DM, NGU, ws_bf(a, WS_WGU), 2, scr, r, lane); continue; } r -= TI_GU;
            if (r < TI_DN) { p0_transpose_item(a.in[I_WDN], DFF, DM, ws_bf(a, WS_WDN), 0, scr, r, lane); continue; } r -= TI_DN;
            { GAS v4u* o = (GAS v4u*)(win_t(a) + (size_t)(IN_DIM + r) * DM) + lane; o[0] = (v4u){0u, 0u, 0u, 0u}; o[64] = (v4u){0u, 0u, 0u, 0u}; }
        }
    }
}
__device__ __forceinline__ void p1_xn(const Args& a, int gw, int NGW, int lane) {
    const float* mod = ws_f(a, WS_MOD); bf16* XN = xn_buf(a); const float* nw = a.in[I_NMPRE];
    for (int row = gw; row < M; row += NGW) {
        const f32x4* xr = (const f32x4*)x_row(a, row) + lane; const float* mr = mod + (size_t)seq_of_row(row) * NMOD;
        f32x4 v[4]; float s = 0.f;
#pragma unroll
        for (int j = 0; j < 4; ++j) { v[j] = xr[64 * j]; s += (v[j].x * v[j].x + v[j].y * v[j].y) + (v[j].z * v[j].z + v[j].w * v[j].w); }
        const float rs = 1.f / sqrtf(wave_sum(s) * (1.f / DM) + EPS);
        unsigned long long* o8 = (unsigned long long*)(XN + (size_t)row * DM) + lane;
#pragma unroll
        for (int j = 0; j < 4; ++j) { const int c = 4 * lane + 256 * j; const f32x4 w = *(const f32x4*)(nw + c), sh = *(const f32x4*)(mr + c), sc = *(const f32x4*)(mr + DM + c);
            const f32x4 h = v[j] * rs * w * (sc + 1.f) + sh;
            o8[64 * j] = (unsigned long long)pk2(h.x, h.y) | ((unsigned long long)pk2(h.z, h.w) << 32); }
    }
}
typedef short bf16x8 __attribute__((ext_vector_type(8)));
typedef unsigned u32x2 __attribute__((ext_vector_type(2)));
constexpr int P128 = 136, P64 = 72, LP = 68, TP = 36;
#define MFMA16(a, b, c) __builtin_amdgcn_mfma_f32_16x16x32_bf16(a, b, c, 0, 0, 0)
__device__ __forceinline__ bf16x8 ldfrag(const LAS bf16* base, int pitch, int row0, int k0, int lane) { return *(const LAS bf16x8*)(base + (row0 + (lane & 15)) * pitch + k0 + 8 * (lane >> 4)); }
typedef float f32x2_t __attribute__((ext_vector_type(2))); typedef __bf16 bf16x2_t __attribute__((ext_vector_type(2)));
__device__ __forceinline__ unsigned cvtpk(float lo, float hi) { f32x2_t v = {lo, hi}; bf16x2_t b = __builtin_convertvector(v, bf16x2_t); return __builtin_bit_cast(unsigned, b); }
__device__ __forceinline__ u32x2 pack4(f32x4 v) { u32x2 r; r.x = cvtpk(v[0], v[1]); r.y = cvtpk(v[2], v[3]); return r; }
__device__ __forceinline__ float silu_f(float x) { return x * __builtin_amdgcn_rcpf(1.f + __expf(-x)); }
__device__ __forceinline__ void unpack8(v4u r, float (&x)[8]) { x[0] = bf2f(r.x & 0xffffu); x[1] = __uint_as_float(r.x & 0xffff0000u); x[2] = bf2f(r.y & 0xffffu); x[3] = __uint_as_float(r.y & 0xffff0000u);
    x[4] = bf2f(r.z & 0xffffu); x[5] = __uint_as_float(r.z & 0xffff0000u); x[6] = bf2f(r.w & 0xffffu); x[7] = __uint_as_float(r.w & 0xffff0000u); }
__device__ __forceinline__ v4u tpack(const unsigned (&outp)[8][4], int c) { const int cp = c >> 1; const unsigned sel = (c & 1) ? 0x07060302u : 0x05040100u; v4u o;
    o.x = __builtin_amdgcn_perm(outp[1][cp], outp[0][cp], sel); o.y = __builtin_amdgcn_perm(outp[3][cp], outp[2][cp], sel); o.z = __builtin_amdgcn_perm(outp[5][cp], outp[4][cp], sel); o.w = __builtin_amdgcn_perm(outp[7][cp], outp[6][cp], sel); return o; }
__device__ __forceinline__ void conv8x8(const v4u (&R)[11], const float (&cw)[4][8], const float (&cb)[8], unsigned (&outp)[8][4], float (&ssq)[8]) {
    float acc[4][8];
#pragma unroll
    for (int i = 0; i < 11; ++i) { float x[8]; unpack8(R[i], x);
#pragma unroll
        for (int j = 0; j < 4; ++j) { const int l = i - j;
            if (l >= 0 && l < 8) {
#pragma unroll
                for (int c = 0; c < 8; ++c) acc[l & 3][c] = (j == 0 ? cb[c] : acc[l & 3][c]) + cw[j][c] * x[c]; } }
        if (i >= 3) { const int l = i - 3; float s = 0.f;
#pragma unroll
            for (int c = 0; c < 8; ++c) { acc[l & 3][c] = silu_f(acc[l & 3][c]); s += acc[l & 3][c] * acc[l & 3][c]; }
            ssq[l] = s;
#pragma unroll
            for (int cp = 0; cp < 4; ++cp) outp[l][cp] = cvtpk(acc[l & 3][2 * cp], acc[l & 3][2 * cp + 1]); } }
}
__device__ __forceinline__ void lower_pair(int p, int& i, int& j) { i = p >= 6 ? 3 : (p >= 3 ? 2 : (p >= 1 ? 1 : 0)); j = p - (i * (i + 1)) / 2; }
__device__ __forceinline__ void upper_pair(int z, int& i, int& j) { i = z >= 5 ? 2 : (z >= 3 ? 1 : 0); j = z >= 5 ? 3 : (z >= 3 ? z - 1 : z + 1); }
__device__ __forceinline__ void tri_inverse64(LAS float* Lm, LAS float* tmp, int wave, int lane) {
    const int c = lane & 15, q = lane >> 4;
    if (wave == 0) {
        LAS float* Lb = Lm + (16 * q) * LP + 16 * q; float t[16];
#pragma unroll
        for (int l = 0; l < 16; ++l) { float acc = (l == c) ? 1.f : 0.f;
#pragma unroll
            for (int s = 0; s < l; ++s) acc -= Lb[l * LP + s] * t[s];
            t[l] = acc; }
#pragma unroll
        for (int l = 0; l < 16; ++l) Lb[l * LP + c] = t[l];
    }
    __syncthreads();
    if (wave < 2) {
        const int o = 32 * wave; f32x4 acc = (f32x4){0.f, 0.f, 0.f, 0.f};
#pragma unroll
        for (int kk = 0; kk < 4; ++kk) acc = __builtin_amdgcn_mfma_f32_16x16x4f32(Lm[(o + 16 + c) * LP + o + 4 * kk + q], Lm[(o + 4 * kk + q) * LP + o + c], acc, 0, 0, 0);
#pragma unroll
        for (int r = 0; r < 4; ++r) tmp[(16 * wave + 4 * q + r) * TP + c] = acc[r];
    }
    __syncthreads();
    if (wave < 2) {
        const int o = 32 * wave; f32x4 acc = (f32x4){0.f, 0.f, 0.f, 0.f};
#pragma unroll
        for (int kk = 0; kk < 4; ++kk) acc = __builtin_amdgcn_mfma_f32_16x16x4f32(Lm[(o + 16 + c) * LP + o + 16 + 4 * kk + q], tmp[(16 * wave + 4 * kk + q) * TP + c], acc, 0, 0, 0);
#pragma unroll
        for (int r = 0; r < 4; ++r) Lm[(o + 16 + 4 * q + r) * LP + o + c] = -acc[r];
    }
    __syncthreads();
    if (wave < 4) {
        const int ti = wave >> 1, tj = wave & 1; f32x4 acc = (f32x4){0.f, 0.f, 0.f, 0.f};
#pragma unroll
        for (int kk = 0; kk < 8; ++kk) acc = __builtin_amdgcn_mfma_f32_16x16x4f32(Lm[(32 + 16 * ti + c) * LP + 4 * kk + q], Lm[(4 * kk + q) * LP + 16 * tj + c], acc, 0, 0, 0);
#pragma unroll
        for (int r = 0; r < 4; ++r) tmp[(16 * ti + 4 * q + r) * TP + 16 * tj + c] = acc[r];
    }
    __syncthreads();
    if (wave < 4) {
        const int ti = wave >> 1, tj = wave & 1; f32x4 acc = (f32x4){0.f, 0.f, 0.f, 0.f};
#pragma unroll
        for (int kk = 0; kk < 8; ++kk) acc = __builtin_amdgcn_mfma_f32_16x16x4f32(Lm[(32 + 16 * ti + c) * LP + 32 + 4 * kk + q], tmp[(4 * kk + q) * TP + 16 * tj + c], acc, 0, 0, 0);
#pragma unroll
        for (int r = 0; r < 4; ++r) Lm[(32 + 16 * ti + 4 * q + r) * LP + 16 * tj + c] = -acc[r];
    }
    __syncthreads();
}
constexpr int G_Q = 0, G_T1 = 0, G_T2 = 9216, G_K = 18432, G_W = 18432, G_KT = 35840, G_VT = 54272, G_VN = 54272, G_L = 72704, G_VNS = 72704, G_PART = 72704, G_ATT = 91136, G_TMP = 100352, G_ST = 104960, G_VEC = 139776;
static_assert(G_VEC + 11 * 256 <= LDSCTL_OFF, "GDN LDS map");
__device__ __forceinline__ void gdn_chunk_item(const Args& a, LAS unsigned char* lds, int b, int h, int tid_, int wave, int lane_) {
    const bf16* proj = ws_bf(a, WS_PROJ); bf16* mixed = mixed_buf(a);
    const int row0 = b * SEQ;
    LAS bf16* Lq = (LAS bf16*)(lds + G_Q); LAS bf16* Lk = (LAS bf16*)(lds + G_K); LAS bf16* LkT = (LAS bf16*)(lds + G_KT); LAS bf16* LvT = (LAS bf16*)(lds + G_VT);
    LAS bf16* LT1 = (LAS bf16*)(lds + G_T1); LAS bf16* LT2 = (LAS bf16*)(lds + G_T2); LAS bf16* LW = (LAS bf16*)(lds + G_W); LAS bf16* Lvn = (LAS bf16*)(lds + G_VN); LAS bf16* Lvns = (LAS bf16*)(lds + G_VNS);
    LAS bf16* Latt = (LAS bf16*)(lds + G_ATT); LAS bf16* LST = (LAS bf16*)(lds + G_ST); LAS float* LL = (LAS float*)(lds + G_L); LAS float* Ltmp = (LAS float*)(lds + G_TMP); LAS float* Lpart = (LAS float*)(lds + G_PART);
    LAS float* vgc = (LAS float*)(lds + G_VEC); LAS float* vbeta = vgc + 64; LAS float* vrq = vgc + 128; LAS float* vrk = vgc + 192; LAS float* vqs = vgc + 256; LAS float* vvsc = vgc + 320; LAS float* vt2s = vgc + 384; LAS float* vossq = vgc + 448; LAS float* vmisc = vgc + 576;
    const float Ag = -expf(a.in[I_GALOG][h]), dtb = a.in[I_GDTB][h];
    const float cb[8] = {0.f, 0.f, 0.f, 0.f, 0.f, 0.f, 0.f, 0.f};
    f32x4 Sacc[4][2];
#pragma unroll
    for (int x = 0; x < 4; ++x)
#pragma unroll
        for (int d = 0; d < 2; ++d) Sacc[x][d] = (f32x4){0.f, 0.f, 0.f, 0.f};
    for (int i = tid_; i < 128 * P128 / 2; i += NT) ((LAS unsigned*)LST)[i] = 0u;
    const int li = wave >> 1, dvh = wave & 1;
    for (int ch = 0; ch < SEQ / 64; ++ch) {
        const int t0 = 64 * ch;
        int lane = lane_;
        asm volatile("" : "+v"(lane));
        const int tid = wave * 64 + lane, c16 = lane & 15, q4 = lane >> 4, oct = tid % 48, tg = tid / 48, seg = oct >> 4, c0 = 8 * (oct & 15);
        if (tid < 384) {
            v4u R[11]; const bf16* src = (proj + (size_t)(row0 + t0 - 3) * PITCH + PC_QKV + h * 128) + (unsigned)(8 * tg * PITCH + seg * 1024 + c0);
#pragma unroll
            for (int i = 0; i < 11; ++i) R[i] = (t0 + 8 * tg - 3 + i >= 0) ? *(const v4u*)(src + (size_t)i * PITCH) : (v4u){0u, 0u, 0u, 0u};
            float cw[4][8];
#pragma unroll
            for (int j = 0; j < 4; ++j) { const f32x4 w0 = *(const f32x4*)(a.in[I_GCW] + j * GDN_CONV + seg * 1024 + h * 128 + c0), w1 = *(const f32x4*)(a.in[I_GCW] + j * GDN_CONV + seg * 1024 + h * 128 + c0 + 4);
                cw[j][0] = w0.x; cw[j][1] = w0.y; cw[j][2] = w0.z; cw[j][3] = w0.w; cw[j][4] = w1.x; cw[j][5] = w1.y; cw[j][6] = w1.z; cw[j][7] = w1.w; }
            unsigned outp[8][4]; float ssq[8];
            conv8x8(R, cw, cb, outp, ssq);
            if (seg < 2) { LAS bf16* dst = (seg == 0 ? Lq : Lk) + (8 * tg) * P128 + c0;
#pragma unroll
                for (int l = 0; l < 8; ++l) { *(LAS v4u*)(dst + l * P128) = (v4u){outp[l][0], outp[l][1], outp[l][2], outp[l][3]}; Lpart[(seg * 64 + 8 * tg + l) * 16 + (oct & 15)] = ssq[l]; } }
            if (seg >= 1) { LAS bf16* dst = (seg == 1 ? LkT : LvT) + c0 * P64 + 8 * tg;
#pragma unroll
                for (int c = 0; c < 8; ++c) *(LAS v4u*)(dst + c * P64) = tpack(outp, c); }
        } else if (wave == 6) {
            const size_t r = (size_t)(row0 + t0 + lane) * PITCH;
            const float g = Ag * softplus_acc(bf2f(proj[r + PC_ALPHA + h]) + dtb), be = 1.f / (1.f + __expf(-bf2f(proj[r + PC_BETA + h])));
            float gc = g;
#pragma unroll
            for (int d = 1; d < 64; d <<= 1) { const float v = __shfl_up(gc, d); if (lane >= d) gc += v; }
            vgc[lane] = gc; vbeta[lane] = be;
        }
        __syncthreads();
        if (tid < 64) { float sq = 0.f, sk = 0.f;
#pragma unroll
            for (int o = 0; o < 16; ++o) { sq += Lpart[tid * 16 + o]; sk += Lpart[(64 + tid) * 16 + o]; }
            const float rq = 1.f / sqrtf(sq + 1e-6f), rk = 1.f / sqrtf(sk + 1e-6f), gc = vgc[tid], gl = vgc[63], be = vbeta[tid];
            vrq[tid] = rq; vrk[tid] = rk; vqs[tid] = __expf(gc) * rq * 0.08838834764831845f; vvsc[tid] = __expf(gl - gc) * rk; vt2s[tid] = be * __expf(gc) * rk;
            if (tid == 0) vmisc[0] = __expf(gl); }
        __syncthreads();
        f32x4 oacc[4];
#pragma unroll
        for (int tt = 0; tt < 4; ++tt) oacc[tt] = (f32x4){0.f, 0.f, 0.f, 0.f};
#pragma unroll
        for (int ks = 0; ks < 4; ++ks) { const bf16x8 qf = ldfrag(Lq, P128, 16 * li, 32 * ks, lane);
#pragma unroll
            for (int tt = 0; tt < 4; ++tt) oacc[tt] = MFMA16(ldfrag(LST, P128, 16 * (4 * dvh + tt), 32 * ks, lane), qf, oacc[tt]); }
        for (int job = wave; job < 20; job += 8) { const int type = job >= 10 ? 1 : 0; int ti, tj; lower_pair(job - 10 * type, ti, tj);
            f32x4 acc = (f32x4){0.f, 0.f, 0.f, 0.f}; const LAS bf16* Y = type ? Lq : Lk;
#pragma unroll
            for (int ks = 0; ks < 4; ++ks) acc = MFMA16(ldfrag(Lk, P128, 16 * tj, 32 * ks, lane), ldfrag(Y, P128, 16 * ti, 32 * ks, lane), acc);
            const int l = 16 * ti + c16, s0 = 16 * tj + 4 * q4; const float gcl = vgc[l]; const f32x4 gcs = *(const LAS f32x4*)(vgc + s0), rks = *(const LAS f32x4*)(vrk + s0);
            const float rowf = type ? vrq[l] * 0.08838834764831845f : vbeta[l] * vrk[l]; f32x4 val;
#pragma unroll
            for (int r = 0; r < 4; ++r) { const bool ok = type ? (s0 + r <= l) : (s0 + r < l); val[r] = ok ? acc[r] * rowf * rks[r] * __expf(gcl - gcs[r]) : 0.f; }
            if (type == 0) *(LAS f32x4*)(LL + l * LP + s0) = val; else *(LAS u32x2*)(Latt + l * P64 + s0) = pack4(val); }
        for (int z = wave; z < 12; z += 8) { int ti, tj; upper_pair(z >= 6 ? z - 6 : z, ti, tj); const int l = 16 * ti + c16, s0 = 16 * tj + 4 * q4;
            if (z < 6) *(LAS f32x4*)(LL + l * LP + s0) = (f32x4){0.f, 0.f, 0.f, 0.f}; else *(LAS u32x2*)(Latt + l * P64 + s0) = (u32x2){0u, 0u}; }
        __syncthreads();
        tri_inverse64(LL, Ltmp, wave, lane);
        { const int l = tid >> 3, s0 = 8 * (tid & 7); const f32x4 ta = *(const LAS f32x4*)(LL + l * LP + s0), tb = *(const LAS f32x4*)(LL + l * LP + s0 + 4);
            const f32x4 ba = *(const LAS f32x4*)(vbeta + s0), bb = *(const LAS f32x4*)(vbeta + s0 + 4), sa = *(const LAS f32x4*)(vt2s + s0), sb = *(const LAS f32x4*)(vt2s + s0 + 4);
            const u32x2 p0 = pack4(ta * ba), p1 = pack4(tb * bb), r0 = pack4(ta * sa), r1 = pack4(tb * sb);
            *(LAS v4u*)(LT1 + l * P64 + s0) = (v4u){p0.x, p0.y, p1.x, p1.y}; *(LAS v4u*)(LT2 + l * P64 + s0) = (v4u){r0.x, r0.y, r1.x, r1.y}; }
        __syncthreads();
        f32x4 uacc[4], wacc[4];
#pragma unroll
        for (int lt = 0; lt < 4; ++lt) { uacc[lt] = (f32x4){0.f, 0.f, 0.f, 0.f}; wacc[lt] = (f32x4){0.f, 0.f, 0.f, 0.f}; }
#pragma unroll
        for (int ks = 0; ks < 2; ++ks) { const bf16x8 vf = ldfrag(LvT, P64, 16 * wave, 32 * ks, lane), kf = ldfrag(LkT, P64, 16 * wave, 32 * ks, lane);
#pragma unroll
            for (int lt = 2 * ks; lt < 4; ++lt) { uacc[lt] = MFMA16(ldfrag(LT1, P64, 16 * lt, 32 * ks, lane), vf, uacc[lt]); wacc[lt] = MFMA16(kf, ldfrag(LT2, P64, 16 * lt, 32 * ks, lane), wacc[lt]); } }
#pragma unroll
        for (int lt = 0; lt < 4; ++lt) *(LAS u32x2*)(LW + (16 * lt + c16) * P128 + 16 * wave + 4 * q4) = pack4(wacc[lt]);
        __syncthreads();
        {
            f32x4 ws[4];
#pragma unroll
            for (int lt = 0; lt < 4; ++lt) ws[lt] = (f32x4){0.f, 0.f, 0.f, 0.f};
#pragma unroll
            for (int ks = 0; ks < 4; ++ks) { const bf16x8 sf = ldfrag(LST, P128, 16 * wave, 32 * ks, lane);
#pragma unroll
                for (int lt = 0; lt < 4; ++lt) ws[lt] = MFMA16(ldfrag(LW, P128, 16 * lt, 32 * ks, lane), sf, ws[lt]); }
#pragma unroll
            for (int lt = 0; lt < 4; ++lt) { const f32x4 vn = uacc[lt] - ws[lt]; const f32x4 sc = *(const LAS f32x4*)(vvsc + 16 * lt + 4 * q4);
                *(LAS u32x2*)(Lvn + (16 * wave + c16) * P64 + 16 * lt + 4 * q4) = pack4(vn); *(LAS u32x2*)(Lvns + (16 * wave + c16) * P64 + 16 * lt + 4 * q4) = pack4(vn * sc); }
        }
        __syncthreads();
        {
            const float ge = vmisc[0];
#pragma unroll
            for (int x = 0; x < 4; ++x)
#pragma unroll
                for (int d = 0; d < 2; ++d) Sacc[x][d] = Sacc[x][d] * ge;
#pragma unroll
            for (int ks = 0; ks < 2; ++ks) { bf16x8 kf[4];
#pragma unroll
                for (int x = 0; x < 4; ++x) kf[x] = ldfrag(LkT, P64, 16 * (4 * dvh + x), 32 * ks, lane);
#pragma unroll
                for (int d = 0; d < 2; ++d) { const bf16x8 nf = ldfrag(Lvns, P64, 16 * (2 * li + d), 32 * ks, lane);
#pragma unroll
                    for (int x = 0; x < 4; ++x) Sacc[x][d] = MFMA16(kf[x], nf, Sacc[x][d]); } }
#pragma unroll
            for (int x = 0; x < 4; ++x)
#pragma unroll
                for (int d = 0; d < 2; ++d) *(LAS u32x2*)(LST + (16 * (2 * li + d) + c16) * P128 + 16 * (4 * dvh + x) + 4 * q4) = pack4(Sacc[x][d]);
            const float qsl = vqs[16 * li + c16];
#pragma unroll
            for (int tt = 0; tt < 4; ++tt) oacc[tt] = oacc[tt] * qsl;
            for (int ks = 0; ks < (li >= 2 ? 2 : 1); ++ks) { const bf16x8 af = ldfrag(Latt, P64, 16 * li, 32 * ks, lane);
#pragma unroll
                for (int tt = 0; tt < 4; ++tt) oacc[tt] = MFMA16(ldfrag(Lvn, P64, 16 * (4 * dvh + tt), 32 * ks, lane), af, oacc[tt]); }
            float sq = 0.f;
#pragma unroll
            for (int tt = 0; tt < 4; ++tt) sq += (oacc[tt][0] * oacc[tt][0] + oacc[tt][1] * oacc[tt][1]) + (oacc[tt][2] * oacc[tt][2] + oacc[tt][3] * oacc[tt][3]);
            sq += __shfl_xor(sq, 16); sq += __shfl_xor(sq, 32);
            if (q4 == 0) vossq[(16 * li + c16) * 2 + dvh] = sq;
            const size_t row = (size_t)(row0 + t0 + 16 * li + c16);
            unsigned long long gg[4];
#pragma unroll
            for (int tt = 0; tt < 4; ++tt) gg[tt] = *(const unsigned long long*)(proj + row * PITCH + PC_GATE + h * 128 + 16 * (4 * dvh + tt) + 4 * q4);
            __syncthreads();
            const float rs = 1.f / sqrtf((vossq[(16 * li + c16) * 2] + vossq[(16 * li + c16) * 2 + 1]) * (1.f / GDN_D) + EPS);
#pragma unroll
            for (int tt = 0; tt < 4; ++tt) { const int dv0 = 16 * (4 * dvh + tt) + 4 * q4; const f32x4 w = *(const f32x4*)(a.in[I_GNW] + dv0);
                const float g0 = silu_f(bf2f((unsigned)gg[tt] & 0xffffu)), g1 = silu_f(bf2f(((unsigned)gg[tt]) >> 16)), g2 = silu_f(bf2f((unsigned)(gg[tt] >> 32) & 0xffffu)), g3 = silu_f(bf2f((unsigned)(gg[tt] >> 48)));
                const f32x4 o = oacc[tt] * rs * w * (f32x4){g0, g1, g2, g3};
                *(u32x2*)(mixed + row * DMIX + DM + h * 128 + dv0) = pack4(o); }
        }
    }
    const int c16 = lane_ & 15, q4 = lane_ >> 4;
    float* so = a.out + OFF_GDN_P + ((size_t)b * GDN_H + h) * (GDN_D * GDN_D);
#pragma unroll
    for (int x = 0; x < 4; ++x)
#pragma unroll
        for (int d = 0; d < 2; ++d)
#pragma unroll
            for (int r = 0; r < 4; ++r) so[(size_t)(16 * (4 * dvh + x) + 4 * q4 + r) * GDN_D + 16 * (2 * li + d) + c16] = Sacc[x][d][r];
    __syncthreads();
}
constexpr int TB = 16;
__device__ __forceinline__ void ssd_item(const Args& a, LAS unsigned char* lds, int s, int h, int tid, int wave, int lane) {
    const bool prompt = s < NB_P; const int L = prompt ? SEQ : LS; const int row0 = prompt ? s * SEQ : MP + (s - NB_P) * LS; const int g = h >> 3;
    LAS float* raw = (LAS float*)lds;
    LAS float* xs = raw + (TB + 3) * 320; LAS float* Bs = xs + TB * 64; LAS float* Cs = Bs + TB * 128; LAS float* dts = Cs + TB * 128; LAS float* ys = dts + TB;
    const bf16* proj = ws_bf(a, WS_PROJ); bf16* mixed = mixed_buf(a); float* ssq = ws_f(a, WS_SSQ);
    const float A = -expf(a.in[I_SALOG][h]), Dh = a.in[I_SD][h], dtb = a.in[I_SDTB][h];
    const int p = 8 * wave + (lane >> 3), nc = lane & 7;
    float hs[16];
    if (prompt) {
#pragma unroll
        for (int i = 0; i < 16; ++i) hs[i] = 0.f;
    } else { const f32x4* sp = (const f32x4*)(a.in[I_SSD] + ((size_t)(s - NB_P) * SSD_H + h) * (SSD_P * SSD_N) + p * SSD_N + 16 * nc);
#pragma unroll
        for (int q = 0; q < 4; ++q) { const f32x4 v = sp[q]; hs[4 * q] = v.x; hs[4 * q + 1] = v.y; hs[4 * q + 2] = v.z; hs[4 * q + 3] = v.w; } }
    for (int t0 = 0; t0 < L; t0 += TB) {
        const int nb = (L - t0) < TB ? (L - t0) : TB;
        for (int idx = tid; idx < (nb + 3) * 320; idx += NT) { const int i = idx / 320, c = idx - i * 320, tt = t0 - 3 + i;
            const int ch = c < 64 ? h * 64 + c : (c < 192 ? 1024 + g * 128 + (c - 64) : 1280 + g * 128 + (c - 192));
            float v;
            if (tt >= 0) v = bf2f(proj[(size_t)(row0 + tt) * PITCH + PC_XBC + ch]);
            else v = prompt ? 0.f : a.in[I_SSDC][((size_t)(s - NB_P) * 3 + (3 + tt)) * SSD_CONV + ch];
            raw[idx] = v; }
        __syncthreads();
        for (int idx = tid; idx < nb * 320; idx += NT) { const int t = idx / 320, c = idx - t * 320;
            const int ch = c < 64 ? h * 64 + c : (c < 192 ? 1024 + g * 128 + (c - 64) : 1280 + g * 128 + (c - 192));
            float acc = a.in[I_SCB][ch];
#pragma unroll
            for (int j = 0; j < 4; ++j) acc += a.in[I_SCW][j * SSD_CONV + ch] * raw[(t + j) * 320 + c];
            acc = silu_acc(acc);
            if (c < 64) xs[t * 64 + c] = acc; else if (c < 192) Bs[t * 128 + (c - 64)] = acc; else Cs[t * 128 + (c - 192)] = acc; }
        if (tid < nb) dts[tid] = softplus_acc(bf2f(proj[(size_t)(row0 + t0 + tid) * PITCH + PC_DT + h]) + dtb);
        __syncthreads();
        for (int t = 0; t < nb; ++t) {
            const float xv = xs[t * 64 + p], dtv = dts[t], dA = __expf(dtv * A), dx = dtv * xv;
            const LAS f32x4* Bp = (const LAS f32x4*)(Bs + t * 128 + 16 * nc); const LAS f32x4* Cp = (const LAS f32x4*)(Cs + t * 128 + 16 * nc);
            float part = 0.f;
#pragma unroll
            for (int q = 0; q < 4; ++q) { const f32x4 b = Bp[q], c = Cp[q];
#pragma unroll
                for (int e = 0; e < 4; ++e) { hs[4 * q + e] = hs[4 * q + e] * dA + dx * b[e]; part += c[e] * hs[4 * q + e]; } }
            part += __shfl_xor(part, 1); part += __shfl_xor(part, 2); part += __shfl_xor(part, 4);
            if (nc == 0) ys[t * 64 + p] = part + Dh * xv;
        }
        __syncthreads();
        { const int t = tid >> 5, pp = tid & 31; float sq = 0.f; const int row = row0 + t0 + t;
            if (t < nb) { const unsigned zz = *(const unsigned*)(proj + (size_t)row * PITCH + PC_Z + h * 64 + 2 * pp);
                const float y0 = ys[t * 64 + 2 * pp] * silu_acc(bf2f(zz & 0xffffu)), y1 = ys[t * 64 + 2 * pp + 1] * silu_acc(bf2f(zz >> 16));
                *(unsigned*)(mixed + (size_t)row * DMIX + h * 64 + 2 * pp) = pk2(y0, y1); sq = y0 * y0 + y1 * y1; }
            sq += __shfl_xor(sq, 1); sq += __shfl_xor(sq, 2); sq += __shfl_xor(sq, 4); sq += __shfl_xor(sq, 8); sq += __shfl_xor(sq, 16);
            if (t < nb && pp == 0) ssq[(size_t)row * 16 + h] = sq; }
    }
    float* so = a.out + (prompt ? OFF_SSD_P + ((size_t)s * SSD_H + h) * (SSD_P * SSD_N) : OFF_SSD_S + ((size_t)(s - NB_P) * SSD_H + h) * (SSD_P * SSD_N)) + p * SSD_N + 16 * nc;
#pragma unroll
    for (int q = 0; q < 4; ++q) ((f32x4*)so)[q] = (f32x4){hs[4 * q], hs[4 * q + 1], hs[4 * q + 2], hs[4 * q + 3]};
    __syncthreads();
}
__device__ __forceinline__ void gdn_item(const Args& a, LAS unsigned char* lds, int s, int h, int tid, int wave, int lane) {
    const bool prompt = s < NB_P; const int L = prompt ? SEQ : LS; const int row0 = prompt ? s * SEQ : MP + (s - NB_P) * LS;
    LAS float* raw = (LAS float*)lds;
    LAS float* qs = raw + (TB + 3) * 384; LAS float* ks = qs + TB * 128; LAS float* vs = ks + TB * 128; LAS float* gs = vs + TB * 128; LAS float* bs = gs + TB; LAS float* os = bs + TB;
    const bf16* proj = ws_bf(a, WS_PROJ); bf16* mixed = mixed_buf(a);
    const float Ag = -expf(a.in[I_GALOG][h]), dtb = a.in[I_GDTB][h];
    const int dv = 16 * wave + (lane & 15), dkc = lane >> 4;
    float Ss[32];
    const size_t sbase = (size_t)(32 * dkc) * GDN_D + dv;
    if (prompt) {
#pragma unroll
        for (int i = 0; i < 32; ++i) Ss[i] = 0.f;
    } else { const float* sp = a.in[I_GDN] + ((size_t)(s - NB_P) * GDN_H + h) * (GDN_D * GDN_D) + sbase;
#pragma unroll
        for (int i = 0; i < 32; ++i) Ss[i] = sp[(size_t)i * GDN_D]; }
    for (int t0 = 0; t0 < L; t0 += TB) {
        const int nb = (L - t0) < TB ? (L - t0) : TB;
        for (int idx = tid; idx < (nb + 3) * 384; idx += NT) { const int i = idx / 384, c = idx - i * 384, tt = t0 - 3 + i;
            const int ch = (c >> 7) * 1024 + h * 128 + (c & 127);
            float v;
            if (tt >= 0) v = bf2f(proj[(size_t)(row0 + tt) * PITCH + PC_QKV + ch]);
            else v = prompt ? 0.f : a.in[I_GDNC][((size_t)(s - NB_P) * 3 + (3 + tt)) * GDN_CONV + ch];
            raw[idx] = v; }
        __syncthreads();
        for (int idx = tid; idx < nb * 384; idx += NT) { const int t = idx / 384, c = idx - t * 384; const int ch = (c >> 7) * 1024 + h * 128 + (c & 127);
            float acc = 0.f;
#pragma unroll
            for (int j = 0; j < 4; ++j) acc += a.in[I_GCW][j * GDN_CONV + ch] * raw[(t + j) * 384 + c];
            acc = silu_acc(acc);
            if (c < 128) qs[t * 128 + c] = acc; else if (c < 256) ks[t * 128 + (c - 128)] = acc; else vs[t * 128 + (c - 256)] = acc; }
        if (tid < nb) { const size_t r = (size_t)(row0 + t0 + tid) * PITCH;
            gs[tid] = Ag * softplus_acc(bf2f(proj[r + PC_ALPHA + h]) + dtb); bs[tid] = 1.f / (1.f + expf(-bf2f(proj[r + PC_BETA + h]))); }
        __syncthreads();
        {
            const int grp = tid >> 4, j = tid & 15, t = grp >> 1; LAS float* vp = ((grp & 1) ? ks : qs) + t * 128 + 8 * j;
            float sq = 0.f; float e[8];
            if (t < nb) {
#pragma unroll
                for (int i = 0; i < 8; ++i) { e[i] = vp[i]; sq += e[i] * e[i]; } }
            sq += __shfl_xor(sq, 1); sq += __shfl_xor(sq, 2); sq += __shfl_xor(sq, 4); sq += __shfl_xor(sq, 8);
            const float sc = (1.f / sqrtf(sq + 1e-6f)) * ((grp & 1) ? 1.f : 0.08838834764831845f);
            if (t < nb) {
#pragma unroll
                for (int i = 0; i < 8; ++i) vp[i] = e[i] * sc; } }
        __syncthreads();
        for (int t = 0; t < nb; ++t) {
            const float eg = __expf(gs[t]), bt = bs[t];
            const LAS f32x4* kp = (const LAS f32x4*)(ks + t * 128 + 32 * dkc); const LAS f32x4* qp = (const LAS f32x4*)(qs + t * 128 + 32 * dkc);
            f32x4 kk[8]; float u = 0.f;
#pragma unroll
            for (int q = 0; q < 8; ++q) { kk[q] = kp[q];
#pragma unroll
                for (int e = 0; e < 4; ++e) u += kk[q][e] * Ss[4 * q + e]; }
            u += __shfl_xor(u, 16); u += __shfl_xor(u, 32);
            const float wv = bt * (vs[t * 128 + dv] - eg * u);
            float o = 0.f;
#pragma unroll
            for (int q = 0; q < 8; ++q) { const f32x4 qq = qp[q];
#pragma unroll
                for (int e = 0; e < 4; ++e) { Ss[4 * q + e] = eg * Ss[4 * q + e] + kk[q][e] * wv; o += qq[e] * Ss[4 * q + e]; } }
            o += __shfl_xor(o, 16); o += __shfl_xor(o, 32);
            if (dkc == 0) os[t * 128 + dv] = o;
        }
        __syncthreads();
        { const int t = tid >> 5, j = tid & 31; const int row = row0 + t0 + t; float sq = 0.f; f32x4 o4 = (f32x4){0.f, 0.f, 0.f, 0.f};
            if (t < nb) { o4 = *(const LAS f32x4*)(os + t * 128 + 4 * j); sq = (o4.x * o4.x + o4.y * o4.y) + (o4.z * o4.z + o4.w * o4.w); }
            sq += __shfl_xor(sq, 1); sq += __shfl_xor(sq, 2); sq += __shfl_xor(sq, 4); sq += __shfl_xor(sq, 8); sq += __shfl_xor(sq, 16);
            if (t < nb) { const float rs = 1.f / sqrtf(sq * (1.f / GDN_D) + EPS); const f32x4 w = *(const f32x4*)(a.in[I_GNW] + 4 * j);
                const unsigned long long gg = *(const unsigned long long*)(proj + (size_t)row * PITCH + PC_GATE + h * 128 + 4 * j);
                const float g0 = silu_acc(bf2f((unsigned)gg & 0xffffu)), g1 = silu_acc(bf2f(((unsigned)gg) >> 16)), g2 = silu_acc(bf2f((unsigned)(gg >> 32) & 0xffffu)), g3 = silu_acc(bf2f((unsigned)(gg >> 48)));
                *(unsigned long long*)(mixed + (size_t)row * DMIX + DM + h * 128 + 4 * j) =
                    (unsigned long long)pk2(o4.x * rs * w.x * g0, o4.y * rs * w.y * g1) | ((unsigned long long)pk2(o4.z * rs * w.z * g2, o4.w * rs * w.w * g3) << 32); } }
    }
    float* so = a.out + (prompt ? OFF_GDN_P + ((size_t)s * GDN_H + h) * (GDN_D * GDN_D) : OFF_GDN_S + ((size_t)(s - NB_P) * GDN_H + h) * (GDN_D * GDN_D)) + sbase;
#pragma unroll
    for (int i = 0; i < 32; ++i) so[(size_t)i * GDN_D] = Ss[i];
    __syncthreads();
}
__device__ __forceinline__ void convstate_item(const Args& a, int s, int tid) {
    const bool prompt = s < NB_P; const int L = prompt ? SEQ : LS; const int row0 = prompt ? s * SEQ : MP + (s - NB_P) * LS; const bf16* proj = ws_bf(a, WS_PROJ);
    float* o1 = a.out + (prompt ? OFF_SSDC_P + (size_t)s * 3 * SSD_CONV : OFF_SSDC_S + (size_t)(s - NB_P) * 3 * SSD_CONV);
    float* o2 = a.out + (prompt ? OFF_GDNC_P + (size_t)s * 3 * GDN_CONV : OFF_GDNC_S + (size_t)(s - NB_P) * 3 * GDN_CONV);
    for (int idx = tid; idx < 3 * SSD_CONV; idx += NT) { const int j = idx / SSD_CONV, c = idx - j * SSD_CONV; o1[idx] = bf2f(proj[(size_t)(row0 + L - 3 + j) * PITCH + PC_XBC + c]); }
    for (int idx = tid; idx < 3 * GDN_CONV; idx += NT) { const int j = idx / GDN_CONV, c = idx - j * GDN_CONV; o2[idx] = bf2f(proj[(size_t)(row0 + L - 3 + j) * PITCH + PC_QKV + c]); }
}
constexpr int Q_GP = NB_P * GDN_H, Q_SP = Q_GP + NB_P * SSD_H, Q_GS = Q_SP + NB_S * GDN_H, Q_SS = Q_GS + NB_S * SSD_H, Q_ALL = Q_SS + NSEQ;
__device__ __forceinline__ void p3_mixers(const Args& a, LAS unsigned char* lds, volatile LAS unsigned* misc, int tid_, int wave, int lane_) {
    unsigned* qctr = (unsigned*)(a.ws + WS_CTL) + CW_QUEUE;
    for (;;) {
        if (tid_ == 0) misc[0] = __hip_atomic_fetch_add(qctr, 1u, __ATOMIC_RELAXED, __HIP_MEMORY_SCOPE_AGENT);
        __syncthreads();
        const int it = (int)misc[0];
        __syncthreads();
        if (it >= Q_ALL) break;
        int tid = tid_, lane = lane_;
        asm volatile("" : "+v"(tid), "+v"(lane));
        if (it < Q_GP) gdn_chunk_item(a, lds, it >> 3, it & 7, tid, wave, lane);
        else if (it < Q_SP) ssd_item(a, lds, (it - Q_GP) >> 4, (it - Q_GP) & 15, tid, wave, lane);
        else if (it < Q_GS) gdn_item(a, lds, NB_P + ((it - Q_SP) >> 3), (it - Q_SP) & 7, tid, wave, lane);
        else if (it < Q_SS) ssd_item(a, lds, NB_P + ((it - Q_GS) >> 4), (it - Q_GS) & 15, tid, wave, lane);
        else convstate_item(a, it - Q_SS, tid);
    }
}
__device__ __forceinline__ void p3b_ssdnorm(const Args& a, int gw, int NGW, int lane) {
    bf16* mixed = mixed_buf(a); const float* ssq = ws_f(a, WS_SSQ); const float* nw = a.in[I_SNW] + 16 * lane;
    for (int row = gw; row < M; row += NGW) {
        const f32x4* sp = (const f32x4*)(ssq + (size_t)row * 16 + 8 * (lane >> 5)); const f32x4 s0 = sp[0], s1 = sp[1];
        const float rs = 1.f / sqrtf(((s0.x + s0.y) + (s0.z + s0.w) + (s1.x + s1.y) + (s1.z + s1.w)) * (1.f / 512.f) + EPS);
        v4u* mp = (v4u*)(mixed + (size_t)row * DMIX + 16 * lane);
#pragma unroll
        for (int q = 0; q < 2; ++q) { v4u v = mp[q]; const f32x4 w0 = *(const f32x4*)(nw + 8 * q), w1 = *(const f32x4*)(nw + 8 * q + 4);
            v.x = pk2(bf2f(v.x & 0xffffu) * rs * w0.x, bf2f(v.x >> 16) * rs * w0.y); v.y = pk2(bf2f(v.y & 0xffffu) * rs * w0.z, bf2f(v.y >> 16) * rs * w0.w);
            v.z = pk2(bf2f(v.z & 0xffffu) * rs * w1.x, bf2f(v.z >> 16) * rs * w1.y); v.w = pk2(bf2f(v.w & 0xffffu) * rs * w1.z, bf2f(v.w >> 16) * rs * w1.w);
            mp[q] = v; }
    }
}
__device__ __forceinline__ void p5_mid(const Args& a, int gw, int NGW, int lane) {
    const float* mod = ws_f(a, WS_MOD); const float* T1 = ws_f(a, WS_T1); bf16* XN2 = ws_bf(a, WS_XN2); const float* wpost = a.in[I_NMPOST]; const float* wpre = a.in[I_NFPRE];
    for (int row = gw; row < M; row += NGW) {
        const f32x4* tr = (const f32x4*)(T1 + (size_t)row * DM) + lane; const f32x4* xr = (const f32x4*)x_row(a, row) + lane; const float* mr = mod + (size_t)seq_of_row(row) * NMOD;
        f32x4 v[4]; float s = 0.f;
#pragma unroll
        for (int j = 0; j < 4; ++j) { v[j] = tr[64 * j]; s += (v[j].x * v[j].x + v[j].y * v[j].y) + (v[j].z * v[j].z + v[j].w * v[j].w); }
        const float rs = 1.f / sqrtf(wave_sum(s) * (1.f / DM) + EPS);
        float s2 = 0.f; f32x4* yo = (f32x4*)(a.out + OFF_Y + (size_t)row * DM) + lane;
#pragma unroll
        for (int j = 0; j < 4; ++j) { const int c = 4 * lane + 256 * j; const f32x4 w = *(const f32x4*)(wpost + c), g1 = *(const f32x4*)(mr + 2 * DM + c);
            v[j] = xr[64 * j] + g1 * (v[j] * rs * w); yo[64 * j] = v[j]; s2 += (v[j].x * v[j].x + v[j].y * v[j].y) + (v[j].z * v[j].z + v[j].w * v[j].w); }
        const float rs2 = 1.f / sqrtf(wave_sum(s2) * (1.f / DM) + EPS);
        unsigned long long* o8 = (unsigned long long*)(XN2 + (size_t)row * DM) + lane;
#pragma unroll
        for (int j = 0; j < 4; ++j) { const int c = 4 * lane + 256 * j; const f32x4 w = *(const f32x4*)(wpre + c), sh = *(const f32x4*)(mr + 3 * DM + c), sc = *(const f32x4*)(mr + 4 * DM + c);
            const f32x4 h = v[j] * rs2 * w * (sc + 1.f) + sh;
            o8[64 * j] = (unsigned long long)pk2(h.x, h.y) | ((unsigned long long)pk2(h.z, h.w) << 32); }
    }
}
__device__ __forceinline__ void p8_final(const Args& a, int gw, int NGW, int lane) {
    const float* mod = ws_f(a, WS_MOD); const float* T2 = ws_f(a, WS_T2); const float* wpost = a.in[I_NFPOST];
    for (int row = gw; row < M; row += NGW) {
        const f32x4* tr = (const f32x4*)(T2 + (size_t)row * DM) + lane; const float* mr = mod + (size_t)seq_of_row(row) * NMOD;
        f32x4 v[4]; float s = 0.f;
#pragma unroll
        for (int j = 0; j < 4; ++j) { v[j] = tr[64 * j]; s += (v[j].x * v[j].x + v[j].y * v[j].y) + (v[j].z * v[j].z + v[j].w * v[j].w); }
        const float rs = 1.f / sqrtf(wave_sum(s) * (1.f / DM) + EPS);
        f32x4* yo = (f32x4*)(a.out + OFF_Y + (size_t)row * DM) + lane;
#pragma unroll
        for (int j = 0; j < 4; ++j) { const int c = 4 * lane + 256 * j; const f32x4 w = *(const f32x4*)(wpost + c), g2 = *(const f32x4*)(mr + 5 * DM + c);
            yo[64 * j] = yo[64 * j] + g2 * (v[j] * rs * w); }
    }
}
#ifndef MK_N_LAUNCHES
#define MK_N_LAUNCHES 1
#endif
constexpr int NPH = 10;
constexpr int N_LAUNCHES = MK_N_LAUNCHES;
static_assert(N_LAUNCHES == 1 || N_LAUNCHES == NPH, "MK_N_LAUNCHES is 1 or 10");
#ifndef PG8_SP2
#define PG8_SP2 true
#endif
#ifndef PG8_ALIGN
#define PG8_ALIGN true
#endif
__global__ void __launch_bounds__(NT, 2) hymba_fwd(Args args) {
    extern __shared__ __attribute__((aligned(16))) unsigned char lds_[];
    LAS unsigned char* lds = (LAS unsigned char*)lds_;
    volatile LAS unsigned* MISC = (volatile LAS unsigned*)(lds + MISC_OFF);
    const int tid0 = threadIdx.x, wave = __builtin_amdgcn_readfirstlane(tid0 >> 6);
#define PHASE_IDS int lane = (int)__builtin_amdgcn_mbcnt_hi(~0u, __builtin_amdgcn_mbcnt_lo(~0u, 0u)); asm volatile("" : "+v"(lane)); const int tid = wave * 64 + lane;
    const int G = gridDim.x, bid = blockIdx.x;
    const int gw = bid * NWAVES + wave, NGW = G * NWAVES;
    gu32* ctl = (gu32*)(args.ws + WS_CTL);
    for (int u = tid0; u < (LDS_BYTES - LDSCTL_OFF) / 4; u += NT) ((LAS unsigned*)(lds + LDSCTL_OFF))[u] = 0u;
    __syncthreads();
    XcdBarrier bar; bar.bar = (unsigned*)(ctl + CW_BAR); bar.x = 0; bar.st = nullptr;
    if (N_LAUNCHES == 1) bar = xcd_barrier_post((unsigned*)(ctl + CW_BAR), MISC + 8);
#define GRID_BAR(seam) do { if (N_LAUNCHES != 1) { if (wave == 0 && __builtin_amdgcn_mbcnt_lo(~0u, 0u) == 0u) __hip_atomic_store(ctl + CW_TMO, 0xBADBA0u | (unsigned)(seam), RLX_AGENT); } else { xcd_barrier(bar); } } while (0)
    const int lo = args.ph_lo, hi = args.ph_hi;
#define IN(k) (lo <= (k) && (k) < hi)
#define BOTH(k) (IN(k) && IN((k) + 1))
    if (IN(0)) { PHASE_IDS p0_prologue(args, lds, bid, G, tid, wave, lane); if (BOTH(0)) GRID_BAR(0); }
    if (IN(1)) { PHASE_IDS p1_xn(args, gw, NGW, lane); if (BOTH(1)) GRID_BAR(1); }
    if (IN(2)) {
        pg8::Gemm g{xn_buf(args), win_t(args), M, IN_PAD, DM}; pg8::StaticOrder S; S.init(M, IN_PAD, G, bid);
        pg8::EpiBf16Clip E{ws_bf(args, WS_PROJ), PITCH, IN_DIM};
        pg8::gemm_phase<pg8::EpiBf16Clip, pg8::StaticOrder, PG8_ALIGN, PG8_SP2>(lds + RING_OFF, g, S, E);
        if (BOTH(2)) GRID_BAR(2);
    }
    if (IN(3)) { PHASE_IDS p3_mixers(args, lds, MISC, tid, wave, lane); if (BOTH(3)) GRID_BAR(3); }
    if (IN(4)) { PHASE_IDS p3b_ssdnorm(args, gw, NGW, lane); if (BOTH(4)) GRID_BAR(4); }
    if (IN(5)) {
        pg8::Gemm g{mixed_buf(args), ws_bf(args, WS_WOUT), M, DM, DMIX}; pg8::StaticOrder S; S.init(M, DM, G, bid);
        pg8::EpiF32 E{ws_f(args, WS_T1), DM};
        pg8::gemm_phase<pg8::EpiF32, pg8::StaticOrder, PG8_ALIGN, PG8_SP2>(lds + RING_OFF, g, S, E);
        if (BOTH(5)) GRID_BAR(5);
    }
    if (IN(6)) { PHASE_IDS p5_mid(args, gw, NGW, lane); if (BOTH(6)) GRID_BAR(6); }
    if (IN(7)) {
        pg8::Gemm g{ws_bf(args, WS_XN2), ws_bf(args, WS_WGU), M, NGU, DM}; pg8::StaticOrder S; S.init(M, NGU, G, bid);
        pg8::EpiSwiGLU E{ws_bf(args, WS_ACT), DFF};
        pg8::gemm_phase<pg8::EpiSwiGLU, pg8::StaticOrder, PG8_ALIGN, PG8_SP2>(lds + RING_OFF, g, S, E);
        if (BOTH(7)) GRID_BAR(7);
    }
    if (IN(8)) {
        pg8::Gemm g{ws_bf(args, WS_ACT), ws_bf(args, WS_WDN), M, DM, DFF}; pg8::StaticOrder S; S.init(M, DM, G, bid);
        pg8::EpiF32 E{ws_f(args, WS_T2), DM};
        pg8::gemm_phase<pg8::EpiF32, pg8::StaticOrder, PG8_ALIGN, PG8_SP2>(lds + RING_OFF, g, S, E);
        if (BOTH(8)) GRID_BAR(8);
    }
    if (IN(9)) { PHASE_IDS p8_final(args, gw, NGW, lane); }
#undef IN
#undef BOTH
}
extern "C" void kernel_launch(void* const* d_in, const int* in_sizes, int n_in, void* d_out, int out_size, void* d_ws, size_t ws_size, hipStream_t stream) {
    static int grid = 0;
    if (grid == 0) {
        if (n_in != 28 || in_sizes[0] != MP * DM || (size_t)out_size != OUT_TOTAL || ws_size < WS_END) {
            fprintf(stderr, "kernel_launch: shape/workspace mismatch: n_in %d in0 %d out %d ws %zu (need %zu); nothing launched\n", n_in, n_in > 0 ? in_sizes[0] : -1, out_size, ws_size, (size_t)WS_END); grid = -1; return; }
        int dev = 0, cus = 0, per_cu = 0;
        if (hipGetDevice(&dev) != hipSuccess || hipDeviceGetAttribute(&cus, hipDeviceAttributeMultiprocessorCount, dev) != hipSuccess) { fprintf(stderr, "kernel_launch: device query failed\n"); grid = -1; return; }
        if (hipFuncSetAttribute((const void*)hymba_fwd, hipFuncAttributeMaxDynamicSharedMemorySize, LDS_BYTES) != hipSuccess) { fprintf(stderr, "kernel_launch: hipFuncSetAttribute failed\n"); grid = -1; return; }
        if (hipOccupancyMaxActiveBlocksPerMultiprocessor(&per_cu, (const void*)hymba_fwd, NT, LDS_BYTES) != hipSuccess || per_cu < 1)
            fprintf(stderr, "kernel_launch: note: occupancy query reports %d workgroups per CU\n", per_cu);
        (void)hipGetLastError();
        grid = cus;
    }
    if (grid < 0) return;
    if (hipMemsetAsync((char*)d_ws + WS_CTL, 0, CTL_ZERO_BYTES, stream) != hipSuccess) { fprintf(stderr, "kernel_launch: memset failed\n"); return; }
    Args a{};
    for (int i = 0; i < 28; ++i) a.in[i] = (const float*)d_in[i];
    a.out = (float*)d_out; a.ws = (unsigned char*)d_ws;
    for (int li = 0; li < N_LAUNCHES; ++li) {
        a.ph_lo = (N_LAUNCHES == 1) ? 0 : li; a.ph_hi = (N_LAUNCHES == 1) ? NPH : li + 1; a.li = li;
        hipLaunchKernelGGL(hymba_fwd, dim3(grid), dim3(NT), LDS_BYTES, stream, a);
        const hipError_t le = hipPeekAtLastError();
        if (le != hipSuccess) { fprintf(stderr, "kernel_launch: launch %d failed: %s\n", li, hipGetErrorName(le)); break; }
    }
}
```

```cpp
#include <hip/hip_runtime.h>
#include <cstdio>
#include <cstdint>
namespace pg8 {
#define PG8_LAS __attribute__((address_space(3)))
typedef unsigned short bf16_t;
typedef short bf16x8 __attribute__((ext_vector_type(8)));
typedef float f32x4 __attribute__((ext_vector_type(4)));
typedef unsigned u32x4 __attribute__((ext_vector_type(4)));
constexpr int BM = 256, BK = 64, HALF = 128, HTB = HALF * BK * 2  , STAGE_BYTES = 8 * HTB, NXCD = 8, WGM = 8;

__host__ __device__ __forceinline__ int lds_byte(int r, int c) { const int st = (r >> 4) * 2 + (c >> 5), rr = r & 15, cc = c & 31, ob = rr * 64 + cc * 2; return st * 1024 + (ob ^ (((ob >> 9) & 1) << 5)); }
__host__ __device__ __forceinline__ void stage_rc(int b, int& R, int& C) { const int st = b / 1024, sb = b % 1024, swz = sb ^ (((sb >> 9) & 1) << 5); R = (st >> 1) * 16 + swz / 64; C = (st & 1) * 32 + (swz % 64) / 2; }
__host__ __device__ __forceinline__ int perm32(int rho) { const int n = rho >> 4, i = rho & 15; return 8 * (i >> 2) + 4 * n + (i & 3); }

struct Unit { int pm, pn; };
struct Gemm { const bf16_t* A; const bf16_t* Bt; int M, N, K; };

struct StaticOrder {
    int nM, nN, nwg, G, c;
    __host__ __device__ void init(int M, int N, int G_, int c_) { nM = M / BM; nN = N / BM; nwg = nM * nN; G = G_; c = c_; }
    __host__ __device__ bool next(int i, Unit& u) const {
        const long L = (long)i * G + c; if (L >= nwg) return false;
        int wgid = (int)L; { const int q = nwg / NXCD, r = nwg % NXCD, xcd = wgid % NXCD, off = wgid / NXCD; wgid = (xcd < r ? xcd * (q + 1) : r * (q + 1) + (xcd - r) * q) + off; }
        const int nig = WGM * nN, gid = wgid / nig, fm = gid * WGM, gsz = (nM - fm) < WGM ? (nM - fm) : WGM;
        u.pm = fm + ((wgid % nig) % gsz); u.pn = (wgid % nig) / gsz; return true;
    }
    __device__ __forceinline__ void a_ready(const Unit&) const {}
    __device__ __forceinline__ void done(const Unit&) const {}
};

typedef float f32x2c __attribute__((ext_vector_type(2))); typedef __bf16 bf16x2c __attribute__((ext_vector_type(2)));
__device__ __forceinline__ unsigned cvt_pk_bf16(float lo, float hi) { f32x2c v = {lo, hi}; bf16x2c b = __builtin_convertvector(v, bf16x2c); return __builtin_bit_cast(unsigned, b); }
typedef float f32x2 __attribute__((ext_vector_type(2)));
__device__ __forceinline__ float silu_fast(float x) { return x * __builtin_amdgcn_rcpf(1.f + __expf(-x)); }
struct EpiBf16Clip {
    static constexpr bool PERM = true, AFTER_DRAIN = false;
    bf16_t* O; int ldc; int ncols;
    __device__ __forceinline__ void operator()(const f32x4 (&acc)[2][2][4][2], const Unit& u, int wr, int wc, int fr, int fq) const {
        const int row0 = u.pm * BM + wr * 64 + fr; const int col0 = u.pn * BM + wc * 32 + 8 * fq;
#pragma unroll
        for (int ai = 0; ai < 2; ++ai)
#pragma unroll
            for (int m = 0; m < 4; ++m) { bf16_t* rowp = O + (size_t)(row0 + ai * HALF + m * 16) * ldc + col0;
#pragma unroll
                for (int bj = 0; bj < 2; ++bj) { if (col0 + bj * HALF < ncols) { const f32x4 v0 = acc[ai][bj][m][0], v1 = acc[ai][bj][m][1];
                    u32x4 w; w.x = cvt_pk_bf16(v0[0], v0[1]); w.y = cvt_pk_bf16(v0[2], v0[3]); w.z = cvt_pk_bf16(v1[0], v1[1]); w.w = cvt_pk_bf16(v1[2], v1[3]);
                    *(u32x4*)(rowp + bj * HALF) = w; } } }
    }
};
struct EpiF32 {
    static constexpr bool PERM = false, AFTER_DRAIN = false;
    float* O; int ldc;
    __device__ __forceinline__ void operator()(const f32x4 (&acc)[2][2][4][2], const Unit& u, int wr, int wc, int fr, int fq) const {
        const int row0 = u.pm * BM + wr * 64 + fr; const int col0 = u.pn * BM + wc * 32 + 4 * fq;
#pragma unroll
        for (int ai = 0; ai < 2; ++ai)
#pragma unroll
            for (int m = 0; m < 4; ++m) { float* rowp = O + (size_t)(row0 + ai * HALF + m * 16) * ldc + col0;
#pragma unroll
                for (int bj = 0; bj < 2; ++bj)
#pragma unroll
                    for (int n = 0; n < 2; ++n) *(f32x4*)(rowp + bj * HALF + n * 16) = acc[ai][bj][m][n]; }
    }
};
struct EpiSwiGLU {
    static constexpr bool PERM = true, AFTER_DRAIN = false;
    bf16_t* O; int ldc;
    __device__ __forceinline__ void operator()(const f32x4 (&acc)[2][2][4][2], const Unit& u, int wr, int wc, int fr, int fq) const {
        const int row0 = u.pm * BM + wr * 64 + fr; const int col0 = u.pn * HALF + wc * 32 + 8 * fq;
#pragma unroll
        for (int ai = 0; ai < 2; ++ai)
#pragma unroll
            for (int m = 0; m < 4; ++m) { bf16_t* rowp = O + (size_t)(row0 + ai * HALF + m * 16) * ldc + col0;
                f32x4 v[2];
#pragma unroll
                for (int n = 0; n < 2; ++n) { const f32x4 g = acc[ai][0][m][n], up = acc[ai][1][m][n];
                    v[n] = (f32x4){silu_fast(g[0]) * up[0], silu_fast(g[1]) * up[1], silu_fast(g[2]) * up[2], silu_fast(g[3]) * up[3]}; }
                u32x4 w; w.x = cvt_pk_bf16(v[0][0], v[0][1]); w.y = cvt_pk_bf16(v[0][2], v[0][3]); w.z = cvt_pk_bf16(v[1][0], v[1][1]); w.w = cvt_pk_bf16(v[1][2], v[1][3]);
                *(u32x4*)rowp = w; }
    }
};
template <class Epi, class Sched, bool ALIGN_EPI = false, bool SP2 = false>
__device__ __forceinline__ void gemm_phase(PG8_LAS unsigned char* lds, const Gemm g, const Sched& S, const Epi& E) {
    const int tid = threadIdx.x, wid = __builtin_amdgcn_readfirstlane(tid >> 6), lane = tid & 63, wr = wid >> 2, wc = wid & 3, fr = lane & 15, fq = lane >> 4;
    const int K = g.K, nt = K / BK;
    unsigned voffA[2], voffB[2];
#pragma unroll
    for (int i = 0; i < 2; ++i) { int R, C; stage_rc(tid * 16 + i * 8192, R, C); const int Rb = Epi::PERM ? ((R & ~31) + perm32(R & 31)) : R;
        voffA[i] = (unsigned)(R * K + C) * 2u; voffB[i] = (unsigned)(Rb * K + C) * 2u; }
    const size_t kstep = (size_t)(BK * 2);
    const size_t hstep = (size_t)HALF * K * 2;
    const size_t tstep = 2 * hstep;
    const unsigned ldsw = (unsigned)wid * 1024u;
    const int aoff = lds_byte(wr * 64 + fr, fq * 8), boff = lds_byte(wc * 32 + fr, fq * 8);
#define PG8_SA(b, h) (((b) * 2 + (h)) * HTB)
#define PG8_SB(b, h) ((4 + (b) * 2 + (h)) * HTB)
#define PG8_STAGE(bufoff, gbase, voff) do { _Pragma("unroll") for (int _i = 0; _i < 2; ++_i) \
        __builtin_amdgcn_global_load_lds((const unsigned*)((const char*)(gbase) + (voff)[_i]), (PG8_LAS unsigned*)(lds + (bufoff) + ldsw + _i * 8192), 16, 0, 0); } while (0)
#define PG8_LDA(dst, b, h) do { _Pragma("unroll") for (int m = 0; m < 4; ++m) _Pragma("unroll") for (int k = 0; k < 2; ++k) dst[m][k] = *(const PG8_LAS bf16x8*)(lds + PG8_SA(b, h) + aoff + m * 2048 + k * 1024); } while (0)
#define PG8_LDB(dst, b, h) do { _Pragma("unroll") for (int n = 0; n < 2; ++n) _Pragma("unroll") for (int k = 0; k < 2; ++k) dst[n][k] = *(const PG8_LAS bf16x8*)(lds + PG8_SB(b, h) + boff + n * 2048 + k * 1024); } while (0)
#define PG8_MMA(ai, bj, At, Bt) do { __builtin_amdgcn_s_setprio(1); _Pragma("unroll") for (int m = 0; m < 4; ++m) _Pragma("unroll") for (int n = 0; n < 2; ++n) _Pragma("unroll") for (int k = 0; k < 2; ++k) \
        acc[ai][bj][m][n] = __builtin_amdgcn_mfma_f32_16x16x32_bf16(Bt[n][k], At[m][k], acc[ai][bj][m][n], 0, 0, 0); __builtin_amdgcn_s_setprio(0); } while (0)
#define PG8_WAIT_V(n) asm volatile("s_waitcnt vmcnt(" #n ")" ::: "memory")
#define PG8_WAIT_L(n) asm volatile("s_waitcnt lgkmcnt(" #n ")" ::: "memory")
#define PG8_BAR __builtin_amdgcn_s_barrier()
#define PG8_SCHED __builtin_amdgcn_sched_barrier(0)
    Unit cur, nxt; int ui = 0;
    if (!S.next(0, cur)) return;
    f32x4 acc[2][2][4][2];
#pragma unroll
    for (int a = 0; a < 2; ++a)
#pragma unroll
        for (int b = 0; b < 2; ++b)
#pragma unroll
            for (int m = 0; m < 4; ++m)
#pragma unroll
                for (int n = 0; n < 2; ++n) acc[a][b][m][n] = (f32x4){0.f, 0.f, 0.f, 0.f};
    bf16x8 At[4][2], B0[2][2], B1[2][2];
    const char* cA = (const char*)g.A + (size_t)cur.pm * tstep; const char* cB = (const char*)g.Bt + (size_t)cur.pn * tstep;
    S.a_ready(cur);
    if constexpr (SP2) {
        PG8_STAGE(PG8_SB(0, 0), cB, voffB); PG8_STAGE(PG8_SB(0, 1), cB + hstep, voffB); PG8_STAGE(PG8_SA(0, 0), cA, voffA); PG8_STAGE(PG8_SA(0, 1), cA + hstep, voffA);
        if (wr == 1) PG8_BAR;
        PG8_WAIT_V(2); PG8_BAR;
        PG8_STAGE(PG8_SB(1, 0), cB + kstep, voffB); PG8_STAGE(PG8_SA(1, 0), cA + kstep, voffA); PG8_STAGE(PG8_SB(1, 1), cB + hstep + kstep, voffB);
        PG8_WAIT_V(6); PG8_BAR;
    } else {
        PG8_STAGE(PG8_SB(0, 0), cB, voffB); PG8_STAGE(PG8_SA(0, 0), cA, voffA); PG8_STAGE(PG8_SB(0, 1), cB + hstep, voffB); PG8_STAGE(PG8_SA(0, 1), cA + hstep, voffA);
        if (wr == 1) PG8_BAR;
        PG8_WAIT_V(4); PG8_BAR;
        PG8_STAGE(PG8_SB(1, 0), cB + kstep, voffB); PG8_STAGE(PG8_SA(1, 0), cA + kstep, voffA); PG8_STAGE(PG8_SB(1, 1), cB + hstep + kstep, voffB);
        PG8_WAIT_V(6); PG8_BAR;
    }
    for (;;) {
        const bool has_next = S.next(ui + 1, nxt);
        const char* nA = has_next ? (const char*)g.A + (size_t)nxt.pm * tstep : cA; const char* nB = has_next ? (const char*)g.Bt + (size_t)nxt.pn * tstep : cB;
        for (int t = 0; t < nt; t += 2) {
            const bool last = (t == nt - 2);
            const char* a1 = cA + (size_t)(t + 1) * kstep;
            const char* a2 = last ? nA : cA + (size_t)(t + 2) * kstep; const char* b2 = last ? nB : cB + (size_t)(t + 2) * kstep;
            const char* a3 = a2 + kstep; const char* b3 = b2 + kstep;
            if (last && has_next) S.a_ready(nxt);
            if constexpr (SP2) {
            PG8_LDB(B0, 0, 0); PG8_LDB(B1, 0, 1); PG8_SCHED; PG8_LDA(At, 0, 0); PG8_STAGE(PG8_SA(1, 1), a1 + hstep, voffA);
            PG8_WAIT_V(8); PG8_WAIT_L(0); PG8_BAR; PG8_MMA(0, 0, At, B0); PG8_MMA(0, 1, At, B1); PG8_BAR; PG8_SCHED;
            PG8_LDA(At, 0, 1); PG8_STAGE(PG8_SB(0, 0), b2, voffB); PG8_STAGE(PG8_SB(0, 1), b2 + hstep, voffB); PG8_STAGE(PG8_SA(0, 0), a2, voffA);
            PG8_WAIT_V(8); PG8_WAIT_L(0); PG8_BAR; PG8_MMA(1, 0, At, B0); PG8_MMA(1, 1, At, B1); PG8_BAR; PG8_SCHED;
            PG8_LDB(B0, 1, 0); PG8_LDB(B1, 1, 1); PG8_SCHED; PG8_LDA(At, 1, 0); PG8_STAGE(PG8_SA(0, 1), a2 + hstep, voffA);
            PG8_WAIT_V(8); PG8_WAIT_L(0); PG8_BAR; PG8_MMA(0, 0, At, B0); PG8_MMA(0, 1, At, B1); PG8_BAR; PG8_SCHED;
            PG8_LDA(At, 1, 1); PG8_STAGE(PG8_SB(1, 0), b3, voffB); PG8_STAGE(PG8_SB(1, 1), b3 + hstep, voffB); PG8_STAGE(PG8_SA(1, 0), a3, voffA);
            PG8_WAIT_V(8); PG8_WAIT_L(0); PG8_BAR; PG8_MMA(1, 0, At, B0); PG8_MMA(1, 1, At, B1); PG8_BAR; PG8_SCHED;
            } else {
            PG8_LDB(B0, 0, 0); PG8_SCHED; PG8_LDA(At, 0, 0); PG8_STAGE(PG8_SA(1, 1), a1 + hstep, voffA);
            PG8_WAIT_L(8); PG8_BAR; PG8_WAIT_L(0); PG8_MMA(0, 0, At, B0); PG8_BAR; PG8_SCHED;
            PG8_LDB(B1, 0, 1); PG8_STAGE(PG8_SB(0, 0), b2, voffB);
            PG8_BAR; PG8_WAIT_L(0); PG8_MMA(0, 1, At, B1); PG8_BAR;
            PG8_LDA(At, 0, 1); PG8_STAGE(PG8_SA(0, 0), a2, voffA);
            PG8_BAR; PG8_WAIT_L(0); PG8_MMA(1, 0, At, B0); PG8_BAR; PG8_SCHED;
            PG8_STAGE(PG8_SB(0, 1), b2 + hstep, voffB);
            PG8_WAIT_V(6); PG8_BAR; PG8_MMA(1, 1, At, B1); PG8_BAR;
            PG8_LDB(B0, 1, 0); PG8_SCHED; PG8_LDA(At, 1, 0); PG8_STAGE(PG8_SA(0, 1), a2 + hstep, voffA);
            PG8_WAIT_L(8); PG8_BAR; PG8_WAIT_L(0); PG8_MMA(0, 0, At, B0); PG8_BAR; PG8_SCHED;
            PG8_LDB(B1, 1, 1); PG8_STAGE(PG8_SB(1, 0), b3, voffB);
            PG8_BAR; PG8_WAIT_L(0); PG8_MMA(0, 1, At, B1); PG8_BAR;
            PG8_LDA(At, 1, 1); PG8_STAGE(PG8_SA(1, 0), a3, voffA);
            PG8_BAR; PG8_WAIT_L(0); PG8_MMA(1, 0, At, B0); PG8_BAR; PG8_SCHED;
            PG8_STAGE(PG8_SB(1, 1), b3 + hstep, voffB);
            PG8_WAIT_V(6); PG8_BAR; PG8_MMA(1, 1, At, B1); PG8_BAR;
            }
        }
        if constexpr (ALIGN_EPI) { if (wr == 0) PG8_BAR; }
        if constexpr (!Epi::AFTER_DRAIN) { E(acc, cur, wr, wc, fr, fq); S.done(cur); }
        if (!has_next) break;
#pragma unroll
        for (int a = 0; a < 2; ++a)
#pragma unroll
            for (int b = 0; b < 2; ++b)
#pragma unroll
                for (int m = 0; m < 4; ++m)
#pragma unroll
                    for (int n = 0; n < 2; ++n) acc[a][b][m][n] = (f32x4){0.f, 0.f, 0.f, 0.f};
        cur = nxt; cA = nA; cB = nB; ++ui;
        if constexpr (ALIGN_EPI) { if (wr == 1) PG8_BAR; }
    }
    PG8_WAIT_V(0);
    if constexpr (!ALIGN_EPI) { if (wr == 0) PG8_BAR; }
    PG8_BAR;
    if constexpr (Epi::AFTER_DRAIN) { E.fused(acc, cur, wr, wc, fr, fq, lds, wid, lane); S.done(cur); }
#undef PG8_SA
#undef PG8_SB
#undef PG8_STAGE
#undef PG8_LDA
#undef PG8_LDB
#undef PG8_MMA
#undef PG8_WAIT_V
#undef PG8_WAIT_L
#undef PG8_BAR
#undef PG8_SCHED
}
}
#define GAS __attribute__((address_space(1)))
#define LAS __attribute__((address_space(3)))
typedef unsigned short bf16;
typedef unsigned v4u __attribute__((ext_vector_type(4)));
typedef float f32x4 __attribute__((ext_vector_type(4)));
typedef short bf16x8 __attribute__((ext_vector_type(8)));
typedef GAS unsigned gu32;
typedef GAS unsigned long long gu64;
#define RLX_AGENT __ATOMIC_RELAXED, __HIP_MEMORY_SCOPE_AGENT
#define LDS_WAIT() asm volatile("s_waitcnt lgkmcnt(0)" ::: "memory")
#define VM_WAIT() asm volatile("s_waitcnt vmcnt(0)" ::: "memory")
__device__ __forceinline__ unsigned long long rt() { return __builtin_amdgcn_s_memrealtime(); }
__device__ __forceinline__ unsigned f2bf(float f) { unsigned u = __builtin_bit_cast(unsigned, f); return (u + 0x7fffu + ((u >> 16) & 1u)) >> 16; }
__device__ __forceinline__ unsigned pk2(float lo, float hi) { return f2bf(lo) | (f2bf(hi) << 16); }

#define XB_TMO      128
#define XB_XCNT(j)  (256  + 64 * (j))
#define XB_XSUB(j)  (1280 + 64 * (j))
#define XB_XGEN(j)  (2304 + 64 * (j))
#define XB_TOP      3328
#define XB_TOPGEN   3392
#define XCD_BAR_WORDS 3456
#define XB_SPIN_CAP (1u << 18)

__device__ __forceinline__ unsigned xb_ld(unsigned* p)              { return __hip_atomic_load(p, __ATOMIC_RELAXED, __HIP_MEMORY_SCOPE_AGENT); }
__device__ __forceinline__ unsigned xb_add(unsigned* p, unsigned v) { return __hip_atomic_fetch_add(p, v, __ATOMIC_RELAXED, __HIP_MEMORY_SCOPE_AGENT); }
__device__ __forceinline__ unsigned xb_xcc_id() { return (unsigned)__builtin_amdgcn_s_getreg((3 << 11) | 20) & 0xFu; }
#define XB_SPIN(cond, bar) do { unsigned _sp = 0; while (cond) { __builtin_amdgcn_s_sleep(1); \
    if ((++_sp & 255u) == 0u) { if (xb_ld(&(bar)[XB_TMO])) break; if (_sp > XB_SPIN_CAP) { atomicAdd(&(bar)[XB_TMO], 1u); break; } } } } while (0)

struct XcdBarrier {
    unsigned* bar; unsigned x;
    volatile LAS unsigned* st;
};

__device__ __forceinline__ XcdBarrier xcd_barrier_post(unsigned* bar, volatile LAS unsigned* st) {
    XcdBarrier b; b.bar = bar; b.x = xb_xcc_id(); b.st = st;
    if (threadIdx.x == 0) (void)xb_add(&bar[XB_XCNT(b.x)], 1u);
    return b;
}
__device__ __forceinline__ void xcd_barrier_complete(unsigned* bar, unsigned x, unsigned& nloc, unsigned& nx) {
    const unsigned G = gridDim.x * gridDim.y * gridDim.z;
    unsigned sum, cnt, mine, sp = 0u;
    for (;;) {
        sum = 0u; cnt = 0u; mine = 0u;
#pragma unroll
        for (unsigned j = 0; j < 16; ++j) { const unsigned c = xb_ld(&bar[XB_XCNT(j)]); sum += c; cnt += (c > 0u) ? 1u : 0u; mine = (j == x) ? c : mine; }
        if (sum == G) break;
        __builtin_amdgcn_s_sleep(1);
        if ((++sp & 255u) == 0u) { if (xb_ld(&bar[XB_TMO])) break; if (sp > XB_SPIN_CAP) { atomicAdd(&bar[XB_TMO], 1u); break; } }
    }
    nloc = mine > 0u ? mine : 1u; nx = cnt > 0u ? cnt : 1u;
}

__device__ __forceinline__ void xcd_barrier(const XcdBarrier& b) {
    asm volatile("s_waitcnt vmcnt(0)" ::: "memory");
    __syncthreads();
    if (threadIdx.x == 0) {
        unsigned* bar = b.bar;
        __builtin_amdgcn_s_waitcnt(0);
        unsigned nloc = b.st[0], nx = b.st[1];
        if (nloc == 0u) { xcd_barrier_complete(bar, b.x, nloc, nx); b.st[0] = nloc; b.st[1] = nx; }
        const unsigned old = xb_add(&bar[XB_XSUB(b.x)], 1u);
        const unsigned gen = old / nloc;
        if (old + 1u == (gen + 1u) * nloc) {
            __builtin_amdgcn_fence(__ATOMIC_RELEASE, "agent");
            asm volatile("s_waitcnt vmcnt(0)" ::: "memory");
            const unsigned og = xb_add(&bar[XB_TOP], 1u);
            const unsigned tg = og / nx;
            if (og + 1u == (tg + 1u) * nx) xb_add(&bar[XB_TOPGEN], 1u);
            else XB_SPIN(xb_ld(&bar[XB_TOPGEN]) == tg, bar);
            __builtin_amdgcn_fence(__ATOMIC_ACQUIRE, "agent");
            xb_add(&bar[XB_XGEN(b.x)], 1u);
            asm volatile("s_waitcnt vmcnt(0)" ::: "memory");
        } else {
            XB_SPIN(xb_ld(&bar[XB_XGEN(b.x)]) == gen, bar);
            __builtin_amdgcn_fence(__ATOMIC_ACQUIRE, "agent");
            asm volatile("s_waitcnt vmcnt(0)" ::: "memory");
        }
    }
    __syncthreads();
}
constexpr int NWAVES = 8, NT = NWAVES * 64;
constexpr int DM = 1024, NB_P = 8, SEQ = 2048, NB_S = 128, LS = 8;
constexpr int MP = NB_P * SEQ, MS = NB_S * LS, M = MP + MS;
constexpr int NSEQ = NB_P + NB_S;
constexpr int IN_DIM = 6688, IN_PAD = 6912, PITCH = IN_DIM;
constexpr int PC_Z = 0, PC_XBC = 1024, PC_QKV = 2560, PC_GATE = 5632, PC_DT = 6656, PC_BETA = 6672, PC_ALPHA = 6680;
constexpr int DMIX = 2048, DFF = 2816, NGU = 2 * DFF, NMOD = 6 * DM;
constexpr int SSD_H = 16, SSD_P = 64, SSD_N = 128, SSD_CONV = 1536, GDN_H = 8, GDN_D = 128, GDN_CONV = 3072;
constexpr float EPS = 1e-6f;
constexpr size_t OFF_Y = 0, OFF_SSD_P = (size_t)M * DM, OFF_SSDC_P = OFF_SSD_P + (size_t)NB_P * SSD_H * SSD_P * SSD_N, OFF_GDN_P = OFF_SSDC_P + (size_t)NB_P * 3 * SSD_CONV,
                 OFF_GDNC_P = OFF_GDN_P + (size_t)NB_P * GDN_H * GDN_D * GDN_D, OFF_SSD_S = OFF_GDNC_P + (size_t)NB_P * 3 * GDN_CONV, OFF_SSDC_S = OFF_SSD_S + (size_t)NB_S * SSD_H * SSD_P * SSD_N,
                 OFF_GDN_S = OFF_SSDC_S + (size_t)NB_S * 3 * SSD_CONV, OFF_GDNC_S = OFF_GDN_S + (size_t)NB_S * GDN_H * GDN_D * GDN_D, OUT_TOTAL = OFF_GDNC_S + (size_t)NB_S * 3 * GDN_CONV;
static_assert(OUT_TOTAL == 55357440, "output size");
constexpr size_t MiB = 1u << 20;
constexpr size_t WS_CTL = 0, CTL_ZERO_BYTES = 1 * MiB;
constexpr size_t WS_WOUT = 1 * MiB, WS_WGU = 5 * MiB, WS_WDN = 16 * MiB, WS_MOD = 22 * MiB, WS_SSQ = 26 * MiB, WS_PROJ = 28 * MiB;
constexpr size_t PROJ_BYTES = (size_t)M * PITCH * 2;
constexpr size_t WS_T1 = WS_PROJ, WS_XN2 = WS_PROJ + 68 * MiB, WS_ACT = WS_PROJ + 102 * MiB, WS_T2 = WS_PROJ;
constexpr size_t WS_END = 251 * MiB;
static_assert(WS_WOUT + (size_t)DM * DMIX * 2 <= WS_WGU && WS_WGU + (size_t)NGU * DM * 2 <= WS_WDN && WS_WDN + (size_t)DM * DFF * 2 <= WS_MOD && WS_MOD + (size_t)NSEQ * NMOD * 4 <= WS_SSQ && WS_SSQ + (size_t)M * 16 * 4 <= WS_PROJ, "ws map");
static_assert(WS_PROJ + PROJ_BYTES <= WS_END && (size_t)M * DM * 4 <= 68 * MiB && (size_t)M * DM * 2 <= 34 * MiB && WS_ACT + (size_t)M * DFF * 2 <= WS_PROJ + PROJ_BYTES, "ws overlays");
static_assert((size_t)IN_PAD * DM * 2 <= (size_t)NB_S * SSD_H * SSD_P * SSD_N * 4 && (size_t)M * DM * 2 <= (size_t)NB_S * GDN_H * GDN_D * GDN_D * 4 && (size_t)M * DMIX * 2 == (size_t)M * DM * 4, "d_out scratch");
constexpr int CW_TMO = 0, CW_CODE = 1, CW_QUEUE = 64, CW_BAR = 4096;
constexpr int RING_OFF = 0, RING_BYTES = 131072, LDS_BYTES = 147456, LDSCTL_OFF = LDS_BYTES - 1024, MISC_OFF = LDSCTL_OFF + 320;
struct Args { const float* in[28]; float* out; unsigned char* ws; int ph_lo, ph_hi, li, pad; };
enum { I_XP = 0, I_XS, I_CP, I_CS, I_SSD, I_SSDC, I_GDN, I_GDNC, I_WADA, I_BADA, I_NMPRE, I_NMPOST, I_NFPRE, I_NFPOST, I_WIN, I_SCW, I_SCB, I_SDTB, I_SALOG, I_SD, I_SNW, I_GCW, I_GDTB, I_GALOG, I_GNW, I_WOUT, I_WGU, I_WDN };
__device__ __forceinline__ float bf2f(unsigned v) { return __uint_as_float(v << 16); }
__device__ __forceinline__ float silu_acc(float x) { return x / (1.f + expf(-x)); }
__device__ __forceinline__ float softplus_acc(float x) { return fmaxf(x, 0.f) + log1pf(expf(-fabsf(x))); }
__device__ __forceinline__ float wave_sum(float v) {
#pragma unroll
    for (int o = 1; o < 64; o <<= 1) v += __shfl_xor(v, o);
    return v;
}
__device__ __forceinline__ bf16* ws_bf(const Args& a, size_t off) { return (bf16*)(a.ws + off); }
__device__ __forceinline__ float* ws_f(const Args& a, size_t off) { return (float*)(a.ws + off); }
__device__ __forceinline__ bf16* win_t(const Args& a) { return (bf16*)(a.out + OFF_SSD_S); }
__device__ __forceinline__ bf16* xn_buf(const Args& a) { return (bf16*)(a.out + OFF_GDN_S); }
__device__ __forceinline__ bf16* mixed_buf(const Args& a) { return (bf16*)(a.out + OFF_Y); }
__device__ __forceinline__ const float* x_row(const Args& a, int row) { return row < MP ? a.in[I_XP] + (size_t)row * DM : a.in[I_XS] + (size_t)(row - MP) * DM; }
__device__ __forceinline__ int seq_of_row(int row) { return row < MP ? (row >> 11) : NB_P + ((row - MP) >> 3); }

__device__ __forceinline__ int dest_row(int which, int n) {
    if (which == 1) { if (n < 2560) return n; if (n < 2576) return PC_DT + (n - 2560); if (n < 6672) return n - 16; return n; }
    if (which == 2) { const int j = n < DFF ? n : n - DFF; return 256 * (j >> 7) + (n < DFF ? 0 : 128) + (j & 127); }
    return n;
}
__device__ __forceinline__ void p0_transpose_item(const float* W, int K, int N, bf16* WT, int which, LAS float* scr, int item, int lane) {
    const int nblk = N / 32, kb = item / nblk, nb = item % nblk, k0 = 64 * kb, n0 = 32 * nb;
#pragma unroll 8
    for (int i = 0; i < 32; ++i) { const int kk = 2 * i + (lane >> 5); scr[kk * 33 + (lane & 31)] = W[(size_t)(k0 + kk) * N + n0 + (lane & 31)]; }
    LDS_WAIT(); asm volatile("" ::: "memory");
    const int c = lane & 7;
#pragma unroll
    for (int j = 0; j < 4; ++j) { const int n = (lane >> 3) + 8 * j; const LAS float* s = scr + (8 * c) * 33 + n;
        v4u o; o.x = pk2(s[0 * 33], s[1 * 33]); o.y = pk2(s[2 * 33], s[3 * 33]); o.z = pk2(s[4 * 33], s[5 * 33]); o.w = pk2(s[6 * 33], s[7 * 33]);
        *(GAS v4u*)(WT + (size_t)dest_row(which, n0 + n) * K + k0 + 8 * c) = o; }
    LDS_WAIT(); asm volatile("" ::: "memory");
}
constexpr int TI_IN = (DM / 64) * (IN_DIM / 32), TI_OUT = (DMIX / 64) * (DM / 32), TI_GU = (DM / 64) * (NGU / 32), TI_DN = (DFF / 64) * (DM / 32), TI_PAD = IN_PAD - IN_DIM;
constexpr int TI_ALL = TI_IN + TI_OUT + TI_GU + TI_DN + TI_PAD;
constexpr int ADA_RB = 17, ADA_ITEMS = (NSEQ / ADA_RB) * (NMOD / 512);
static_assert(NSEQ % ADA_RB == 0 && IN_DIM % 32 == 0 && NGU % 32 == 0 && DFF % 64 == 0, "P0 tiling");
__device__ __forceinline__ void p0_ada_item(const Args& a, LAS unsigned char* lds, int it, int tid, int wave, int lane) {
    LAS float* cs = (LAS float*)lds;
    const int rb = it / (NMOD / 512), cb = it % (NMOD / 512);
    for (int idx = tid; idx < ADA_RB * DM; idx += NT) { const int r = idx >> 10, k = idx & 1023, row = ADA_RB * rb + r;
        const float c = row < NB_P ? a.in[I_CP][row * DM + k] : a.in[I_CS][(row - NB_P) * DM + k]; cs[idx] = silu_acc(c); }
    __syncthreads();
    const int n = 512 * cb + 64 * wave + lane;
    const float* wp = a.in[I_WADA] + n;
    float acc[ADA_RB];
#pragma unroll
    for (int r = 0; r < ADA_RB; ++r) acc[r] = 0.f;
    for (int k = 0; k < DM; k += 4) {
        const float w0 = wp[(size_t)(k + 0) * NMOD], w1 = wp[(size_t)(k + 1) * NMOD], w2 = wp[(size_t)(k + 2) * NMOD], w3 = wp[(size_t)(k + 3) * NMOD];
#pragma unroll
        for (int r = 0; r < ADA_RB; ++r) { const f32x4 c4 = *(const LAS f32x4*)(cs + r * DM + k); acc[r] += c4.x * w0; acc[r] += c4.y * w1; acc[r] += c4.z * w2; acc[r] += c4.w * w3; }
    }
    float* mod = ws_f(a, WS_MOD); const float b = a.in[I_BADA][n];
#pragma unroll
    for (int r = 0; r < ADA_RB; ++r) mod[(size_t)(ADA_RB * rb + r) * NMOD + n] = acc[r] + b;
    __syncthreads();
}
__device__ __forceinline__ void p0_prologue(const Args& a, LAS unsigned char* lds, int bid, int G, int tid, int wave, int lane) {
    const bool split = G > 128;
    const int ada_lo = 0, ada_G = split ? ADA_ITEMS : G;
    if (!split || bid < ADA_ITEMS) for (int it = bid - ada_lo; it < ADA_ITEMS; it += ada_G) p0_ada_item(a, lds, it, tid, wave, lane);
    if (!split || bid >= ADA_ITEMS) {
        LAS float* scr = (LAS float*)(lds + wave * 16384);
        const int gw = (split ? bid - ADA_ITEMS : bid) * NWAVES + wave, NGW = (split ? G - ADA_ITEMS : G) * NWAVES;
        for (int it = gw; it < TI_ALL; it += NGW) {
            int r = it;
            if (r < TI_IN) { p0_transpose_item(a.in[I_WIN], DM, IN_DIM, win_t(a), 1, scr, r, lane); continue; } r -= TI_IN;
            if (r < TI_OUT) { p0_transpose_item(a.in[I_WOUT], DMIX, DM, ws_bf(a, WS_WOUT), 0, scr, r, lane); continue; } r -= TI_OUT;
            if (r < TI_GU) { p0_transpose_item(a.in[I_WGU], DM, NGU, ws_bf(a, WS_WGU), 2, scr, r, lane); continue; } r -= TI_GU;
            if (r < TI_DN) { p0_transpose_item(a.in[I_WDN], DFF, DM, ws_bf(a, WS_WDN), 0, scr, r, lane); continue; } r -= TI_DN;
            { GAS v4u* o = (GAS v4u*)(win_t(a) + (size_t)(IN_DIM + r) * DM) + lane; o[0] = (v4u){0u, 0u, 0u, 0u}; o[64] = (v4u){0u, 0u, 0u, 0u}; }
        }
    }
}
__device__ __forceinline__ void p1_xn(const Args& a, int gw, int NGW, int lane) {
    const float* mod = ws_f(a, WS_MOD); bf16* XN = xn_buf(a); const float* nw = a.in[I_NMPRE];
    for (int row = gw; row < M; row += NGW) {
        const f32x4* xr = (const f32x4*)x_row(a, row) + lane; const float* mr = mod + (size_t)seq_of_row(row) * NMOD;
        f32x4 v[4]; float s = 0.f;
#pragma unroll
        for (int j = 0; j < 4; ++j) { v[j] = xr[64 * j]; s += (v[j].x * v[j].x + v[j].y * v[j].y) + (v[j].z * v[j].z + v[j].w * v[j].w); }
        const float rs = 1.f / sqrtf(wave_sum(s) * (1.f / DM) + EPS);
        unsigned long long* o8 = (unsigned long long*)(XN + (size_t)row * DM) + lane;
#pragma unroll
        for (int j = 0; j < 4; ++j) { const int c = 4 * lane + 256 * j; const f32x4 w = *(const f32x4*)(nw + c), sh = *(const f32x4*)(mr + c), sc = *(const f32x4*)(mr + DM + c);
            const f32x4 h = v[j] * rs * w * (sc + 1.f) + sh;
            o8[64 * j] = (unsigned long long)pk2(h.x, h.y) | ((unsigned long long)pk2(h.z, h.w) << 32); }
    }
}
typedef short bf16x8 __attribute__((ext_vector_type(8)));
typedef unsigned u32x2 __attribute__((ext_vector_type(2)));
constexpr int P128 = 136, P64 = 72, LP = 68, TP = 36;
#define MFMA16(a, b, c) __builtin_amdgcn_mfma_f32_16x16x32_bf16(a, b, c, 0, 0, 0)
__device__ __forceinline__ bf16x8 ldfrag(const LAS bf16* base, int pitch, int row0, int k0, int lane) { return *(const LAS bf16x8*)(base + (row0 + (lane & 15)) * pitch + k0 + 8 * (lane >> 4)); }
typedef float f32x2_t __attribute__((ext_vector_type(2))); typedef __bf16 bf16x2_t __attribute__((ext_vector_type(2)));
__device__ __forceinline__ unsigned cvtpk(float lo, float hi) { f32x2_t v = {lo, hi}; bf16x2_t b = __builtin_convertvector(v, bf16x2_t); return __builtin_bit_cast(unsigned, b); }
__device__ __forceinline__ u32x2 pack4(f32x4 v) { u32x2 r; r.x = cvtpk(v[0], v[1]); r.y = cvtpk(v[2], v[3]); return r; }
__device__ __forceinline__ float silu_f(float x) { return x * __builtin_amdgcn_rcpf(1.f + __expf(-x)); }
__device__ __forceinline__ void unpack8(v4u r, float (&x)[8]) { x[0] = bf2f(r.x & 0xffffu); x[1] = __uint_as_float(r.x & 0xffff0000u); x[2] = bf2f(r.y & 0xffffu); x[3] = __uint_as_float(r.y & 0xffff0000u);
    x[4] = bf2f(r.z & 0xffffu); x[5] = __uint_as_float(r.z & 0xffff0000u); x[6] = bf2f(r.w & 0xffffu); x[7] = __uint_as_float(r.w & 0xffff0000u); }
__device__ __forceinline__ v4u tpack(const unsigned (&outp)[8][4], int c) { const int cp = c >> 1; const unsigned sel = (c & 1) ? 0x07060302u : 0x05040100u; v4u o;
    o.x = __builtin_amdgcn_perm(outp[1][cp], outp[0][cp], sel); o.y = __builtin_amdgcn_perm(outp[3][cp], outp[2][cp], sel); o.z = __builtin_amdgcn_perm(outp[5][cp], outp[4][cp], sel); o.w = __builtin_amdgcn_perm(outp[7][cp], outp[6][cp], sel); return o; }
__device__ __forceinline__ void conv8x8(const v4u (&R)[11], const float (&cw)[4][8], const float (&cb)[8], unsigned (&outp)[8][4], float (&ssq)[8]) {
    float acc[4][8];
#pragma unroll
    for (int i = 0; i < 11; ++i) { float x[8]; unpack8(R[i], x);
#pragma unroll
        for (int j = 0; j < 4; ++j) { const int l = i - j;
            if (l >= 0 && l < 8) {
#pragma unroll
                for (int c = 0; c < 8; ++c) acc[l & 3][c] = (j == 0 ? cb[c] : acc[l & 3][c]) + cw[j][c] * x[c]; } }
        if (i >= 3) { const int l = i - 3; float s = 0.f;
#pragma unroll
            for (int c = 0; c < 8; ++c) { acc[l & 3][c] = silu_f(acc[l & 3][c]); s += acc[l & 3][c] * acc[l & 3][c]; }
            ssq[l] = s;
#pragma unroll
            for (int cp = 0; cp < 4; ++cp) outp[l][cp] = cvtpk(acc[l & 3][2 * cp], acc[l & 3][2 * cp + 1]); } }
}
__device__ __forceinline__ void lower_pair(int p, int& i, int& j) { i = p >= 6 ? 3 : (p >= 3 ? 2 : (p >= 1 ? 1 : 0)); j = p - (i * (i + 1)) / 2; }
__device__ __forceinline__ void upper_pair(int z, int& i, int& j) { i = z >= 5 ? 2 : (z >= 3 ? 1 : 0); j = z >= 5 ? 3 : (z >= 3 ? z - 1 : z + 1); }
__device__ __forceinline__ void tri_inverse64(LAS float* Lm, LAS float* tmp, int wave, int lane) {
    const int c = lane & 15, q = lane >> 4;
    if (wave == 0) {
        LAS float* Lb = Lm + (16 * q) * LP + 16 * q; float t[16];
#pragma unroll
        for (int l = 0; l < 16; ++l) { float acc = (l == c) ? 1.f : 0.f;
#pragma unroll
            for (int s = 0; s < l; ++s) acc -= Lb[l * LP + s] * t[s];
            t[l] = acc; }
#pragma unroll
        for (int l = 0; l < 16; ++l) Lb[l * LP + c] = t[l];
    }
    __syncthreads();
    if (wave < 2) {
        const int o = 32 * wave; f32x4 acc = (f32x4){0.f, 0.f, 0.f, 0.f};
#pragma unroll
        for (int kk = 0; kk < 4; ++kk) acc = __builtin_amdgcn_mfma_f32_16x16x4f32(Lm[(o + 16 + c) * LP + o + 4 * kk + q], Lm[(o + 4 * kk + q) * LP + o + c], acc, 0, 0, 0);
#pragma unroll
        for (int r = 0; r < 4; ++r) tmp[(16 * wave + 4 * q + r) * TP + c] = acc[r];
    }
    __syncthreads();
    if (wave < 2) {
        const int o = 32 * wave; f32x4 acc = (f32x4){0.f, 0.f, 0.f, 0.f};
#pragma unroll
        for (int kk = 0; kk < 4; ++kk) acc = __builtin_amdgcn_mfma_f32_16x16x4f32(Lm[(o + 16 + c) * LP + o + 16 + 4 * kk + q], tmp[(16 * wave + 4 * kk + q) * TP + c], acc, 0, 0, 0);
#pragma unroll
        for (int r = 0; r < 4; ++r) Lm[(o + 16 + 4 * q + r) * LP + o + c] = -acc[r];
    }
    __syncthreads();
    if (wave < 4) {
        const int ti = wave >> 1, tj = wave & 1; f32x4 acc = (f32x4){0.f, 0.f, 0.f, 0.f};
#pragma unroll
        for (int kk = 0; kk < 8; ++kk) acc = __builtin_amdgcn_mfma_f32_16x16x4f32(Lm[(32 + 16 * ti + c) * LP + 4 * kk + q], Lm[(4 * kk + q) * LP + 16 * tj + c], acc, 0, 0, 0);
#pragma unroll
        for (int r = 0; r < 4; ++r) tmp[(16 * ti + 4 * q + r) * TP + 16 * tj + c] = acc[r];
    }
    __syncthreads();
    if (wave < 4) {
        const int ti = wave >> 1, tj = wave & 1; f32x4 acc = (f32x4){0.f, 0.f, 0.f, 0.f};
#pragma unroll
        for (int kk = 0; kk < 8; ++kk) acc = __builtin_amdgcn_mfma_f32_16x16x4f32(Lm[(32 + 16 * ti + c) * LP + 32 + 4 * kk + q], tmp[(4 * kk + q) * TP + 16 * tj + c], acc, 0, 0, 0);
#pragma unroll
        for (int r = 0; r < 4; ++r) Lm[(32 + 16 * ti + 4 * q + r) * LP + 16 * tj + c] = -acc[r];
    }
    __syncthreads();
}
constexpr int G_Q = 0, G_T1 = 0, G_T2 = 9216, G_K = 18432, G_W = 18432, G_KT = 35840, G_VT = 54272, G_VN = 54272, G_L = 72704, G_VNS = 72704, G_PART = 72704, G_ATT = 91136, G_TMP = 100352, G_ST = 104960, G_VEC = 139776;
static_assert(G_VEC + 11 * 256 <= LDSCTL_OFF, "GDN LDS map");
__device__ __forceinline__ void gdn_chunk_item(const Args& a, LAS unsigned char* lds, int b, int h, int tid_, int wave, int lane_) {
    const bf16* proj = ws_bf(a, WS_PROJ); bf16* mixed = mixed_buf(a);
    const int row0 = b * SEQ;
    LAS bf16* Lq = (LAS bf16*)(lds + G_Q); LAS bf16* Lk = (LAS bf16*)(lds + G_K); LAS bf16* LkT = (LAS bf16*)(lds + G_KT); LAS bf16* LvT = (LAS bf16*)(lds + G_VT);
    LAS bf16* LT1 = (LAS bf16*)(lds + G_T1); LAS bf16* LT2 = (LAS bf16*)(lds + G_T2); LAS bf16* LW = (LAS bf16*)(lds + G_W); LAS bf16* Lvn = (LAS bf16*)(lds + G_VN); LAS bf16* Lvns = (LAS bf16*)(lds + G_VNS);
    LAS bf16* Latt = (LAS bf16*)(lds + G_ATT); LAS bf16* LST = (LAS bf16*)(lds + G_ST); LAS float* LL = (LAS float*)(lds + G_L); LAS float* Ltmp = (LAS float*)(lds + G_TMP); LAS float* Lpart = (LAS float*)(lds + G_PART);
    LAS float* vgc = (LAS float*)(lds + G_VEC); LAS float* vbeta = vgc + 64; LAS float* vrq = vgc + 128; LAS float* vrk = vgc + 192; LAS float* vqs = vgc + 256; LAS float* vvsc = vgc + 320; LAS float* vt2s = vgc + 384; LAS float* vossq = vgc + 448; LAS float* vmisc = vgc + 576;
    const float Ag = -expf(a.in[I_GALOG][h]), dtb = a.in[I_GDTB][h];
    const float cb[8] = {0.f, 0.f, 0.f, 0.f, 0.f, 0.f, 0.f, 0.f};
    f32x4 Sacc[4][2];
#pragma unroll
    for (int x = 0; x < 4; ++x)
#pragma unroll
        for (int d = 0; d < 2; ++d) Sacc[x][d] = (f32x4){0.f, 0.f, 0.f, 0.f};
    for (int i = tid_; i < 128 * P128 / 2; i += NT) ((LAS unsigned*)LST)[i] = 0u;
    const int li = wave >> 1, dvh = wave & 1;
    for (int ch = 0; ch < SEQ / 64; ++ch) {
        const int t0 = 64 * ch;
        int lane = lane_;
        asm volatile("" : "+v"(lane));
        const int tid = wave * 64 + lane, c16 = lane & 15, q4 = lane >> 4, oct = tid % 48, tg = tid / 48, seg = oct >> 4, c0 = 8 * (oct & 15);
        if (tid < 384) {
            v4u R[11]; const bf16* src = (proj + (size_t)(row0 + t0 - 3) * PITCH + PC_QKV + h * 128) + (unsigned)(8 * tg * PITCH + seg * 1024 + c0);
#pragma unroll
            for (int i = 0; i < 11; ++i) R[i] = (t0 + 8 * tg - 3 + i >= 0) ? *(const v4u*)(src + (size_t)i * PITCH) : (v4u){0u, 0u, 0u, 0u};
            float cw[4][8];
#pragma unroll
            for (int j = 0; j < 4; ++j) { const f32x4 w0 = *(const f32x4*)(a.in[I_GCW] + j * GDN_CONV + seg * 1024 + h * 128 + c0), w1 = *(const f32x4*)(a.in[I_GCW] + j * GDN_CONV + seg * 1024 + h * 128 + c0 + 4);
                cw[j][0] = w0.x; cw[j][1] = w0.y; cw[j][2] = w0.z; cw[j][3] = w0.w; cw[j][4] = w1.x; cw[j][5] = w1.y; cw[j][6] = w1.z; cw[j][7] = w1.w; }
            unsigned outp[8][4]; float ssq[8];
            conv8x8(R, cw, cb, outp, ssq);
            if (seg < 2) { LAS bf16* dst = (seg == 0 ? Lq : Lk) + (8 * tg) * P128 + c0;
#pragma unroll
                for (int l = 0; l < 8; ++l) { *(LAS v4u*)(dst + l * P128) = (v4u){outp[l][0], outp[l][1], outp[l][2], outp[l][3]}; Lpart[(seg * 64 + 8 * tg + l) * 16 + (oct & 15)] = ssq[l]; } }
            if (seg >= 1) { LAS bf16* dst = (seg == 1 ? LkT : LvT) + c0 * P64 + 8 * tg;
#pragma unroll
                for (int c = 0; c < 8; ++c) *(LAS v4u*)(dst + c * P64) = tpack(outp, c); }
        } else if (wave == 6) {
            const size_t r = (size_t)(row0 + t0 + lane) * PITCH;
            const float g = Ag * softplus_acc(bf2f(proj[r + PC_ALPHA + h]) + dtb), be = 1.f / (1.f + __expf(-bf2f(proj[r + PC_BETA + h])));
            float gc = g;
#pragma unroll
            for (int d = 1; d < 64; d <<= 1) { const float v = __shfl_up(gc, d); if (lane >= d) gc += v; }
            vgc[lane] = gc; vbeta[lane] = be;
        }
        __syncthreads();
        if (tid < 64) { float sq = 0.f, sk = 0.f;
#pragma unroll
            for (int o = 0; o < 16; ++o) { sq += Lpart[tid * 16 + o]; sk += Lpart[(64 + tid) * 16 + o]; }
            const float rq = 1.f / sqrtf(sq + 1e-6f), rk = 1.f / sqrtf(sk + 1e-6f), gc = vgc[tid], gl = vgc[63], be = vbeta[tid];
            vrq[tid] = rq; vrk[tid] = rk; vqs[tid] = __expf(gc) * rq * 0.08838834764831845f; vvsc[tid] = __expf(gl - gc) * rk; vt2s[tid] = be * __expf(gc) * rk;
            if (tid == 0) vmisc[0] = __expf(gl); }
        __syncthreads();
        f32x4 oacc[4];
#pragma unroll
        for (int tt = 0; tt < 4; ++tt) oacc[tt] = (f32x4){0.f, 0.f, 0.f, 0.f};
#pragma unroll
        for (int ks = 0; ks < 4; ++ks) { const bf16x8 qf = ldfrag(Lq, P128, 16 * li, 32 * ks, lane);
#pragma unroll
            for (int tt = 0; tt < 4; ++tt) oacc[tt] = MFMA16(ldfrag(LST, P128, 16 * (4 * dvh + tt), 32 * ks, lane), qf, oacc[tt]); }
        for (int job = wave; job < 20; job += 8) { const int type = job >= 10 ? 1 : 0; int ti, tj; lower_pair(job - 10 * type, ti, tj);
            f32x4 acc = (f32x4){0.f, 0.f, 0.f, 0.f}; const LAS bf16* Y = type ? Lq : Lk;
#pragma unroll
            for (int ks = 0; ks < 4; ++ks) acc = MFMA16(ldfrag(Lk, P128, 16 * tj, 32 * ks, lane), ldfrag(Y, P128, 16 * ti, 32 * ks, lane), acc);
            const int l = 16 * ti + c16, s0 = 16 * tj + 4 * q4; const float gcl = vgc[l]; const f32x4 gcs = *(const LAS f32x4*)(vgc + s0), rks = *(const LAS f32x4*)(vrk + s0);
            const float rowf = type ? vrq[l] * 0.08838834764831845f : vbeta[l] * vrk[l]; f32x4 val;
#pragma unroll
            for (int r = 0; r < 4; ++r) { const bool ok = type ? (s0 + r <= l) : (s0 + r < l); val[r] = ok ? acc[r] * rowf * rks[r] * __expf(gcl - gcs[r]) : 0.f; }
            if (type == 0) *(LAS f32x4*)(LL + l * LP + s0) = val; else *(LAS u32x2*)(Latt + l * P64 + s0) = pack4(val); }
        for (int z = wave; z < 12; z += 8) { int ti, tj; upper_pair(z >= 6 ? z - 6 : z, ti, tj); const int l = 16 * ti + c16, s0 = 16 * tj + 4 * q4;
            if (z < 6) *(LAS f32x4*)(LL + l * LP + s0) = (f32x4){0.f, 0.f, 0.f, 0.f}; else *(LAS u32x2*)(Latt + l * P64 + s0) = (u32x2){0u, 0u}; }
        __syncthreads();
        tri_inverse64(LL, Ltmp, wave, lane);
        { const int l = tid >> 3, s0 = 8 * (tid & 7); const f32x4 ta = *(const LAS f32x4*)(LL + l * LP + s0), tb = *(const LAS f32x4*)(LL + l * LP + s0 + 4);
            const f32x4 ba = *(const LAS f32x4*)(vbeta + s0), bb = *(const LAS f32x4*)(vbeta + s0 + 4), sa = *(const LAS f32x4*)(vt2s + s0), sb = *(const LAS f32x4*)(vt2s + s0 + 4);
            const u32x2 p0 = pack4(ta * ba), p1 = pack4(tb * bb), r0 = pack4(ta * sa), r1 = pack4(tb * sb);
            *(LAS v4u*)(LT1 + l * P64 + s0) = (v4u){p0.x, p0.y, p1.x, p1.y}; *(LAS v4u*)(LT2 + l * P64 + s0) = (v4u){r0.x, r0.y, r1.x, r1.y}; }
        __syncthreads();
        f32x4 uacc[4], wacc[4];
#pragma unroll
        for (int lt = 0; lt < 4; ++lt) { uacc[lt] = (f32x4){0.f, 0.f, 0.f, 0.f}; wacc[lt] = (f32x4){0.f, 0.f, 0.f, 0.f}; }
#pragma unroll
        for (int ks = 0; ks < 2; ++ks) { const bf16x8 vf = ldfrag(LvT, P64, 16 * wave, 32 * ks, lane), kf = ldfrag(LkT, P64, 16 * wave, 32 * ks, lane);
#pragma unroll
            for (int lt = 2 * ks; lt < 4; ++lt) { uacc[lt] = MFMA16(ldfrag(LT1, P64, 16 * lt, 32 * ks, lane), vf, uacc[lt]); wacc[lt] = MFMA16(kf, ldfrag(LT2, P64, 16 * lt, 32 * ks, lane), wacc[lt]); } }
#pragma unroll
        for (int lt = 0; lt < 4; ++lt) *(LAS u32x2*)(LW + (16 * lt + c16) * P128 + 16 * wave + 4 * q4) = pack4(wacc[lt]);
        __syncthreads();
        {
            f32x4 ws[4];
#pragma unroll
            for (int lt = 0; lt < 4; ++lt) ws[lt] = (f32x4){0.f, 0.f, 0.f, 0.f};
#pragma unroll
            for (int ks = 0; ks < 4; ++ks) { const bf16x8 sf = ldfrag(LST, P128, 16 * wave, 32 * ks, lane);
#pragma unroll
                for (int lt = 0; lt < 4; ++lt) ws[lt] = MFMA16(ldfrag(LW, P128, 16 * lt, 32 * ks, lane), sf, ws[lt]); }
#pragma unroll
            for (int lt = 0; lt < 4; ++lt) { const f32x4 vn = uacc[lt] - ws[lt]; const f32x4 sc = *(const LAS f32x4*)(vvsc + 16 * lt + 4 * q4);
                *(LAS u32x2*)(Lvn + (16 * wave + c16) * P64 + 16 * lt + 4 * q4) = pack4(vn); *(LAS u32x2*)(Lvns + (16 * wave + c16) * P64 + 16 * lt + 4 * q4) = pack4(vn * sc); }
        }
        __syncthreads();
        {
            const float ge = vmisc[0];
#pragma unroll
            for (int x = 0; x < 4; ++x)
#pragma unroll
                for (int d = 0; d < 2; ++d) Sacc[x][d] = Sacc[x][d] * ge;
#pragma unroll
            for (int ks = 0; ks < 2; ++ks) { bf16x8 kf[4];
#pragma unroll
                for (int x = 0; x < 4; ++x) kf[x] = ldfrag(LkT, P64, 16 * (4 * dvh + x), 32 * ks, lane);
#pragma unroll
                for (int d = 0; d < 2; ++d) { const bf16x8 nf = ldfrag(Lvns, P64, 16 * (2 * li + d), 32 * ks, lane);
#pragma unroll
                    for (int x = 0; x < 4; ++x) Sacc[x][d] = MFMA16(kf[x], nf, Sacc[x][d]); } }
#pragma unroll
            for (int x = 0; x < 4; ++x)
#pragma unroll
                for (int d = 0; d < 2; ++d) *(LAS u32x2*)(LST + (16 * (2 * li + d) + c16) * P128 + 16 * (4 * dvh + x) + 4 * q4) = pack4(Sacc[x][d]);
            const float qsl = vqs[16 * li + c16];
#pragma unroll
            for (int tt = 0; tt < 4; ++tt) oacc[tt] = oacc[tt] * qsl;
            for (int ks = 0; ks < (li >= 2 ? 2 : 1); ++ks) { const bf16x8 af = ldfrag(Latt, P64, 16 * li, 32 * ks, lane);
#pragma unroll
                for (int tt = 0; tt < 4; ++tt) oacc[tt] = MFMA16(ldfrag(Lvn, P64, 16 * (4 * dvh + tt), 32 * ks, lane), af, oacc[tt]); }
            float sq = 0.f;
#pragma unroll
            for (int tt = 0; tt < 4; ++tt) sq += (oacc[tt][0] * oacc[tt][0] + oacc[tt][1] * oacc[tt][1]) + (oacc[tt][2] * oacc[tt][2] + oacc[tt][3] * oacc[tt][3]);
            sq += __shfl_xor(sq, 16); sq += __shfl_xor(sq, 32);
            if (q4 == 0) vossq[(16 * li + c16) * 2 + dvh] = sq;
            const size_t row = (size_t)(row0 + t0 + 16 * li + c16);
            unsigned long long gg[4];
#pragma unroll
            for (int tt = 0; tt < 4; ++tt) gg[tt] = *(const unsigned long long*)(proj + row * PITCH + PC_GATE + h * 128 + 16 * (4 * dvh + tt) + 4 * q4);
            __syncthreads();
            const float rs = 1.f / sqrtf((vossq[(16 * li + c16) * 2] + vossq[(16 * li + c16) * 2 + 1]) * (1.f / GDN_D) + EPS);
#pragma unroll
            for (int tt = 0; tt < 4; ++tt) { const int dv0 = 16 * (4 * dvh + tt) + 4 * q4; const f32x4 w = *(const f32x4*)(a.in[I_GNW] + dv0);
                const float g0 = silu_f(bf2f((unsigned)gg[tt] & 0xffffu)), g1 = silu_f(bf2f(((unsigned)gg[tt]) >> 16)), g2 = silu_f(bf2f((unsigned)(gg[tt] >> 32) & 0xffffu)), g3 = silu_f(bf2f((unsigned)(gg[tt] >> 48)));
                const f32x4 o = oacc[tt] * rs * w * (f32x4){g0, g1, g2, g3};
                *(u32x2*)(mixed + row * DMIX + DM + h * 128 + dv0) = pack4(o); }
        }
    }
    const int c16 = lane_ & 15, q4 = lane_ >> 4;
    float* so = a.out + OFF_GDN_P + ((size_t)b * GDN_H + h) * (GDN_D * GDN_D);
#pragma unroll
    for (int x = 0; x < 4; ++x)
#pragma unroll
        for (int d = 0; d < 2; ++d)
#pragma unroll
            for (int r = 0; r < 4; ++r) so[(size_t)(16 * (4 * dvh + x) + 4 * q4 + r) * GDN_D + 16 * (2 * li + d) + c16] = Sacc[x][d][r];
    __syncthreads();
}
constexpr int S_C = 0, S_B = 17408, S_BT = 34816, S_XT = 53248, S_XWT = 71680, S_M = 90112, S_H = 108544, S_VEC = 143360;
static_assert(S_VEC + 6 * 256 <= LDSCTL_OFF, "SSD LDS map");
__device__ __forceinline__ void ssd_chunk_item(const Args& a, LAS unsigned char* lds, int b, int g, int hp, int tid_, int wave, int lane_) {
    const bf16* proj = ws_bf(a, WS_PROJ); bf16* mixed = mixed_buf(a); float* ssqo = ws_f(a, WS_SSQ);
    const int row0 = b * SEQ, h0 = 8 * g + 2 * hp;
    LAS bf16* LC = (LAS bf16*)(lds + S_C); LAS bf16* LB = (LAS bf16*)(lds + S_B); LAS bf16* LBT = (LAS bf16*)(lds + S_BT); LAS bf16* LXT = (LAS bf16*)(lds + S_XT); LAS bf16* LXW = (LAS bf16*)(lds + S_XWT);
    LAS bf16* LM = (LAS bf16*)(lds + S_M); LAS bf16* LH = (LAS bf16*)(lds + S_H);
    LAS float* vdt = (LAS float*)(lds + S_VEC); LAS float* vacs = vdt + 128;
    const int hh = wave >> 2, wq = wave & 3;
    const float A_h = -expf(a.in[I_SALOG][h0 + (lane_ >> 5 ? 1 : 0)]);
    f32x4 hacc[8];
#pragma unroll
    for (int nt = 0; nt < 8; ++nt) hacc[nt] = (f32x4){0.f, 0.f, 0.f, 0.f};
    for (int i = tid_; i < 2 * 64 * P128 / 2; i += NT) ((LAS unsigned*)LH)[i] = 0u;
    for (int ch = 0; ch < SEQ / 64; ++ch) {
        const int t0 = 64 * ch;
        int lane = lane_;
        asm volatile("" : "+v"(lane));
        const int tid = wave * 64 + lane, c16 = lane & 15, q4 = lane >> 4, oct = tid % 48, tg = tid / 48, seg = oct >> 4, c0 = 8 * (oct & 15);
        if (tid < 384) {
            const int chb = (seg == 0 ? h0 * 64 : (seg == 1 ? 1024 + g * 128 : 1280 + g * 128)) + c0;
            v4u R[11]; const bf16* src = (proj + (size_t)(row0 + t0 - 3) * PITCH + PC_XBC) + (unsigned)(8 * tg * PITCH + chb);
#pragma unroll
            for (int i = 0; i < 11; ++i) R[i] = (t0 + 8 * tg - 3 + i >= 0) ? *(const v4u*)(src + (size_t)i * PITCH) : (v4u){0u, 0u, 0u, 0u};
            float cw[4][8], cb[8];
#pragma unroll
            for (int j = 0; j < 4; ++j) { const f32x4 w0 = *(const f32x4*)(a.in[I_SCW] + j * SSD_CONV + chb), w1 = *(const f32x4*)(a.in[I_SCW] + j * SSD_CONV + chb + 4);
                cw[j][0] = w0.x; cw[j][1] = w0.y; cw[j][2] = w0.z; cw[j][3] = w0.w; cw[j][4] = w1.x; cw[j][5] = w1.y; cw[j][6] = w1.z; cw[j][7] = w1.w; }
            { const f32x4 b0 = *(const f32x4*)(a.in[I_SCB] + chb), b1 = *(const f32x4*)(a.in[I_SCB] + chb + 4); cb[0] = b0.x; cb[1] = b0.y; cb[2] = b0.z; cb[3] = b0.w; cb[4] = b1.x; cb[5] = b1.y; cb[6] = b1.z; cb[7] = b1.w; }
            unsigned outp[8][4]; float ssq[8];
            conv8x8(R, cw, cb, outp, ssq);
            if (seg >= 1) { LAS bf16* dst = (seg == 1 ? LB : LC) + (8 * tg) * P128 + c0;
#pragma unroll
                for (int l = 0; l < 8; ++l) *(LAS v4u*)(dst + l * P128) = (v4u){outp[l][0], outp[l][1], outp[l][2], outp[l][3]}; }
            if (seg <= 1) { LAS bf16* dst = (seg == 0 ? LXT : LBT) + c0 * P64 + 8 * tg;
#pragma unroll
                for (int c = 0; c < 8; ++c) *(LAS v4u*)(dst + c * P64) = tpack(outp, c); }
        } else if (wave == 6) {
#pragma unroll
            for (int e = 0; e < 2; ++e) { const float dtv = softplus_acc(bf2f(proj[(size_t)(row0 + t0 + lane) * PITCH + PC_DT + h0 + e]) + a.in[I_SDTB][h0 + e]);
                float ac = dtv * (-expf(a.in[I_SALOG][h0 + e]));
#pragma unroll
                for (int d = 1; d < 64; d <<= 1) { const float v = __shfl_up(ac, d); if (lane >= d) ac += v; }
                vdt[64 * e + lane] = dtv; vacs[64 * e + lane] = ac; }
        }
        __syncthreads();
        { const int pr = tid >> 2, l0 = 16 * (tid & 3), e = pr >> 6; const float al = vacs[64 * e + 63];
            const v4u x0 = *(const LAS v4u*)(LXT + pr * P64 + l0), x1 = *(const LAS v4u*)(LXT + pr * P64 + l0 + 8); float xf[16]; { float t8[8]; unpack8(x0, t8);
#pragma unroll
                for (int i = 0; i < 8; ++i) xf[i] = t8[i]; unpack8(x1, t8);
#pragma unroll
                for (int i = 0; i < 8; ++i) xf[8 + i] = t8[i]; }
            unsigned o[8];
#pragma unroll
            for (int i = 0; i < 8; ++i) { const int l = l0 + 2 * i; const float s0 = vdt[64 * e + l] * __expf(al - vacs[64 * e + l]), s1 = vdt[64 * e + l + 1] * __expf(al - vacs[64 * e + l + 1]); o[i] = cvtpk(xf[2 * i] * s0, xf[2 * i + 1] * s1); }
            *(LAS v4u*)(LXW + pr * P64 + l0) = (v4u){o[0], o[1], o[2], o[3]}; *(LAS v4u*)(LXW + pr * P64 + l0 + 8) = (v4u){o[4], o[5], o[6], o[7]}; }
        f32x4 yacc[4];
#pragma unroll
        for (int pt = 0; pt < 4; ++pt) yacc[pt] = (f32x4){0.f, 0.f, 0.f, 0.f};
#pragma unroll
        for (int ks = 0; ks < 4; ++ks) { const bf16x8 cf = ldfrag(LC, P128, 16 * wq, 32 * ks, lane);
#pragma unroll
            for (int pt = 0; pt < 4; ++pt) yacc[pt] = MFMA16(ldfrag(LH + hh * 64 * P128, P128, 16 * pt, 32 * ks, lane), cf, yacc[pt]); }
        for (int job = wave; job < 10; job += 8) { int ti, tj; lower_pair(job, ti, tj);
            f32x4 acc = (f32x4){0.f, 0.f, 0.f, 0.f};
#pragma unroll
            for (int ks = 0; ks < 4; ++ks) acc = MFMA16(ldfrag(LB, P128, 16 * tj, 32 * ks, lane), ldfrag(LC, P128, 16 * ti, 32 * ks, lane), acc);
            const int l = 16 * ti + c16, s0 = 16 * tj + 4 * q4;
#pragma unroll
            for (int e = 0; e < 2; ++e) { const float al = vacs[64 * e + l], Dh = a.in[I_SD][h0 + e]; const f32x4 as = *(const LAS f32x4*)(vacs + 64 * e + s0), ds = *(const LAS f32x4*)(vdt + 64 * e + s0); f32x4 val;
#pragma unroll
                for (int r = 0; r < 4; ++r) val[r] = (s0 + r <= l) ? acc[r] * ds[r] * __expf(al - as[r]) + ((s0 + r == l) ? Dh : 0.f) : 0.f;
                *(LAS u32x2*)(LM + e * 64 * P64 + l * P64 + s0) = pack4(val); } }
        if (wave >= 2 && wave < 6) { const int e = (wave - 2) >> 1, up = (wave - 2) & 1; const int l = (up ? 32 : 0) + c16, s0 = (up ? 48 : 16) + 4 * q4;
            *(LAS u32x2*)(LM + e * 64 * P64 + l * P64 + s0) = (u32x2){0u, 0u}; }
        __syncthreads();
        {
            const float ea = __expf(vacs[64 * hh + 16 * wq + c16]);
#pragma unroll
            for (int pt = 0; pt < 4; ++pt) yacc[pt] = yacc[pt] * ea;
            for (int ks = 0; ks < (wq >= 2 ? 2 : 1); ++ks) { const bf16x8 mf = ldfrag(LM + hh * 64 * P64, P64, 16 * wq, 32 * ks, lane);
#pragma unroll
                for (int pt = 0; pt < 4; ++pt) yacc[pt] = MFMA16(ldfrag(LXT + hh * 64 * P64, P64, 16 * pt, 32 * ks, lane), mf, yacc[pt]); }
            const float el = __expf(vacs[64 * hh + 63]);
#pragma unroll
            for (int nt = 0; nt < 8; ++nt) hacc[nt] = hacc[nt] * el;
#pragma unroll
            for (int ks = 0; ks < 2; ++ks) { const bf16x8 xf = ldfrag(LXW + hh * 64 * P64, P64, 16 * wq, 32 * ks, lane);
#pragma unroll
                for (int nt = 0; nt < 8; ++nt) hacc[nt] = MFMA16(ldfrag(LBT, P64, 16 * nt, 32 * ks, lane), xf, hacc[nt]); }
#pragma unroll
            for (int nt = 0; nt < 8; ++nt) *(LAS u32x2*)(LH + hh * 64 * P128 + (16 * wq + c16) * P128 + 16 * nt + 4 * q4) = pack4(hacc[nt]);
            const size_t row = (size_t)(row0 + t0 + 16 * wq + c16); float sq = 0.f;
#pragma unroll
            for (int pt = 0; pt < 4; ++pt) { const int p0 = (h0 + hh) * 64 + 16 * pt + 4 * q4; const unsigned long long zz = *(const unsigned long long*)(proj + row * PITCH + PC_Z + p0);
                const f32x4 y = yacc[pt] * (f32x4){silu_f(bf2f((unsigned)zz & 0xffffu)), silu_f(bf2f(((unsigned)zz) >> 16)), silu_f(bf2f((unsigned)(zz >> 32) & 0xffffu)), silu_f(bf2f((unsigned)(zz >> 48)))};
                *(u32x2*)(mixed + row * DMIX + p0) = pack4(y); sq += (y[0] * y[0] + y[1] * y[1]) + (y[2] * y[2] + y[3] * y[3]); }
            sq += __shfl_xor(sq, 16); sq += __shfl_xor(sq, 32);
            if (q4 == 0) ssqo[row * 16 + h0 + hh] = sq;
        }
        __syncthreads();
    }
    { const int c16 = lane_ & 15, q4 = lane_ >> 4; float* so = a.out + OFF_SSD_P + ((size_t)b * SSD_H + h0 + hh) * (SSD_P * SSD_N) + (size_t)(16 * wq + c16) * SSD_N + 4 * q4;
#pragma unroll
        for (int nt = 0; nt < 8; ++nt) *(f32x4*)(so + 16 * nt) = hacc[nt]; }
    (void)A_h;
    __syncthreads();
}
constexpr int TB = 16;
__device__ __forceinline__ void ssd_item(const Args& a, LAS unsigned char* lds, int s, int h, int tid, int wave, int lane) {
    const bool prompt = s < NB_P; const int L = prompt ? SEQ : LS; const int row0 = prompt ? s * SEQ : MP + (s - NB_P) * LS; const int g = h >> 3;
    LAS float* raw = (LAS float*)lds;
    LAS float* xs = raw + (TB + 3) * 320; LAS float* Bs = xs + TB * 64; LAS float* Cs = Bs + TB * 128; LAS float* dts = Cs + TB * 128; LAS float* ys = dts + TB;
    const bf16* proj = ws_bf(a, WS_PROJ); bf16* mixed = mixed_buf(a); float* ssq = ws_f(a, WS_SSQ);
    const float A = -expf(a.in[I_SALOG][h]), Dh = a.in[I_SD][h], dtb = a.in[I_SDTB][h];
    const int p = 8 * wave + (lane >> 3), nc = lane & 7;
    float hs[16];
    if (prompt) {
#pragma unroll
        for (int i = 0; i < 16; ++i) hs[i] = 0.f;
    } else { const f32x4* sp = (const f32x4*)(a.in[I_SSD] + ((size_t)(s - NB_P) * SSD_H + h) * (SSD_P * SSD_N) + p * SSD_N + 16 * nc);
#pragma unroll
        for (int q = 0; q < 4; ++q) { const f32x4 v = sp[q]; hs[4 * q] = v.x; hs[4 * q + 1] = v.y; hs[4 * q + 2] = v.z; hs[4 * q + 3] = v.w; } }
    for (int t0 = 0; t0 < L; t0 += TB) {
        const int nb = (L - t0) < TB ? (L - t0) : TB;
        for (int idx = tid; idx < (nb + 3) * 320; idx += NT) { const int i = idx / 320, c = idx - i * 320, tt = t0 - 3 + i;
            const int ch = c < 64 ? h * 64 + c : (c < 192 ? 1024 + g * 128 + (c - 64) : 1280 + g * 128 + (c - 192));
            float v;
            if (tt >= 0) v = bf2f(proj[(size_t)(row0 + tt) * PITCH + PC_XBC + ch]);
            else v = prompt ? 0.f : a.in[I_SSDC][((size_t)(s - NB_P) * 3 + (3 + tt)) * SSD_CONV + ch];
            raw[idx] = v; }
        __syncthreads();
        for (int idx = tid; idx < nb * 320; idx += NT) { const int t = idx / 320, c = idx - t * 320;
            const int ch = c < 64 ? h * 64 + c : (c < 192 ? 1024 + g * 128 + (c - 64) : 1280 + g * 128 + (c - 192));
            float acc = a.in[I_SCB][ch];
#pragma unroll
            for (int j = 0; j < 4; ++j) acc += a.in[I_SCW][j * SSD_CONV + ch] * raw[(t + j) * 320 + c];
            acc = silu_acc(acc);
            if (c < 64) xs[t * 64 + c] = acc; else if (c < 192) Bs[t * 128 + (c - 64)] = acc; else Cs[t * 128 + (c - 192)] = acc; }
        if (tid < nb) dts[tid] = softplus_acc(bf2f(proj[(size_t)(row0 + t0 + tid) * PITCH + PC_DT + h]) + dtb);
        __syncthreads();
        for (int t = 0; t < nb; ++t) {
            const float xv = xs[t * 64 + p], dtv = dts[t], dA = __expf(dtv * A), dx = dtv * xv;
            const LAS f32x4* Bp = (const LAS f32x4*)(Bs + t * 128 + 16 * nc); const LAS f32x4* Cp = (const LAS f32x4*)(Cs + t * 128 + 16 * nc);
            float part = 0.f;
#pragma unroll
            for (int q = 0; q < 4; ++q) { const f32x4 b = Bp[q], c = Cp[q];
#pragma unroll
                for (int e = 0; e < 4; ++e) { hs[4 * q + e] = hs[4 * q + e] * dA + dx * b[e]; part += c[e] * hs[4 * q + e]; } }
            part += __shfl_xor(part, 1); part += __shfl_xor(part, 2); part += __shfl_xor(part, 4);
            if (nc == 0) ys[t * 64 + p] = part + Dh * xv;
        }
        __syncthreads();
        { const int t = tid >> 5, pp = tid & 31; float sq = 0.f; const int row = row0 + t0 + t;
            if (t < nb) { const unsigned zz = *(const unsigned*)(proj + (size_t)row * PITCH + PC_Z + h * 64 + 2 * pp);
                const float y0 = ys[t * 64 + 2 * pp] * silu_acc(bf2f(zz & 0xffffu)), y1 = ys[t * 64 + 2 * pp + 1] * silu_acc(bf2f(zz >> 16));
                *(unsigned*)(mixed + (size_t)row * DMIX + h * 64 + 2 * pp) = pk2(y0, y1); sq = y0 * y0 + y1 * y1; }
            sq += __shfl_xor(sq, 1); sq += __shfl_xor(sq, 2); sq += __shfl_xor(sq, 4); sq += __shfl_xor(sq, 8); sq += __shfl_xor(sq, 16);
            if (t < nb && pp == 0) ssq[(size_t)row * 16 + h] = sq; }
    }
    float* so = a.out + (prompt ? OFF_SSD_P + ((size_t)s * SSD_H + h) * (SSD_P * SSD_N) : OFF_SSD_S + ((size_t)(s - NB_P) * SSD_H + h) * (SSD_P * SSD_N)) + p * SSD_N + 16 * nc;
#pragma unroll
    for (int q = 0; q < 4; ++q) ((f32x4*)so)[q] = (f32x4){hs[4 * q], hs[4 * q + 1], hs[4 * q + 2], hs[4 * q + 3]};
    __syncthreads();
}
__device__ __forceinline__ void gdn_item(const Args& a, LAS unsigned char* lds, int s, int h, int tid, int wave, int lane) {
    const bool prompt = s < NB_P; const int L = prompt ? SEQ : LS; const int row0 = prompt ? s * SEQ : MP + (s - NB_P) * LS;
    LAS float* raw = (LAS float*)lds;
    LAS float* qs = raw + (TB + 3) * 384; LAS float* ks = qs + TB * 128; LAS float* vs = ks + TB * 128; LAS float* gs = vs + TB * 128; LAS float* bs = gs + TB; LAS float* os = bs + TB;
    const bf16* proj = ws_bf(a, WS_PROJ); bf16* mixed = mixed_buf(a);
    const float Ag = -expf(a.in[I_GALOG][h]), dtb = a.in[I_GDTB][h];
    const int dv = 16 * wave + (lane & 15), dkc = lane >> 4;
    float Ss[32];
    const size_t sbase = (size_t)(32 * dkc) * GDN_D + dv;
    if (prompt) {
#pragma unroll
        for (int i = 0; i < 32; ++i) Ss[i] = 0.f;
    } else { const float* sp = a.in[I_GDN] + ((size_t)(s - NB_P) * GDN_H + h) * (GDN_D * GDN_D) + sbase;
#pragma unroll
        for (int i = 0; i < 32; ++i) Ss[i] = sp[(size_t)i * GDN_D]; }
    for (int t0 = 0; t0 < L; t0 += TB) {
        const int nb = (L - t0) < TB ? (L - t0) : TB;
        for (int idx = tid; idx < (nb + 3) * 384; idx += NT) { const int i = idx / 384, c = idx - i * 384, tt = t0 - 3 + i;
            const int ch = (c >> 7) * 1024 + h * 128 + (c & 127);
            float v;
            if (tt >= 0) v = bf2f(proj[(size_t)(row0 + tt) * PITCH + PC_QKV + ch]);
            else v = prompt ? 0.f : a.in[I_GDNC][((size_t)(s - NB_P) * 3 + (3 + tt)) * GDN_CONV + ch];
            raw[idx] = v; }
        __syncthreads();
        for (int idx = tid; idx < nb * 384; idx += NT) { const int t = idx / 384, c = idx - t * 384; const int ch = (c >> 7) * 1024 + h * 128 + (c & 127);
            float acc = 0.f;
#pragma unroll
            for (int j = 0; j < 4; ++j) acc += a.in[I_GCW][j * GDN_CONV + ch] * raw[(t + j) * 384 + c];
            acc = silu_acc(acc);
            if (c < 128) qs[t * 128 + c] = acc; else if (c < 256) ks[t * 128 + (c - 128)] = acc; else vs[t * 128 + (c - 256)] = acc; }
        if (tid < nb) { const size_t r = (size_t)(row0 + t0 + tid) * PITCH;
            gs[tid] = Ag * softplus_acc(bf2f(proj[r + PC_ALPHA + h]) + dtb); bs[tid] = 1.f / (1.f + expf(-bf2f(proj[r + PC_BETA + h]))); }
        __syncthreads();
        {
            const int grp = tid >> 4, j = tid & 15, t = grp >> 1; LAS float* vp = ((grp & 1) ? ks : qs) + t * 128 + 8 * j;
            float sq = 0.f; float e[8];
            if (t < nb) {
#pragma unroll
                for (int i = 0; i < 8; ++i) { e[i] = vp[i]; sq += e[i] * e[i]; } }
            sq += __shfl_xor(sq, 1); sq += __shfl_xor(sq, 2); sq += __shfl_xor(sq, 4); sq += __shfl_xor(sq, 8);
            const float sc = (1.f / sqrtf(sq + 1e-6f)) * ((grp & 1) ? 1.f : 0.08838834764831845f);
            if (t < nb) {
#pragma unroll
                for (int i = 0; i < 8; ++i) vp[i] = e[i] * sc; } }
        __syncthreads();
        for (int t = 0; t < nb; ++t) {
            const float eg = __expf(gs[t]), bt = bs[t];
            const LAS f32x4* kp = (const LAS f32x4*)(ks + t * 128 + 32 * dkc); const LAS f32x4* qp = (const LAS f32x4*)(qs + t * 128 + 32 * dkc);
            f32x4 kk[8]; float u = 0.f;
#pragma unroll
            for (int q = 0; q < 8; ++q) { kk[q] = kp[q];
#pragma unroll
                for (int e = 0; e < 4; ++e) u += kk[q][e] * Ss[4 * q + e]; }
            u += __shfl_xor(u, 16); u += __shfl_xor(u, 32);
            const float wv = bt * (vs[t * 128 + dv] - eg * u);
            float o = 0.f;
#pragma unroll
            for (int q = 0; q < 8; ++q) { const f32x4 qq = qp[q];
#pragma unroll
                for (int e = 0; e < 4; ++e) { Ss[4 * q + e] = eg * Ss[4 * q + e] + kk[q][e] * wv; o += qq[e] * Ss[4 * q + e]; } }
            o += __shfl_xor(o, 16); o += __shfl_xor(o, 32);
            if (dkc == 0) os[t * 128 + dv] = o;
        }
        __syncthreads();
        { const int t = tid >> 5, j = tid & 31; const int row = row0 + t0 + t; float sq = 0.f; f32x4 o4 = (f32x4){0.f, 0.f, 0.f, 0.f};
            if (t < nb) { o4 = *(const LAS f32x4*)(os + t * 128 + 4 * j); sq = (o4.x * o4.x + o4.y * o4.y) + (o4.z * o4.z + o4.w * o4.w); }
            sq += __shfl_xor(sq, 1); sq += __shfl_xor(sq, 2); sq += __shfl_xor(sq, 4); sq += __shfl_xor(sq, 8); sq += __shfl_xor(sq, 16);
            if (t < nb) { const float rs = 1.f / sqrtf(sq * (1.f / GDN_D) + EPS); const f32x4 w = *(const f32x4*)(a.in[I_GNW] + 4 * j);
                const unsigned long long gg = *(const unsigned long long*)(proj + (size_t)row * PITCH + PC_GATE + h * 128 + 4 * j);
                const float g0 = silu_acc(bf2f((unsigned)gg & 0xffffu)), g1 = silu_acc(bf2f(((unsigned)gg) >> 16)), g2 = silu_acc(bf2f((unsigned)(gg >> 32) & 0xffffu)), g3 = silu_acc(bf2f((unsigned)(gg >> 48)));
                *(unsigned long long*)(mixed + (size_t)row * DMIX + DM + h * 128 + 4 * j) =
                    (unsigned long long)pk2(o4.x * rs * w.x * g0, o4.y * rs * w.y * g1) | ((unsigned long long)pk2(o4.z * rs * w.z * g2, o4.w * rs * w.w * g3) << 32); } }
    }
    float* so = a.out + (prompt ? OFF_GDN_P + ((size_t)s * GDN_H + h) * (GDN_D * GDN_D) : OFF_GDN_S + ((size_t)(s - NB_P) * GDN_H + h) * (GDN_D * GDN_D)) + sbase;
#pragma unroll
    for (int i = 0; i < 32; ++i) so[(size_t)i * GDN_D] = Ss[i];
    __syncthreads();
}
__device__ __forceinline__ void convstate_item(const Args& a, int s, int tid) {
    const bool prompt = s < NB_P; const int L = prompt ? SEQ : LS; const int row0 = prompt ? s * SEQ : MP + (s - NB_P) * LS; const bf16* proj = ws_bf(a, WS_PROJ);
    float* o1 = a.out + (prompt ? OFF_SSDC_P + (size_t)s * 3 * SSD_CONV : OFF_SSDC_S + (size_t)(s - NB_P) * 3 * SSD_CONV);
    float* o2 = a.out + (prompt ? OFF_GDNC_P + (size_t)s * 3 * GDN_CONV : OFF_GDNC_S + (size_t)(s - NB_P) * 3 * GDN_CONV);
    for (int idx = tid; idx < 3 * SSD_CONV; idx += NT) { const int j = idx / SSD_CONV, c = idx - j * SSD_CONV; o1[idx] = bf2f(proj[(size_t)(row0 + L - 3 + j) * PITCH + PC_XBC + c]); }
    for (int idx = tid; idx < 3 * GDN_CONV; idx += NT) { const int j = idx / GDN_CONV, c = idx - j * GDN_CONV; o2[idx] = bf2f(proj[(size_t)(row0 + L - 3 + j) * PITCH + PC_QKV + c]); }
}
constexpr int Q_GP = NB_P * GDN_H, Q_SP = Q_GP + NB_P * SSD_H / 2, Q_GS = Q_SP + NB_S * GDN_H, Q_SS = Q_GS + NB_S * SSD_H, Q_ALL = Q_SS + NSEQ;
__device__ __forceinline__ void p3_mixers(const Args& a, LAS unsigned char* lds, volatile LAS unsigned* misc, int tid_, int wave, int lane_) {
    unsigned* qctr = (unsigned*)(a.ws + WS_CTL) + CW_QUEUE;
    for (;;) {
        if (tid_ == 0) misc[0] = __hip_atomic_fetch_add(qctr, 1u, __ATOMIC_RELAXED, __HIP_MEMORY_SCOPE_AGENT);
        __syncthreads();
        const int it = (int)misc[0];
        __syncthreads();
        if (it >= Q_ALL) break;
        int tid = tid_, lane = lane_;
        asm volatile("" : "+v"(tid), "+v"(lane));
        if (it < Q_GP) gdn_chunk_item(a, lds, it >> 3, it & 7, tid, wave, lane);
        else if (it < Q_SP) { const int j = it - Q_GP; ssd_chunk_item(a, lds, j >> 3, (j >> 2) & 1, j & 3, tid, wave, lane); }
        else if (it < Q_GS) gdn_item(a, lds, NB_P + ((it - Q_SP) >> 3), (it - Q_SP) & 7, tid, wave, lane);
        else if (it < Q_SS) ssd_item(a, lds, NB_P + ((it - Q_GS) >> 4), (it - Q_GS) & 15, tid, wave, lane);
        else convstate_item(a, it - Q_SS, tid);
    }
}
__device__ __forceinline__ void p3b_ssdnorm(const Args& a, int gw, int NGW, int lane) {
    bf16* mixed = mixed_buf(a); const float* ssq = ws_f(a, WS_SSQ); const float* nw = a.in[I_SNW] + 16 * lane;
    for (int row = gw; row < M; row += NGW) {
        const f32x4* sp = (const f32x4*)(ssq + (size_t)row * 16 + 8 * (lane >> 5)); const f32x4 s0 = sp[0], s1 = sp[1];
        const float rs = 1.f / sqrtf(((s0.x + s0.y) + (s0.z + s0.w) + (s1.x + s1.y) + (s1.z + s1.w)) * (1.f / 512.f) + EPS);
        v4u* mp = (v4u*)(mixed + (size_t)row * DMIX + 16 * lane);
#pragma unroll
        for (int q = 0; q < 2; ++q) { v4u v = mp[q]; const f32x4 w0 = *(const f32x4*)(nw + 8 * q), w1 = *(const f32x4*)(nw + 8 * q + 4);
            v.x = pk2(bf2f(v.x & 0xffffu) * rs * w0.x, bf2f(v.x >> 16) * rs * w0.y); v.y = pk2(bf2f(v.y & 0xffffu) * rs * w0.z, bf2f(v.y >> 16) * rs * w0.w);
            v.z = pk2(bf2f(v.z & 0xffffu) * rs * w1.x, bf2f(v.z >> 16) * rs * w1.y); v.w = pk2(bf2f(v.w & 0xffffu) * rs * w1.z, bf2f(v.w >> 16) * rs * w1.w);
            mp[q] = v; }
    }
}
__device__ __forceinline__ void p5_mid(const Args& a, int gw, int NGW, int lane) {
    const float* mod = ws_f(a, WS_MOD); const float* T1 = ws_f(a, WS_T1); bf16* XN2 = ws_bf(a, WS_XN2); const float* wpost = a.in[I_NMPOST]; const float* wpre = a.in[I_NFPRE];
    for (int row = gw; row < M; row += NGW) {
        const f32x4* tr = (const f32x4*)(T1 + (size_t)row * DM) + lane; const f32x4* xr = (const f32x4*)x_row(a, row) + lane; const float* mr = mod + (size_t)seq_of_row(row) * NMOD;
        f32x4 v[4]; float s = 0.f;
#pragma unroll
        for (int j = 0; j < 4; ++j) { v[j] = tr[64 * j]; s += (v[j].x * v[j].x + v[j].y * v[j].y) + (v[j].z * v[j].z + v[j].w * v[j].w); }
        const float rs = 1.f / sqrtf(wave_sum(s) * (1.f / DM) + EPS);
        float s2 = 0.f; f32x4* yo = (f32x4*)(a.out + OFF_Y + (size_t)row * DM) + lane;
#pragma unroll
        for (int j = 0; j < 4; ++j) { const int c = 4 * lane + 256 * j; const f32x4 w = *(const f32x4*)(wpost + c), g1 = *(const f32x4*)(mr + 2 * DM + c);
            v[j] = xr[64 * j] + g1 * (v[j] * rs * w); yo[64 * j] = v[j]; s2 += (v[j].x * v[j].x + v[j].y * v[j].y) + (v[j].z * v[j].z + v[j].w * v[j].w); }
        const float rs2 = 1.f / sqrtf(wave_sum(s2) * (1.f / DM) + EPS);
        unsigned long long* o8 = (unsigned long long*)(XN2 + (size_t)row * DM) + lane;
#pragma unroll
        for (int j = 0; j < 4; ++j) { const int c = 4 * lane + 256 * j; const f32x4 w = *(const f32x4*)(wpre + c), sh = *(const f32x4*)(mr + 3 * DM + c), sc = *(const f32x4*)(mr + 4 * DM + c);
            const f32x4 h = v[j] * rs2 * w * (sc + 1.f) + sh;
            o8[64 * j] = (unsigned long long)pk2(h.x, h.y) | ((unsigned long long)pk2(h.z, h.w) << 32); }
    }
}
__device__ __forceinline__ void p8_final(const Args& a, int gw, int NGW, int lane) {
    const float* mod = ws_f(a, WS_MOD); const float* T2 = ws_f(a, WS_T2); const float* wpost = a.in[I_NFPOST];
    for (int row = gw; row < M; row += NGW) {
        const f32x4* tr = (const f32x4*)(T2 + (size_t)row * DM) + lane; const float* mr = mod + (size_t)seq_of_row(row) * NMOD;
        f32x4 v[4]; float s = 0.f;
#pragma unroll
        for (int j = 0; j < 4; ++j) { v[j] = tr[64 * j]; s += (v[j].x * v[j].x + v[j].y * v[j].y) + (v[j].z * v[j].z + v[j].w * v[j].w); }
        const float rs = 1.f / sqrtf(wave_sum(s) * (1.f / DM) + EPS);
        f32x4* yo = (f32x4*)(a.out + OFF_Y + (size_t)row * DM) + lane;
#pragma unroll
        for (int j = 0; j < 4; ++j) { const int c = 4 * lane + 256 * j; const f32x4 w = *(const f32x4*)(wpost + c), g2 = *(const f32x4*)(mr + 5 * DM + c);
            yo[64 * j] = yo[64 * j] + g2 * (v[j] * rs * w); }
    }
}
#ifndef MK_N_LAUNCHES
#define MK_N_LAUNCHES 1
#endif
constexpr int NPH = 10;
constexpr int N_LAUNCHES = MK_N_LAUNCHES;
static_assert(N_LAUNCHES == 1 || N_LAUNCHES == NPH, "MK_N_LAUNCHES is 1 or 10");
#ifndef PG8_SP2
#define PG8_SP2 true
#endif
#ifndef PG8_ALIGN
#define PG8_ALIGN true
#endif
__global__ void __launch_bounds__(NT, 2) hymba_fwd(Args args) {
    extern __shared__ __attribute__((aligned(16))) unsigned char lds_[];
    LAS unsigned char* lds = (LAS unsigned char*)lds_;
    volatile LAS unsigned* MISC = (volatile LAS unsigned*)(lds + MISC_OFF);
    const int tid0 = threadIdx.x, wave = __builtin_amdgcn_readfirstlane(tid0 >> 6);
#define PHASE_IDS int lane = (int)__builtin_amdgcn_mbcnt_hi(~0u, __builtin_amdgcn_mbcnt_lo(~0u, 0u)); asm volatile("" : "+v"(lane)); const int tid = wave * 64 + lane;
    const int G = gridDim.x, bid = blockIdx.x;
    const int gw = bid * NWAVES + wave, NGW = G * NWAVES;
    gu32* ctl = (gu32*)(args.ws + WS_CTL);
    for (int u = tid0; u < (LDS_BYTES - LDSCTL_OFF) / 4; u += NT) ((LAS unsigned*)(lds + LDSCTL_OFF))[u] = 0u;
    __syncthreads();
    XcdBarrier bar; bar.bar = (unsigned*)(ctl + CW_BAR); bar.x = 0; bar.st = nullptr;
    if (N_LAUNCHES == 1) bar = xcd_barrier_post((unsigned*)(ctl + CW_BAR), MISC + 8);
#define GRID_BAR(seam) do { if (N_LAUNCHES != 1) { if (wave == 0 && __builtin_amdgcn_mbcnt_lo(~0u, 0u) == 0u) __hip_atomic_store(ctl + CW_TMO, 0xBADBA0u | (unsigned)(seam), RLX_AGENT); } else { xcd_barrier(bar); } } while (0)
    const int lo = args.ph_lo, hi = args.ph_hi;
#define IN(k) (lo <= (k) && (k) < hi)
#define BOTH(k) (IN(k) && IN((k) + 1))
    if (IN(0)) { PHASE_IDS p0_prologue(args, lds, bid, G, tid, wave, lane); if (BOTH(0)) GRID_BAR(0); }
    if (IN(1)) { PHASE_IDS p1_xn(args, gw, NGW, lane); if (BOTH(1)) GRID_BAR(1); }
    if (IN(2)) {
        pg8::Gemm g{xn_buf(args), win_t(args), M, IN_PAD, DM}; pg8::StaticOrder S; S.init(M, IN_PAD, G, bid);
        pg8::EpiBf16Clip E{ws_bf(args, WS_PROJ), PITCH, IN_DIM};
        pg8::gemm_phase<pg8::EpiBf16Clip, pg8::StaticOrder, PG8_ALIGN, PG8_SP2>(lds + RING_OFF, g, S, E);
        if (BOTH(2)) GRID_BAR(2);
    }
    if (IN(3)) { PHASE_IDS p3_mixers(args, lds, MISC, tid, wave, lane); if (BOTH(3)) GRID_BAR(3); }
    if (IN(4)) { PHASE_IDS p3b_ssdnorm(args, gw, NGW, lane); if (BOTH(4)) GRID_BAR(4); }
    if (IN(5)) {
        pg8::Gemm g{mixed_buf(args), ws_bf(args, WS_WOUT), M, DM, DMIX}; pg8::StaticOrder S; S.init(M, DM, G, bid);
        pg8::EpiF32 E{ws_f(args, WS_T1), DM};
        pg8::gemm_phase<pg8::EpiF32, pg8::StaticOrder, PG8_ALIGN, PG8_SP2>(lds + RING_OFF, g, S, E);
        if (BOTH(5)) GRID_BAR(5);
    }
    if (IN(6)) { PHASE_IDS p5_mid(args, gw, NGW, lane); if (BOTH(6)) GRID_BAR(6); }
    if (IN(7)) {
        pg8::Gemm g{ws_bf(args, WS_XN2), ws_bf(args, WS_WGU), M, NGU, DM}; pg8::StaticOrder S; S.init(M, NGU, G, bid);
        pg8::EpiSwiGLU E{ws_bf(args, WS_ACT), DFF};
        pg8::gemm_phase<pg8::EpiSwiGLU, pg8::StaticOrder, PG8_ALIGN, PG8_SP2>(lds + RING_OFF, g, S, E);
        if (BOTH(7)) GRID_BAR(7);
    }
    if (IN(8)) {
        pg8::Gemm g{ws_bf(args, WS_ACT), ws_bf(args, WS_WDN), M, DM, DFF}; pg8::StaticOrder S; S.init(M, DM, G, bid);
        pg8::EpiF32 E{ws_f(args, WS_T2), DM};
        pg8::gemm_phase<pg8::EpiF32, pg8::StaticOrder, PG8_ALIGN, PG8_SP2>(lds + RING_OFF, g, S, E);
        if (BOTH(8)) GRID_BAR(8);
    }
    if (IN(9)) { PHASE_IDS p8_final(args, gw, NGW, lane); }
#undef IN
#undef BOTH
}
extern "C" void kernel_launch(void* const* d_in, const int* in_sizes, int n_in, void* d_out, int out_size, void* d_ws, size_t ws_size, hipStream_t stream) {
    static int grid = 0;
    if (grid == 0) {
        if (n_in != 28 || in_sizes[0] != MP * DM || (size_t)out_size != OUT_TOTAL || ws_size < WS_END) {
            fprintf(stderr, "kernel_launch: shape/workspace mismatch: n_in %d in0 %d out %d ws %zu (need %zu); nothing launched\n", n_in, n_in > 0 ? in_sizes[0] : -1, out_size, ws_size, (size_t)WS_END); grid = -1; return; }
        int dev = 0, cus = 0, per_cu = 0;
        if (hipGetDevice(&dev) != hipSuccess || hipDeviceGetAttribute(&cus, hipDeviceAttributeMultiprocessorCount, dev) != hipSuccess) { fprintf(stderr, "kernel_launch: device query failed\n"); grid = -1; return; }
        if (hipFuncSetAttribute((const void*)hymba_fwd, hipFuncAttributeMaxDynamicSharedMemorySize, LDS_BYTES) != hipSuccess) { fprintf(stderr, "kernel_launch: hipFuncSetAttribute failed\n"); grid = -1; return; }
        if (hipOccupancyMaxActiveBlocksPerMultiprocessor(&per_cu, (const void*)hymba_fwd, NT, LDS_BYTES) != hipSuccess || per_cu < 1)
            fprintf(stderr, "kernel_launch: note: occupancy query reports %d workgroups per CU\n", per_cu);
        (void)hipGetLastError();
        grid = cus;
    }
    if (grid < 0) return;
    if (hipMemsetAsync((char*)d_ws + WS_CTL, 0, CTL_ZERO_BYTES, stream) != hipSuccess) { fprintf(stderr, "kernel_launch: memset failed\n"); return; }
    Args a{};
    for (int i = 0; i < 28; ++i) a.in[i] = (const float*)d_in[i];
    a.out = (float*)d_out; a.ws = (unsigned char*)d_ws;
    for (int li = 0; li < N_LAUNCHES; ++li) {
        a.ph_lo = (N_LAUNCHES == 1) ? 0 : li; a.ph_hi = (N_LAUNCHES == 1) ? NPH : li + 1; a.li = li;
        hipLaunchKernelGGL(hymba_fwd, dim3(grid), dim3(NT), LDS_BYTES, stream, a);
        const hipError_t le = hipPeekAtLastError();
        if (le != hipSuccess) { fprintf(stderr, "kernel_launch: launch %d failed: %s\n", li, hipGetErrorName(le)); break; }
    }
}
```

```cpp
#include <hip/hip_runtime.h>
#include <cstdio>
#include <cstdint>
namespace pg8 {
#define PG8_LAS __attribute__((address_space(3)))
typedef unsigned short bf16_t;
typedef short bf16x8 __attribute__((ext_vector_type(8)));
typedef float f32x4 __attribute__((ext_vector_type(4)));
typedef unsigned u32x4 __attribute__((ext_vector_type(4)));
constexpr int BM = 256, BK = 64, HALF = 128, HTB = HALF * BK * 2  , STAGE_BYTES = 8 * HTB, NXCD = 8, WGM = 8;

__host__ __device__ __forceinline__ int lds_byte(int r, int c) { const int st = (r >> 4) * 2 + (c >> 5), rr = r & 15, cc = c & 31, ob = rr * 64 + cc * 2; return st * 1024 + (ob ^ (((ob >> 9) & 1) << 5)); }
__host__ __device__ __forceinline__ void stage_rc(int b, int& R, int& C) { const int st = b / 1024, sb = b % 1024, swz = sb ^ (((sb >> 9) & 1) << 5); R = (st >> 1) * 16 + swz / 64; C = (st & 1) * 32 + (swz % 64) / 2; }
__host__ __device__ __forceinline__ int perm32(int rho) { const int n = rho >> 4, i = rho & 15; return 8 * (i >> 2) + 4 * n + (i & 3); }

struct Unit { int pm, pn; };
struct Gemm { const bf16_t* A; const bf16_t* Bt; int M, N, K; };

struct StaticOrder {
    int nM, nN, nwg, G, c;
    __host__ __device__ void init(int M, int N, int G_, int c_) { nM = M / BM; nN = N / BM; nwg = nM * nN; G = G_; c = c_; }
    __host__ __device__ bool next(int i, Unit& u) const {
        const long L = (long)i * G + c; if (L >= nwg) return false;
        int wgid = (int)L; { const int q = nwg / NXCD, r = nwg % NXCD, xcd = wgid % NXCD, off = wgid / NXCD; wgid = (xcd < r ? xcd * (q + 1) : r * (q + 1) + (xcd - r) * q) + off; }
        const int nig = WGM * nN, gid = wgid / nig, fm = gid * WGM, gsz = (nM - fm) < WGM ? (nM - fm) : WGM;
        u.pm = fm + ((wgid % nig) % gsz); u.pn = (wgid % nig) / gsz; return true;
    }
    __device__ __forceinline__ void a_ready(const Unit&) const {}
    __device__ __forceinline__ void done(const Unit&) const {}
};

typedef float f32x2c __attribute__((ext_vector_type(2))); typedef __bf16 bf16x2c __attribute__((ext_vector_type(2)));
__device__ __forceinline__ unsigned cvt_pk_bf16(float lo, float hi) { f32x2c v = {lo, hi}; bf16x2c b = __builtin_convertvector(v, bf16x2c); return __builtin_bit_cast(unsigned, b); }
typedef float f32x2 __attribute__((ext_vector_type(2)));
__device__ __forceinline__ float silu_fast(float x) { return x * __builtin_amdgcn_rcpf(1.f + __expf(-x)); }
struct EpiBf16Clip {
    static constexpr bool PERM = true, AFTER_DRAIN = false;
    bf16_t* O; int ldc; int ncols;
    __device__ __forceinline__ void operator()(const f32x4 (&acc)[2][2][4][2], const Unit& u, int wr, int wc, int fr, int fq) const {
        const int row0 = u.pm * BM + wr * 64 + fr; const int col0 = u.pn * BM + wc * 32 + 8 * fq;
#pragma unroll
        for (int ai = 0; ai < 2; ++ai)
#pragma unroll
            for (int m = 0; m < 4; ++m) { bf16_t* rowp = O + (size_t)(row0 + ai * HALF + m * 16) * ldc + col0;
#pragma unroll
                for (int bj = 0; bj < 2; ++bj) { if (col0 + bj * HALF < ncols) { const f32x4 v0 = acc[ai][bj][m][0], v1 = acc[ai][bj][m][1];
                    u32x4 w; w.x = cvt_pk_bf16(v0[0], v0[1]); w.y = cvt_pk_bf16(v0[2], v0[3]); w.z = cvt_pk_bf16(v1[0], v1[1]); w.w = cvt_pk_bf16(v1[2], v1[3]);
                    *(u32x4*)(rowp + bj * HALF) = w; } } }
    }
};
struct EpiF32 {
    static constexpr bool PERM = false, AFTER_DRAIN = false;
    float* O; int ldc;
    __device__ __forceinline__ void operator()(const f32x4 (&acc)[2][2][4][2], const Unit& u, int wr, int wc, int fr, int fq) const {
        const int row0 = u.pm * BM + wr * 64 + fr; const int col0 = u.pn * BM + wc * 32 + 4 * fq;
#pragma unroll
        for (int ai = 0; ai < 2; ++ai)
#pragma unroll
            for (int m = 0; m < 4; ++m) { float* rowp = O + (size_t)(row0 + ai * HALF + m * 16) * ldc + col0;
#pragma unroll
                for (int bj = 0; bj < 2; ++bj)
#pragma unroll
                    for (int n = 0; n < 2; ++n) *(f32x4*)(rowp + bj * HALF + n * 16) = acc[ai][bj][m][n]; }
    }
};
struct EpiSwiGLU {
    static constexpr bool PERM = true, AFTER_DRAIN = false;
    bf16_t* O; int ldc;
    __device__ __forceinline__ void operator()(const f32x4 (&acc)[2][2][4][2], const Unit& u, int wr, int wc, int fr, int fq) const {
        const int row0 = u.pm * BM + wr * 64 + fr; const int col0 = u.pn * HALF + wc * 32 + 8 * fq;
#pragma unroll
        for (int ai = 0; ai < 2; ++ai)
#pragma unroll
            for (int m = 0; m < 4; ++m) { bf16_t* rowp = O + (size_t)(row0 + ai * HALF + m * 16) * ldc + col0;
                f32x4 v[2];
#pragma unroll
                for (int n = 0; n < 2; ++n) { const f32x4 g = acc[ai][0][m][n], up = acc[ai][1][m][n];
                    v[n] = (f32x4){silu_fast(g[0]) * up[0], silu_fast(g[1]) * up[1], silu_fast(g[2]) * up[2], silu_fast(g[3]) * up[3]}; }
                u32x4 w; w.x = cvt_pk_bf16(v[0][0], v[0][1]); w.y = cvt_pk_bf16(v[0][2], v[0][3]); w.z = cvt_pk_bf16(v[1][0], v[1][1]); w.w = cvt_pk_bf16(v[1][2], v[1][3]);
                *(u32x4*)rowp = w; }
    }
};
template <class Epi, class Sched, bool ALIGN_EPI = false, bool SP2 = false>
__device__ __forceinline__ void gemm_phase(PG8_LAS unsigned char* lds, const Gemm g, const Sched& S, const Epi& E) {
    const int tid = threadIdx.x, wid = __builtin_amdgcn_readfirstlane(tid >> 6), lane = tid & 63, wr = wid >> 2, wc = wid & 3, fr = lane & 15, fq = lane >> 4;
    const int K = g.K, nt = K / BK;
    unsigned voffA[2], voffB[2];
#pragma unroll
    for (int i = 0; i < 2; ++i) { int R, C; stage_rc(tid * 16 + i * 8192, R, C); const int Rb = Epi::PERM ? ((R & ~31) + perm32(R & 31)) : R;
        voffA[i] = (unsigned)(R * K + C) * 2u; voffB[i] = (unsigned)(Rb * K + C) * 2u; }
    const size_t kstep = (size_t)(BK * 2);
    const size_t hstep = (size_t)HALF * K * 2;
    const size_t tstep = 2 * hstep;
    const unsigned ldsw = (unsigned)wid * 1024u;
    const int aoff = lds_byte(wr * 64 + fr, fq * 8), boff = lds_byte(wc * 32 + fr, fq * 8);
#define PG8_SA(b, h) (((b) * 2 + (h)) * HTB)
#define PG8_SB(b, h) ((4 + (b) * 2 + (h)) * HTB)
#define PG8_STAGE(bufoff, gbase, voff) do { _Pragma("unroll") for (int _i = 0; _i < 2; ++_i) \
        __builtin_amdgcn_global_load_lds((const unsigned*)((const char*)(gbase) + (voff)[_i]), (PG8_LAS unsigned*)(lds + (bufoff) + ldsw + _i * 8192), 16, 0, 0); } while (0)
#define PG8_LDA(dst, b, h) do { _Pragma("unroll") for (int m = 0; m < 4; ++m) _Pragma("unroll") for (int k = 0; k < 2; ++k) dst[m][k] = *(const PG8_LAS bf16x8*)(lds + PG8_SA(b, h) + aoff + m * 2048 + k * 1024); } while (0)
#define PG8_LDB(dst, b, h) do { _Pragma("unroll") for (int n = 0; n < 2; ++n) _Pragma("unroll") for (int k = 0; k < 2; ++k) dst[n][k] = *(const PG8_LAS bf16x8*)(lds + PG8_SB(b, h) + boff + n * 2048 + k * 1024); } while (0)
#define PG8_MMA(ai, bj, At, Bt) do { __builtin_amdgcn_s_setprio(1); _Pragma("unroll") for (int m = 0; m < 4; ++m) _Pragma("unroll") for (int n = 0; n < 2; ++n) _Pragma("unroll") for (int k = 0; k < 2; ++k) \
        acc[ai][bj][m][n] = __builtin_amdgcn_mfma_f32_16x16x32_bf16(Bt[n][k], At[m][k], acc[ai][bj][m][n], 0, 0, 0); __builtin_amdgcn_s_setprio(0); } while (0)
#define PG8_WAIT_V(n) asm volatile("s_waitcnt vmcnt(" #n ")" ::: "memory")
#define PG8_WAIT_L(n) asm volatile("s_waitcnt lgkmcnt(" #n ")" ::: "memory")
#define PG8_BAR __builtin_amdgcn_s_barrier()
#define PG8_SCHED __builtin_amdgcn_sched_barrier(0)
    Unit cur, nxt; int ui = 0;
    if (!S.next(0, cur)) return;
    f32x4 acc[2][2][4][2];
#pragma unroll
    for (int a = 0; a < 2; ++a)
#pragma unroll
        for (int b = 0; b < 2; ++b)
#pragma unroll
            for (int m = 0; m < 4; ++m)
#pragma unroll
                for (int n = 0; n < 2; ++n) acc[a][b][m][n] = (f32x4){0.f, 0.f, 0.f, 0.f};
    bf16x8 At[4][2], B0[2][2], B1[2][2];
    const char* cA = (const char*)g.A + (size_t)cur.pm * tstep; const char* cB = (const char*)g.Bt + (size_t)cur.pn * tstep;
    S.a_ready(cur);
    if constexpr (SP2) {
        PG8_STAGE(PG8_SB(0, 0), cB, voffB); PG8_STAGE(PG8_SB(0, 1), cB + hstep, voffB); PG8_STAGE(PG8_SA(0, 0), cA, voffA); PG8_STAGE(PG8_SA(0, 1), cA + hstep, voffA);
        if (wr == 1) PG8_BAR;
        PG8_WAIT_V(2); PG8_BAR;
        PG8_STAGE(PG8_SB(1, 0), cB + kstep, voffB); PG8_STAGE(PG8_SA(1, 0), cA + kstep, voffA); PG8_STAGE(PG8_SB(1, 1), cB + hstep + kstep, voffB);
        PG8_WAIT_V(6); PG8_BAR;
    } else {
        PG8_STAGE(PG8_SB(0, 0), cB, voffB); PG8_STAGE(PG8_SA(0, 0), cA, voffA); PG8_STAGE(PG8_SB(0, 1), cB + hstep, voffB); PG8_STAGE(PG8_SA(0, 1), cA + hstep, voffA);
        if (wr == 1) PG8_BAR;
        PG8_WAIT_V(4); PG8_BAR;
        PG8_STAGE(PG8_SB(1, 0), cB + kstep, voffB); PG8_STAGE(PG8_SA(1, 0), cA + kstep, voffA); PG8_STAGE(PG8_SB(1, 1), cB + hstep + kstep, voffB);
        PG8_WAIT_V(6); PG8_BAR;
    }
    for (;;) {
        const bool has_next = S.next(ui + 1, nxt);
        const char* nA = has_next ? (const char*)g.A + (size_t)nxt.pm * tstep : cA; const char* nB = has_next ? (const char*)g.Bt + (size_t)nxt.pn * tstep : cB;
        for (int t = 0; t < nt; t += 2) {
            const bool last = (t == nt - 2);
            const char* a1 = cA + (size_t)(t + 1) * kstep;
            const char* a2 = last ? nA : cA + (size_t)(t + 2) * kstep; const char* b2 = last ? nB : cB + (size_t)(t + 2) * kstep;
            const char* a3 = a2 + kstep; const char* b3 = b2 + kstep;
            if (last && has_next) S.a_ready(nxt);
            if constexpr (SP2) {
            PG8_LDB(B0, 0, 0); PG8_LDB(B1, 0, 1); PG8_SCHED; PG8_LDA(At, 0, 0); PG8_STAGE(PG8_SA(1, 1), a1 + hstep, voffA);
            PG8_WAIT_V(8); PG8_WAIT_L(0); PG8_BAR; PG8_MMA(0, 0, At, B0); PG8_MMA(0, 1, At, B1); PG8_BAR; PG8_SCHED;
            PG8_LDA(At, 0, 1); PG8_STAGE(PG8_SB(0, 0), b2, voffB); PG8_STAGE(PG8_SB(0, 1), b2 + hstep, voffB); PG8_STAGE(PG8_SA(0, 0), a2, voffA);
            PG8_WAIT_V(8); PG8_WAIT_L(0); PG8_BAR; PG8_MMA(1, 0, At, B0); PG8_MMA(1, 1, At, B1); PG8_BAR; PG8_SCHED;
            PG8_LDB(B0, 1, 0); PG8_LDB(B1, 1, 1); PG8_SCHED; PG8_LDA(At, 1, 0); PG8_STAGE(PG8_SA(0, 1), a2 + hstep, voffA);
            PG8_WAIT_V(8); PG8_WAIT_L(0); PG8_BAR; PG8_MMA(0, 0, At, B0); PG8_MMA(0, 1, At, B1); PG8_BAR; PG8_SCHED;
            PG8_LDA(At, 1, 1); PG8_STAGE(PG8_SB(1, 0), b3, voffB); PG8_STAGE(PG8_SB(1, 1), b3 + hstep, voffB); PG8_STAGE(PG8_SA(1, 0), a3, voffA);
            PG8_WAIT_V(8); PG8_WAIT_L(0); PG8_BAR; PG8_MMA(1, 0, At, B0); PG8_MMA(1, 1, At, B1); PG8_BAR; PG8_SCHED;
            } else {
            PG8_LDB(B0, 0, 0); PG8_SCHED; PG8_LDA(At, 0, 0); PG8_STAGE(PG8_SA(1, 1), a1 + hstep, voffA);
            PG8_WAIT_L(8); PG8_BAR; PG8_WAIT_L(0); PG8_MMA(0, 0, At, B0); PG8_BAR; PG8_SCHED;
            PG8_LDB(B1, 0, 1); PG8_STAGE(PG8_SB(0, 0), b2, voffB);
            PG8_BAR; PG8_WAIT_L(0); PG8_MMA(0, 1, At, B1); PG8_BAR;
            PG8_LDA(At, 0, 1); PG8_STAGE(PG8_SA(0, 0), a2, voffA);
            PG8_BAR; PG8_WAIT_L(0); PG8_MMA(1, 0, At, B0); PG8_BAR; PG8_SCHED;
            PG8_STAGE(PG8_SB(0, 1), b2 + hstep, voffB);
            PG8_WAIT_V(6); PG8_BAR; PG8_MMA(1, 1, At, B1); PG8_BAR;
            PG8_LDB(B0, 1, 0); PG8_SCHED; PG8_LDA(At, 1, 0); PG8_STAGE(PG8_SA(0, 1), a2 + hstep, voffA);
            PG8_WAIT_L(8); PG8_BAR; PG8_WAIT_L(0); PG8_MMA(0, 0, At, B0); PG8_BAR; PG8_SCHED;
            PG8_LDB(B1, 1, 1); PG8_STAGE(PG8_SB(1, 0), b3, voffB);
            PG8_BAR; PG8_WAIT_L(0); PG8_MMA(0, 1, At, B1); PG8_BAR;
            PG8_LDA(At, 1, 1); PG8_STAGE(PG8_SA(1, 0), a3, voffA);
            PG8_BAR; PG8_WAIT_L(0); PG8_MMA(1, 0, At, B0); PG8_BAR; PG8_SCHED;
            PG8_STAGE(PG8_SB(1, 1), b3 + hstep, voffB);
            PG8_WAIT_V(6); PG8_BAR; PG8_MMA(1, 1, At, B1); PG8_BAR;
            }
        }
        if constexpr (ALIGN_EPI) { if (wr == 0) PG8_BAR; }
        if constexpr (!Epi::AFTER_DRAIN) { E(acc, cur, wr, wc, fr, fq); S.done(cur); }
        if (!has_next) break;
#pragma unroll
        for (int a = 0; a < 2; ++a)
#pragma unroll
            for (int b = 0; b < 2; ++b)
#pragma unroll
                for (int m = 0; m < 4; ++m)
#pragma unroll
                    for (int n = 0; n < 2; ++n) acc[a][b][m][n] = (f32x4){0.f, 0.f, 0.f, 0.f};
        cur = nxt; cA = nA; cB = nB; ++ui;
        if constexpr (ALIGN_EPI) { if (wr == 1) PG8_BAR; }
    }
    PG8_WAIT_V(0);
    if constexpr (!ALIGN_EPI) { if (wr == 0) PG8_BAR; }
    PG8_BAR;
    if constexpr (Epi::AFTER_DRAIN) { E.fused(acc, cur, wr, wc, fr, fq, lds, wid, lane); S.done(cur); }
#undef PG8_SA
#undef PG8_SB
#undef PG8_STAGE
#undef PG8_LDA
#undef PG8_LDB
#undef PG8_MMA
#undef PG8_WAIT_V
#undef PG8_WAIT_L
#undef PG8_BAR
#undef PG8_SCHED
}
}
#define GAS __attribute__((address_space(1)))
#define LAS __attribute__((address_space(3)))
typedef unsigned short bf16;
typedef unsigned v4u __attribute__((ext_vector_type(4)));
typedef float f32x4 __attribute__((ext_vector_type(4)));
typedef short bf16x8 __attribute__((ext_vector_type(8)));
typedef GAS unsigned gu32;
typedef GAS unsigned long long gu64;
#define RLX_AGENT __ATOMIC_RELAXED, __HIP_MEMORY_SCOPE_AGENT
#define LDS_WAIT() asm volatile("s_waitcnt lgkmcnt(0)" ::: "memory")
#define VM_WAIT() asm volatile("s_waitcnt vmcnt(0)" ::: "memory")
__device__ __forceinline__ unsigned long long rt() { return __builtin_amdgcn_s_memrealtime(); }
__device__ __forceinline__ unsigned f2bf(float f) { unsigned u = __builtin_bit_cast(unsigned, f); return (u + 0x7fffu + ((u >> 16) & 1u)) >> 16; }
__device__ __forceinline__ unsigned pk2(float lo, float hi) { return f2bf(lo) | (f2bf(hi) << 16); }

#define XB_TMO      128
#define XB_XCNT(j)  (256  + 64 * (j))
#define XB_XSUB(j)  (1280 + 64 * (j))
#define XB_XGEN(j)  (2304 + 64 * (j))
#define XB_TOP      3328
#define XB_TOPGEN   3392
#define XCD_BAR_WORDS 3456
#define XB_SPIN_CAP (1u << 18)

__device__ __forceinline__ unsigned xb_ld(unsigned* p)              { return __hip_atomic_load(p, __ATOMIC_RELAXED, __HIP_MEMORY_SCOPE_AGENT); }
__device__ __forceinline__ unsigned xb_add(unsigned* p, unsigned v) { return __hip_atomic_fetch_add(p, v, __ATOMIC_RELAXED, __HIP_MEMORY_SCOPE_AGENT); }
__device__ __forceinline__ unsigned xb_xcc_id() { return (unsigned)__builtin_amdgcn_s_getreg((3 << 11) | 20) & 0xFu; }
#define XB_SPIN(cond, bar) do { unsigned _sp = 0; while (cond) { __builtin_amdgcn_s_sleep(1); \
    if ((++_sp & 255u) == 0u) { if (xb_ld(&(bar)[XB_TMO])) break; if (_sp > XB_SPIN_CAP) { atomicAdd(&(bar)[XB_TMO], 1u); break; } } } } while (0)

struct XcdBarrier {
    unsigned* bar; unsigned x;
    volatile LAS unsigned* st;
};

__device__ __forceinline__ XcdBarrier xcd_barrier_post(unsigned* bar, volatile LAS unsigned* st) {
    XcdBarrier b; b.bar = bar; b.x = xb_xcc_id(); b.st = st;
    if (threadIdx.x == 0) (void)xb_add(&bar[XB_XCNT(b.x)], 1u);
    return b;
}
__device__ __forceinline__ void xcd_barrier_complete(unsigned* bar, unsigned x, unsigned& nloc, unsigned& nx) {
    const unsigned G = gridDim.x * gridDim.y * gridDim.z;
    unsigned sum, cnt, mine, sp = 0u;
    for (;;) {
        sum = 0u; cnt = 0u; mine = 0u;
#pragma unroll
        for (unsigned j = 0; j < 16; ++j) { const unsigned c = xb_ld(&bar[XB_XCNT(j)]); sum += c; cnt += (c > 0u) ? 1u : 0u; mine = (j == x) ? c : mine; }
        if (sum == G) break;
        __builtin_amdgcn_s_sleep(1);
        if ((++sp & 255u) == 0u) { if (xb_ld(&bar[XB_TMO])) break; if (sp > XB_SPIN_CAP) { atomicAdd(&bar[XB_TMO], 1u); break; } }
    }
    nloc = mine > 0u ? mine : 1u; nx = cnt > 0u ? cnt : 1u;
}

__device__ __forceinline__ void xcd_barrier(const XcdBarrier& b) {
    asm volatile("s_waitcnt vmcnt(0)" ::: "memory");
    __syncthreads();
    if (threadIdx.x == 0) {
        unsigned* bar = b.bar;
        __builtin_amdgcn_s_waitcnt(0);
        unsigned nloc = b.st[0], nx = b.st[1];
        if (nloc == 0u) { xcd_barrier_complete(bar, b.x, nloc, nx); b.st[0] = nloc; b.st[1] = nx; }
        const unsigned old = xb_add(&bar[XB_XSUB(b.x)], 1u);
        const unsigned gen = old / nloc;
        if (old + 1u == (gen + 1u) * nloc) {
            __builtin_amdgcn_fence(__ATOMIC_RELEASE, "agent");
            asm volatile("s_waitcnt vmcnt(0)" ::: "memory");
            const unsigned og = xb_add(&bar[XB_TOP], 1u);
            const unsigned tg = og / nx;
            if (og + 1u == (tg + 1u) * nx) xb_add(&bar[XB_TOPGEN], 1u);
            else XB_SPIN(xb_ld(&bar[XB_TOPGEN]) == tg, bar);
            __builtin_amdgcn_fence(__ATOMIC_ACQUIRE, "agent");
            xb_add(&bar[XB_XGEN(b.x)], 1u);
            asm volatile("s_waitcnt vmcnt(0)" ::: "memory");
        } else {
            XB_SPIN(xb_ld(&bar[XB_XGEN(b.x)]) == gen, bar);
            __builtin_amdgcn_fence(__ATOMIC_ACQUIRE, "agent");
            asm volatile("s_waitcnt vmcnt(0)" ::: "memory");
        }
    }
    __syncthreads();
}
constexpr int NWAVES = 8, NT = NWAVES * 64;
constexpr int DM = 1024, NB_P = 8, SEQ = 2048, NB_S = 128, LS = 8;
constexpr int MP = NB_P * SEQ, MS = NB_S * LS, M = MP + MS;
constexpr int NSEQ = NB_P + NB_S;
constexpr int IN_DIM = 6688, IN_PAD = 6912, PITCH = IN_DIM;
constexpr int PC_Z = 0, PC_XBC = 1024, PC_QKV = 2560, PC_GATE = 5632, PC_DT = 6656, PC_BETA = 6672, PC_ALPHA = 6680;
constexpr int DMIX = 2048, DFF = 2816, NGU = 2 * DFF, NMOD = 6 * DM;
constexpr int SSD_H = 16, SSD_P = 64, SSD_N = 128, SSD_CONV = 1536, GDN_H = 8, GDN_D = 128, GDN_CONV = 3072;
constexpr float EPS = 1e-6f;
constexpr size_t OFF_Y = 0, OFF_SSD_P = (size_t)M * DM, OFF_SSDC_P = OFF_SSD_P + (size_t)NB_P * SSD_H * SSD_P * SSD_N, OFF_GDN_P = OFF_SSDC_P + (size_t)NB_P * 3 * SSD_CONV,
                 OFF_GDNC_P = OFF_GDN_P + (size_t)NB_P * GDN_H * GDN_D * GDN_D, OFF_SSD_S = OFF_GDNC_P + (size_t)NB_P * 3 * GDN_CONV, OFF_SSDC_S = OFF_SSD_S + (size_t)NB_S * SSD_H * SSD_P * SSD_N,
                 OFF_GDN_S = OFF_SSDC_S + (size_t)NB_S * 3 * SSD_CONV, OFF_GDNC_S = OFF_GDN_S + (size_t)NB_S * GDN_H * GDN_D * GDN_D, OUT_TOTAL = OFF_GDNC_S + (size_t)NB_S * 3 * GDN_CONV;
static_assert(OUT_TOTAL == 55357440, "output size");
constexpr size_t MiB = 1u << 20;
constexpr size_t WS_CTL = 0, CTL_ZERO_BYTES = 1 * MiB;
constexpr size_t WS_WOUT = 1 * MiB, WS_WGU = 5 * MiB, WS_WDN = 16 * MiB, WS_MOD = 22 * MiB, WS_SSQ = 26 * MiB, WS_PROJ = 28 * MiB;
constexpr size_t PROJ_BYTES = (size_t)M * PITCH * 2;
constexpr size_t WS_T1 = WS_PROJ, WS_XN2 = WS_PROJ + 68 * MiB, WS_ACT = WS_PROJ + 102 * MiB, WS_T2 = WS_PROJ;
constexpr size_t WS_END = 251 * MiB;
static_assert(WS_WOUT + (size_t)DM * DMIX * 2 <= WS_WGU && WS_WGU + (size_t)NGU * DM * 2 <= WS_WDN && WS_WDN + (size_t)DM * DFF * 2 <= WS_MOD && WS_MOD + (size_t)NSEQ * NMOD * 4 <= WS_SSQ && WS_SSQ + (size_t)M * 16 * 4 <= WS_PROJ, "ws map");
static_assert(WS_PROJ + PROJ_BYTES <= WS_END && (size_t)M * DM * 4 <= 68 * MiB && (size_t)M * DM * 2 <= 34 * MiB && WS_ACT + (size_t)M * DFF * 2 <= WS_PROJ + PROJ_BYTES, "ws overlays");
static_assert((size_t)IN_PAD * DM * 2 <= (size_t)NB_S * SSD_H * SSD_P * SSD_N * 4 && (size_t)M * DM * 2 <= (size_t)NB_S * GDN_H * GDN_D * GDN_D * 4 && (size_t)M * DMIX * 2 == (size_t)M * DM * 4, "d_out scratch");
constexpr int CW_TMO = 0, CW_CODE = 1, CW_QUEUE = 64, CW_BAR = 4096;
constexpr int RING_OFF = 0, RING_BYTES = 131072, LDS_BYTES = 147456, LDSCTL_OFF = LDS_BYTES - 1024, MISC_OFF = LDSCTL_OFF + 320;
struct Args { const float* in[28]; float* out; unsigned char* ws; int ph_lo, ph_hi, li, pad; };
enum { I_XP = 0, I_XS, I_CP, I_CS, I_SSD, I_SSDC, I_GDN, I_GDNC, I_WADA, I_BADA, I_NMPRE, I_NMPOST, I_NFPRE, I_NFPOST, I_WIN, I_SCW, I_SCB, I_SDTB, I_SALOG, I_SD, I_SNW, I_GCW, I_GDTB, I_GALOG, I_GNW, I_WOUT, I_WGU, I_WDN };
__device__ __forceinline__ float bf2f(unsigned v) { return __uint_as_float(v << 16); }
__device__ __forceinline__ float silu_acc(float x) { return x / (1.f + expf(-x)); }
__device__ __forceinline__ float softplus_acc(float x) { const float e = __expf(-fabsf(x)); const float l = (e < 0.03125f) ? e * (1.f - e * (0.5f - e * (0.33333334f - 0.25f * e))) : __logf(1.f + e); return fmaxf(x, 0.f) + l; }
template <int MASK> __device__ __forceinline__ float sx(float v) { return __int_as_float(__builtin_amdgcn_ds_swizzle(__float_as_int(v), 0x1f | (MASK << 10))); }
__device__ __forceinline__ float sx32(float v, int lane) { return __int_as_float(__builtin_amdgcn_ds_bpermute((lane ^ 32) << 2, __float_as_int(v))); }
__device__ __forceinline__ float sup(float v, int d, int lane) { return __int_as_float(__builtin_amdgcn_ds_bpermute((lane - d) << 2, __float_as_int(v))); }
__device__ __forceinline__ float wave_sum(float v, int lane) { v += sx<1>(v); v += sx<2>(v); v += sx<4>(v); v += sx<8>(v); v += sx<16>(v); v += sx32(v, lane); return v; }
__device__ __forceinline__ bf16* ws_bf(const Args& a, size_t off) { return (bf16*)(a.ws + off); }
__device__ __forceinline__ float* ws_f(const Args& a, size_t off) { return (float*)(a.ws + off); }
__device__ __forceinline__ bf16* win_t(const Args& a) { return (bf16*)(a.out + OFF_SSD_S); }
__device__ __forceinline__ bf16* xn_buf(const Args& a) { return (bf16*)(a.out + OFF_GDN_S); }
__device__ __forceinline__ bf16* mixed_buf(const Args& a) { return (bf16*)(a.out + OFF_Y); }
__device__ __forceinline__ const float* x_row(const Args& a, int row) { return row < MP ? a.in[I_XP] + (size_t)row * DM : a.in[I_XS] + (size_t)(row - MP) * DM; }
__device__ __forceinline__ int seq_of_row(int row) { return row < MP ? (row >> 11) : NB_P + ((row - MP) >> 3); }

__device__ __forceinline__ int dest_row(int which, int n) {
    if (which == 1) { if (n < 2560) return n; if (n < 2576) return PC_DT + (n - 2560); if (n < 6672) return n - 16; return n; }
    if (which == 2) { const int j = n < DFF ? n : n - DFF; return 256 * (j >> 7) + (n < DFF ? 0 : 128) + (j & 127); }
    return n;
}
__device__ __forceinline__ void p0_transpose_item(const float* W, int K, int N, bf16* WT, int which, LAS float* scr, int item, int lane) {
    const int nblk = N / 32, kb = item / nblk, nb = item % nblk, k0 = 64 * kb, n0 = 32 * nb;
#pragma unroll 8
    for (int i = 0; i < 32; ++i) { const int kk = 2 * i + (lane >> 5); scr[kk * 33 + (lane & 31)] = W[(size_t)(k0 + kk) * N + n0 + (lane & 31)]; }
    LDS_WAIT(); asm volatile("" ::: "memory");
    const int c = lane & 7;
#pragma unroll
    for (int j = 0; j < 4; ++j) { const int n = (lane >> 3) + 8 * j; const LAS float* s = scr + (8 * c) * 33 + n;
        v4u o; o.x = pk2(s[0 * 33], s[1 * 33]); o.y = pk2(s[2 * 33], s[3 * 33]); o.z = pk2(s[4 * 33], s[5 * 33]); o.w = pk2(s[6 * 33], s[7 * 33]);
        *(GAS v4u*)(WT + (size_t)dest_row(which, n0 + n) * K + k0 + 8 * c) = o; }
    LDS_WAIT(); asm volatile("" ::: "memory");
}
constexpr int TI_IN = (DM / 64) * (IN_DIM / 32), TI_OUT = (DMIX / 64) * (DM / 32), TI_GU = (DM / 64) * (NGU / 32), TI_DN = (DFF / 64) * (DM / 32), TI_PAD = IN_PAD - IN_DIM;
constexpr int TI_ALL = TI_IN + TI_OUT + TI_GU + TI_DN + TI_PAD;
constexpr int ADA_RB = 17, ADA_ITEMS = (NSEQ / ADA_RB) * (NMOD / 512);
static_assert(NSEQ % ADA_RB == 0 && IN_DIM % 32 == 0 && NGU % 32 == 0 && DFF % 64 == 0, "P0 tiling");
__device__ __forceinline__ void p0_ada_item(const Args& a, LAS unsigned char* lds, int it, int tid, int wave, int lane) {
    LAS float* cs = (LAS float*)lds;
    const int rb = it / (NMOD / 512), cb = it % (NMOD / 512);
    for (int idx = tid; idx < ADA_RB * DM; idx += NT) { const int r = idx >> 10, k = idx & 1023, row = ADA_RB * rb + r;
        const float c = row < NB_P ? a.in[I_CP][row * DM + k] : a.in[I_CS][(row - NB_P) * DM + k]; cs[idx] = silu_acc(c); }
    __syncthreads();
    const int n = 512 * cb + 64 * wave + lane;
    const float* wp = a.in[I_WADA] + n;
    float acc[ADA_RB];
#pragma unroll
    for (int r = 0; r < ADA_RB; ++r) acc[r] = 0.f;
    for (int k = 0; k < DM; k += 4) {
        const float w0 = wp[(size_t)(k + 0) * NMOD], w1 = wp[(size_t)(k + 1) * NMOD], w2 = wp[(size_t)(k + 2) * NMOD], w3 = wp[(size_t)(k + 3) * NMOD];
#pragma unroll
        for (int r = 0; r < ADA_RB; ++r) { const f32x4 c4 = *(const LAS f32x4*)(cs + r * DM + k); acc[r] += c4.x * w0; acc[r] += c4.y * w1; acc[r] += c4.z * w2; acc[r] += c4.w * w3; }
    }
    float* mod = ws_f(a, WS_MOD); const float b = a.in[I_BADA][n];
#pragma unroll
    for (int r = 0; r < ADA_RB; ++r) mod[(size_t)(ADA_RB * rb + r) * NMOD + n] = acc[r] + b;
    __syncthreads();
}
__device__ __forceinline__ void p0_prologue(const Args& a, LAS unsigned char* lds, int bid, int G, int tid, int wave, int lane) {
    const bool split = G > 128;
    const int ada_lo = 0, ada_G = split ? ADA_ITEMS : G;
    if (!split || bid < ADA_ITEMS) for (int it = bid - ada_lo; it < ADA_ITEMS; it += ada_G) p0_ada_item(a, lds, it, tid, wave, lane);
    if (!split || bid >= ADA_ITEMS) {
        LAS float* scr = (LAS float*)(lds + wave * 16384);
        const int gw = (split ? bid - ADA_ITEMS : bid) * NWAVES + wave, NGW = (split ? G - ADA_ITEMS : G) * NWAVES;
        for (int it = gw; it < TI_ALL; it += NGW) {
            int r = it;
            if (r < TI_IN) { p0_transpose_item(a.in[I_WIN], DM, IN_DIM, win_t(a), 1, scr, r, lane); continue; } r -= TI_IN;
            if (r < TI_OUT) { p0_transpose_item(a.in[I_WOUT], DMIX, DM, ws_bf(a, WS_WOUT), 0, scr, r, lane); continue; } r -= TI_OUT;
            if (r < TI_GU) { p0_transpose_item(a.in[I_WGU], DM, NGU, ws_bf(a, WS_WGU), 2, scr, r, lane); continue; } r -= TI_GU;
            if (r < TI_DN) { p0_transpose_item(a.in[I_WDN], DFF, DM, ws_bf(a, WS_WDN), 0, scr, r, lane); continue; } r -= TI_DN;
            { GAS v4u* o = (GAS v4u*)(win_t(a) + (size_t)(IN_DIM + r) * DM) + lane; o[0] = (v4u){0u, 0u, 0u, 0u}; o[64] = (v4u){0u, 0u, 0u, 0u}; }
        }
    }
}
__device__ __forceinline__ void p1_xn(const Args& a, int gw, int NGW, int lane) {
    const float* mod = ws_f(a, WS_MOD); bf16* XN = xn_buf(a); const float* nw = a.in[I_NMPRE];
    for (int row = gw; row < M; row += NGW) {
        const f32x4* xr = (const f32x4*)x_row(a, row) + lane; const float* mr = mod + (size_t)seq_of_row(row) * NMOD;
        f32x4 v[4]; float s = 0.f;
#pragma unroll
        for (int j = 0; j < 4; ++j) { v[j] = xr[64 * j]; s += (v[j].x * v[j].x + v[j].y * v[j].y) + (v[j].z * v[j].z + v[j].w * v[j].w); }
        const float rs = 1.f / sqrtf(wave_sum(s, lane) * (1.f / DM) + EPS);
        unsigned long long* o8 = (unsigned long long*)(XN + (size_t)row * DM) + lane;
#pragma unroll
        for (int j = 0; j < 4; ++j) { const int c = 4 * lane + 256 * j; const f32x4 w = *(const f32x4*)(nw + c), sh = *(const f32x4*)(mr + c), sc = *(const f32x4*)(mr + DM + c);
            const f32x4 h = v[j] * rs * w * (sc + 1.f) + sh;
            o8[64 * j] = (unsigned long long)pk2(h.x, h.y) | ((unsigned long long)pk2(h.z, h.w) << 32); }
    }
}
typedef short bf16x8 __attribute__((ext_vector_type(8)));
typedef unsigned u32x2 __attribute__((ext_vector_type(2)));
constexpr int P128 = 136, P64 = 72, LP = 68, TP = 36;
#define MFMA16(a, b, c) __builtin_amdgcn_mfma_f32_16x16x32_bf16(a, b, c, 0, 0, 0)
__device__ __forceinline__ bf16x8 ldfrag(const LAS bf16* base, int pitch, int row0, int k0, int lane) { return *(const LAS bf16x8*)(base + (row0 + (lane & 15)) * pitch + k0 + 8 * (lane >> 4)); }
typedef float f32x2_t __attribute__((ext_vector_type(2))); typedef __bf16 bf16x2_t __attribute__((ext_vector_type(2)));
__device__ __forceinline__ unsigned cvtpk(float lo, float hi) { f32x2_t v = {lo, hi}; bf16x2_t b = __builtin_convertvector(v, bf16x2_t); return __builtin_bit_cast(unsigned, b); }
__device__ __forceinline__ u32x2 pack4(f32x4 v) { u32x2 r; r.x = cvtpk(v[0], v[1]); r.y = cvtpk(v[2], v[3]); return r; }
__device__ __forceinline__ float silu_f(float x) { return x * __builtin_amdgcn_rcpf(1.f + __expf(-x)); }
__device__ __forceinline__ void unpack8(v4u r, float (&x)[8]) { x[0] = bf2f(r.x & 0xffffu); x[1] = __uint_as_float(r.x & 0xffff0000u); x[2] = bf2f(r.y & 0xffffu); x[3] = __uint_as_float(r.y & 0xffff0000u);
    x[4] = bf2f(r.z & 0xffffu); x[5] = __uint_as_float(r.z & 0xffff0000u); x[6] = bf2f(r.w & 0xffffu); x[7] = __uint_as_float(r.w & 0xffff0000u); }
__device__ __forceinline__ v4u tpack(const unsigned (&outp)[8][4], int c) { const int cp = c >> 1; const unsigned sel = (c & 1) ? 0x07060302u : 0x05040100u; v4u o;
    o.x = __builtin_amdgcn_perm(outp[1][cp], outp[0][cp], sel); o.y = __builtin_amdgcn_perm(outp[3][cp], outp[2][cp], sel); o.z = __builtin_amdgcn_perm(outp[5][cp], outp[4][cp], sel); o.w = __builtin_amdgcn_perm(outp[7][cp], outp[6][cp], sel); return o; }
__device__ __forceinline__ void conv8x8(const v4u (&R)[11], const float (&cw)[4][8], const float (&cb)[8], unsigned (&outp)[8][4], float (&ssq)[8]) {
    float acc[4][8];
#pragma unroll
    for (int i = 0; i < 11; ++i) { float x[8]; unpack8(R[i], x);
#pragma unroll
        for (int j = 0; j < 4; ++j) { const int l = i - j;
            if (l >= 0 && l < 8) {
#pragma unroll
                for (int c = 0; c < 8; ++c) acc[l & 3][c] = (j == 0 ? cb[c] : acc[l & 3][c]) + cw[j][c] * x[c]; } }
        if (i >= 3) { const int l = i - 3; float s = 0.f;
#pragma unroll
            for (int c = 0; c < 8; ++c) { acc[l & 3][c] = silu_f(acc[l & 3][c]); s += acc[l & 3][c] * acc[l & 3][c]; }
            ssq[l] = s;
#pragma unroll
            for (int cp = 0; cp < 4; ++cp) outp[l][cp] = cvtpk(acc[l & 3][2 * cp], acc[l & 3][2 * cp + 1]); } }
}
__device__ __forceinline__ void lower_pair(int p, int& i, int& j) { i = p >= 6 ? 3 : (p >= 3 ? 2 : (p >= 1 ? 1 : 0)); j = p - (i * (i + 1)) / 2; }
__device__ __forceinline__ void upper_pair(int z, int& i, int& j) { i = z >= 5 ? 2 : (z >= 3 ? 1 : 0); j = z >= 5 ? 3 : (z >= 3 ? z - 1 : z + 1); }
__device__ __forceinline__ void tri_inverse64(LAS float* Lm, LAS float* tmp, int wave, int lane) {
    const int c = lane & 15, q = lane >> 4;
    if (wave == 0) {
        LAS float* Lb = Lm + (16 * q) * LP + 16 * q; float t[16];
#pragma unroll
        for (int l = 0; l < 16; ++l) { float acc = (l == c) ? 1.f : 0.f;
#pragma unroll
            for (int s = 0; s < l; ++s) acc -= Lb[l * LP + s] * t[s];
            t[l] = acc; }
#pragma unroll
        for (int l = 0; l < 16; ++l) Lb[l * LP + c] = t[l];
    }
    __syncthreads();
    if (wave < 2) {
        const int o = 32 * wave; f32x4 acc = (f32x4){0.f, 0.f, 0.f, 0.f};
#pragma unroll
        for (int kk = 0; kk < 4; ++kk) acc = __builtin_amdgcn_mfma_f32_16x16x4f32(Lm[(o + 16 + c) * LP + o + 4 * kk + q], Lm[(o + 4 * kk + q) * LP + o + c], acc, 0, 0, 0);
#pragma unroll
        for (int r = 0; r < 4; ++r) tmp[(16 * wave + 4 * q + r) * TP + c] = acc[r];
    }
    __syncthreads();
    if (wave < 2) {
        const int o = 32 * wave; f32x4 acc = (f32x4){0.f, 0.f, 0.f, 0.f};
#pragma unroll
        for (int kk = 0; kk < 4; ++kk) acc = __builtin_amdgcn_mfma_f32_16x16x4f32(Lm[(o + 16 + c) * LP + o + 16 + 4 * kk + q], tmp[(16 * wave + 4 * kk + q) * TP + c], acc, 0, 0, 0);
#pragma unroll
        for (int r = 0; r < 4; ++r) Lm[(o + 16 + 4 * q + r) * LP + o + c] = -acc[r];
    }
    __syncthreads();
    if (wave < 4) {
        const int ti = wave >> 1, tj = wave & 1; f32x4 acc = (f32x4){0.f, 0.f, 0.f, 0.f};
#pragma unroll
        for (int kk = 0; kk < 8; ++kk) acc = __builtin_amdgcn_mfma_f32_16x16x4f32(Lm[(32 + 16 * ti + c) * LP + 4 * kk + q], Lm[(4 * kk + q) * LP + 16 * tj + c], acc, 0, 0, 0);
#pragma unroll
        for (int r = 0; r < 4; ++r) tmp[(16 * ti + 4 * q + r) * TP + 16 * tj + c] = acc[r];
    }
    __syncthreads();
    if (wave < 4) {
        const int ti = wave >> 1, tj = wave & 1; f32x4 acc = (f32x4){0.f, 0.f, 0.f, 0.f};
#pragma unroll
        for (int kk = 0; kk < 8; ++kk) acc = __builtin_amdgcn_mfma_f32_16x16x4f32(Lm[(32 + 16 * ti + c) * LP + 32 + 4 * kk + q], tmp[(4 * kk + q) * TP + 16 * tj + c], acc, 0, 0, 0);
#pragma unroll
        for (int r = 0; r < 4; ++r) Lm[(32 + 16 * ti + 4 * q + r) * LP + 16 * tj + c] = -acc[r];
    }
    __syncthreads();
}
constexpr int G_Q = 0, G_T1 = 0, G_T2 = 9216, G_K = 18432, G_W = 18432, G_KT = 35840, G_VT = 54272, G_VN = 54272, G_L = 72704, G_VNS = 72704, G_PART = 72704, G_ATT = 91136, G_TMP = 100352, G_ST = 104960, G_VEC = 139776;
static_assert(G_VEC + 11 * 256 <= LDSCTL_OFF, "GDN LDS map");
__device__ __forceinline__ void gdn_chunk_item(const Args& a, LAS unsigned char* lds, int b, int h, int tid_, int wave, int lane_) {
    const bf16* proj = ws_bf(a, WS_PROJ); bf16* mixed = mixed_buf(a);
    const int row0 = b * SEQ;
    LAS bf16* Lq = (LAS bf16*)(lds + G_Q); LAS bf16* Lk = (LAS bf16*)(lds + G_K); LAS bf16* LkT = (LAS bf16*)(lds + G_KT); LAS bf16* LvT = (LAS bf16*)(lds + G_VT);
    LAS bf16* LT1 = (LAS bf16*)(lds + G_T1); LAS bf16* LT2 = (LAS bf16*)(lds + G_T2); LAS bf16* LW = (LAS bf16*)(lds + G_W); LAS bf16* Lvn = (LAS bf16*)(lds + G_VN); LAS bf16* Lvns = (LAS bf16*)(lds + G_VNS);
    LAS bf16* Latt = (LAS bf16*)(lds + G_ATT); LAS bf16* LST = (LAS bf16*)(lds + G_ST); LAS float* LL = (LAS float*)(lds + G_L); LAS float* Ltmp = (LAS float*)(lds + G_TMP); LAS float* Lpart = (LAS float*)(lds + G_PART);
    LAS float* vgc = (LAS float*)(lds + G_VEC); LAS float* vbeta = vgc + 64; LAS float* vrq = vgc + 128; LAS float* vrk = vgc + 192; LAS float* vqs = vgc + 256; LAS float* vvsc = vgc + 320; LAS float* vt2s = vgc + 384; LAS float* vossq = vgc + 448; LAS float* vmisc = vgc + 576;
    const float Ag = -expf(a.in[I_GALOG][h]), dtb = a.in[I_GDTB][h];
    const float cb[8] = {0.f, 0.f, 0.f, 0.f, 0.f, 0.f, 0.f, 0.f};
    f32x4 Sacc[4][2];
#pragma unroll
    for (int x = 0; x < 4; ++x)
#pragma unroll
        for (int d = 0; d < 2; ++d) Sacc[x][d] = (f32x4){0.f, 0.f, 0.f, 0.f};
    for (int i = tid_; i < 128 * P128 / 2; i += NT) ((LAS unsigned*)LST)[i] = 0u;
    const int li = wave >> 1, dvh = wave & 1;
    for (int ch = 0; ch < SEQ / 64; ++ch) {
        const int t0 = 64 * ch;
        int lane = lane_;
        asm volatile("" : "+v"(lane));
        const int tid = wave * 64 + lane, c16 = lane & 15, q4 = lane >> 4, oct = tid % 48, tg = tid / 48, seg = oct >> 4, c0 = 8 * (oct & 15);
        if (tid < 384) {
            v4u R[11]; const bf16* src = (proj + (size_t)(row0 + t0 - 3) * PITCH + PC_QKV + h * 128) + (unsigned)(8 * tg * PITCH + seg * 1024 + c0);
#pragma unroll
            for (int i = 0; i < 11; ++i) R[i] = (t0 + 8 * tg - 3 + i >= 0) ? *(const v4u*)(src + (size_t)i * PITCH) : (v4u){0u, 0u, 0u, 0u};
            float cw[4][8];
#pragma unroll
            for (int j = 0; j < 4; ++j) { const f32x4 w0 = *(const f32x4*)(a.in[I_GCW] + j * GDN_CONV + seg * 1024 + h * 128 + c0), w1 = *(const f32x4*)(a.in[I_GCW] + j * GDN_CONV + seg * 1024 + h * 128 + c0 + 4);
                cw[j][0] = w0.x; cw[j][1] = w0.y; cw[j][2] = w0.z; cw[j][3] = w0.w; cw[j][4] = w1.x; cw[j][5] = w1.y; cw[j][6] = w1.z; cw[j][7] = w1.w; }
            unsigned outp[8][4]; float ssq[8];
            conv8x8(R, cw, cb, outp, ssq);
            if (seg < 2) { LAS bf16* dst = (seg == 0 ? Lq : Lk) + (8 * tg) * P128 + c0;
#pragma unroll
                for (int l = 0; l < 8; ++l) { *(LAS v4u*)(dst + l * P128) = (v4u){outp[l][0], outp[l][1], outp[l][2], outp[l][3]}; Lpart[(seg * 64 + 8 * tg + l) * 16 + (oct & 15)] = ssq[l]; } }
            if (seg >= 1) { LAS bf16* dst = (seg == 1 ? LkT : LvT) + c0 * P64 + 8 * tg;
#pragma unroll
                for (int c = 0; c < 8; ++c) *(LAS v4u*)(dst + c * P64) = tpack(outp, c); }
        } else if (wave == 6) {
            const size_t r = (size_t)(row0 + t0 + lane) * PITCH;
            const float g = Ag * softplus_acc(bf2f(proj[r + PC_ALPHA + h]) + dtb), be = 1.f / (1.f + __expf(-bf2f(proj[r + PC_BETA + h])));
            float gc = g;
#pragma unroll
            for (int d = 1; d < 64; d <<= 1) { const float v = sup(gc, d, lane); if (lane >= d) gc += v; }
            vgc[lane] = gc; vbeta[lane] = be;
        }
        __syncthreads();
        if (tid < 64) { float sq = 0.f, sk = 0.f;
#pragma unroll
            for (int o = 0; o < 16; ++o) { sq += Lpart[tid * 16 + o]; sk += Lpart[(64 + tid) * 16 + o]; }
            const float rq = 1.f / sqrtf(sq + 1e-6f), rk = 1.f / sqrtf(sk + 1e-6f), gc = vgc[tid], gl = vgc[63], be = vbeta[tid];
            vrq[tid] = rq; vrk[tid] = rk; vqs[tid] = __expf(gc) * rq * 0.08838834764831845f; vvsc[tid] = __expf(gl - gc) * rk; vt2s[tid] = be * __expf(gc) * rk;
            if (tid == 0) vmisc[0] = __expf(gl); }
        __syncthreads();
        f32x4 oacc[4];
#pragma unroll
        for (int tt = 0; tt < 4; ++tt) oacc[tt] = (f32x4){0.f, 0.f, 0.f, 0.f};
#pragma unroll
        for (int ks = 0; ks < 4; ++ks) { const bf16x8 qf = ldfrag(Lq, P128, 16 * li, 32 * ks, lane);
#pragma unroll
            for (int tt = 0; tt < 4; ++tt) oacc[tt] = MFMA16(ldfrag(LST, P128, 16 * (4 * dvh + tt), 32 * ks, lane), qf, oacc[tt]); }
        for (int job = wave; job < 20; job += 8) { const int type = job >= 10 ? 1 : 0; int ti, tj; lower_pair(job - 10 * type, ti, tj);
            f32x4 acc = (f32x4){0.f, 0.f, 0.f, 0.f}; const LAS bf16* Y = type ? Lq : Lk;
#pragma unroll
            for (int ks = 0; ks < 4; ++ks) acc = MFMA16(ldfrag(Lk, P128, 16 * tj, 32 * ks, lane), ldfrag(Y, P128, 16 * ti, 32 * ks, lane), acc);
            const int l = 16 * ti + c16, s0 = 16 * tj + 4 * q4; const float gcl = vgc[l]; const f32x4 gcs = *(const LAS f32x4*)(vgc + s0), rks = *(const LAS f32x4*)(vrk + s0);
            const float rowf = type ? vrq[l] * 0.08838834764831845f : vbeta[l] * vrk[l]; f32x4 val;
#pragma unroll
            for (int r = 0; r < 4; ++r) { const bool ok = type ? (s0 + r <= l) : (s0 + r < l); val[r] = ok ? acc[r] * rowf * rks[r] * __expf(gcl - gcs[r]) : 0.f; }
            if (type == 0) *(LAS f32x4*)(LL + l * LP + s0) = val; else *(LAS u32x2*)(Latt + l * P64 + s0) = pack4(val); }
        for (int z = wave; z < 12; z += 8) { int ti, tj; upper_pair(z >= 6 ? z - 6 : z, ti, tj); const int l = 16 * ti + c16, s0 = 16 * tj + 4 * q4;
            if (z < 6) *(LAS f32x4*)(LL + l * LP + s0) = (f32x4){0.f, 0.f, 0.f, 0.f}; else *(LAS u32x2*)(Latt + l * P64 + s0) = (u32x2){0u, 0u}; }
        __syncthreads();
        tri_inverse64(LL, Ltmp, wave, lane);
        { const int l = tid >> 3, s0 = 8 * (tid & 7); const f32x4 ta = *(const LAS f32x4*)(LL + l * LP + s0), tb = *(const LAS f32x4*)(LL + l * LP + s0 + 4);
            const f32x4 ba = *(const LAS f32x4*)(vbeta + s0), bb = *(const LAS f32x4*)(vbeta + s0 + 4), sa = *(const LAS f32x4*)(vt2s + s0), sb = *(const LAS f32x4*)(vt2s + s0 + 4);
            const u32x2 p0 = pack4(ta * ba), p1 = pack4(tb * bb), r0 = pack4(ta * sa), r1 = pack4(tb * sb);
            *(LAS v4u*)(LT1 + l * P64 + s0) = (v4u){p0.x, p0.y, p1.x, p1.y}; *(LAS v4u*)(LT2 + l * P64 + s0) = (v4u){r0.x, r0.y, r1.x, r1.y}; }
        __syncthreads();
        f32x4 uacc[4], wacc[4];
#pragma unroll
        for (int lt = 0; lt < 4; ++lt) { uacc[lt] = (f32x4){0.f, 0.f, 0.f, 0.f}; wacc[lt] = (f32x4){0.f, 0.f, 0.f, 0.f}; }
#pragma unroll
        for (int ks = 0; ks < 2; ++ks) { const bf16x8 vf = ldfrag(LvT, P64, 16 * wave, 32 * ks, lane), kf = ldfrag(LkT, P64, 16 * wave, 32 * ks, lane);
#pragma unroll
            for (int lt = 2 * ks; lt < 4; ++lt) { uacc[lt] = MFMA16(ldfrag(LT1, P64, 16 * lt, 32 * ks, lane), vf, uacc[lt]); wacc[lt] = MFMA16(kf, ldfrag(LT2, P64, 16 * lt, 32 * ks, lane), wacc[lt]); } }
#pragma unroll
        for (int lt = 0; lt < 4; ++lt) *(LAS u32x2*)(LW + (16 * lt + c16) * P128 + 16 * wave + 4 * q4) = pack4(wacc[lt]);
        __syncthreads();
        {
            f32x4 ws[4];
#pragma unroll
            for (int lt = 0; lt < 4; ++lt) ws[lt] = (f32x4){0.f, 0.f, 0.f, 0.f};
#pragma unroll
            for (int ks = 0; ks < 4; ++ks) { const bf16x8 sf = ldfrag(LST, P128, 16 * wave, 32 * ks, lane);
#pragma unroll
                for (int lt = 0; lt < 4; ++lt) ws[lt] = MFMA16(ldfrag(LW, P128, 16 * lt, 32 * ks, lane), sf, ws[lt]); }
#pragma unroll
            for (int lt = 0; lt < 4; ++lt) { const f32x4 vn = uacc[lt] - ws[lt]; const f32x4 sc = *(const LAS f32x4*)(vvsc + 16 * lt + 4 * q4);
                *(LAS u32x2*)(Lvn + (16 * wave + c16) * P64 + 16 * lt + 4 * q4) = pack4(vn); *(LAS u32x2*)(Lvns + (16 * wave + c16) * P64 + 16 * lt + 4 * q4) = pack4(vn * sc); }
        }
        __syncthreads();
        {
            const float ge = vmisc[0];
#pragma unroll
            for (int x = 0; x < 4; ++x)
#pragma unroll
                for (int d = 0; d < 2; ++d) Sacc[x][d] = Sacc[x][d] * ge;
#pragma unroll
            for (int ks = 0; ks < 2; ++ks) { bf16x8 kf[4];
#pragma unroll
                for (int x = 0; x < 4; ++x) kf[x] = ldfrag(LkT, P64, 16 * (4 * dvh + x), 32 * ks, lane);
#pragma unroll
                for (int d = 0; d < 2; ++d) { const bf16x8 nf = ldfrag(Lvns, P64, 16 * (2 * li + d), 32 * ks, lane);
#pragma unroll
                    for (int x = 0; x < 4; ++x) Sacc[x][d] = MFMA16(kf[x], nf, Sacc[x][d]); } }
#pragma unroll
            for (int x = 0; x < 4; ++x)
#pragma unroll
                for (int d = 0; d < 2; ++d) *(LAS u32x2*)(LST + (16 * (2 * li + d) + c16) * P128 + 16 * (4 * dvh + x) + 4 * q4) = pack4(Sacc[x][d]);
            const float qsl = vqs[16 * li + c16];
#pragma unroll
            for (int tt = 0; tt < 4; ++tt) oacc[tt] = oacc[tt] * qsl;
            for (int ks = 0; ks < (li >= 2 ? 2 : 1); ++ks) { const bf16x8 af = ldfrag(Latt, P64, 16 * li, 32 * ks, lane);
#pragma unroll
                for (int tt = 0; tt < 4; ++tt) oacc[tt] = MFMA16(ldfrag(Lvn, P64, 16 * (4 * dvh + tt), 32 * ks, lane), af, oacc[tt]); }
            float sq = 0.f;
#pragma unroll
            for (int tt = 0; tt < 4; ++tt) sq += (oacc[tt][0] * oacc[tt][0] + oacc[tt][1] * oacc[tt][1]) + (oacc[tt][2] * oacc[tt][2] + oacc[tt][3] * oacc[tt][3]);
            sq += sx<16>(sq); sq += sx32(sq, lane);
            if (q4 == 0) vossq[(16 * li + c16) * 2 + dvh] = sq;
            const size_t row = (size_t)(row0 + t0 + 16 * li + c16);
            unsigned long long gg[4];
#pragma unroll
            for (int tt = 0; tt < 4; ++tt) gg[tt] = *(const unsigned long long*)(proj + row * PITCH + PC_GATE + h * 128 + 16 * (4 * dvh + tt) + 4 * q4);
            __syncthreads();
            const float rs = 1.f / sqrtf((vossq[(16 * li + c16) * 2] + vossq[(16 * li + c16) * 2 + 1]) * (1.f / GDN_D) + EPS);
#pragma unroll
            for (int tt = 0; tt < 4; ++tt) { const int dv0 = 16 * (4 * dvh + tt) + 4 * q4; const f32x4 w = *(const f32x4*)(a.in[I_GNW] + dv0);
                const float g0 = silu_f(bf2f((unsigned)gg[tt] & 0xffffu)), g1 = silu_f(bf2f(((unsigned)gg[tt]) >> 16)), g2 = silu_f(bf2f((unsigned)(gg[tt] >> 32) & 0xffffu)), g3 = silu_f(bf2f((unsigned)(gg[tt] >> 48)));
                const f32x4 o = oacc[tt] * rs * w * (f32x4){g0, g1, g2, g3};
                *(u32x2*)(mixed + row * DMIX + DM + h * 128 + dv0) = pack4(o); }
        }
    }
    const int c16 = lane_ & 15, q4 = lane_ >> 4;
    float* so = a.out + OFF_GDN_P + ((size_t)b * GDN_H + h) * (GDN_D * GDN_D);
#pragma unroll
    for (int x = 0; x < 4; ++x)
#pragma unroll
        for (int d = 0; d < 2; ++d)
#pragma unroll
            for (int r = 0; r < 4; ++r) so[(size_t)(16 * (4 * dvh + x) + 4 * q4 + r) * GDN_D + 16 * (2 * li + d) + c16] = Sacc[x][d][r];
    __syncthreads();
}
constexpr int S_C = 0, S_B = 17408, S_BT = 34816, S_XT = 53248, S_XWT = 71680, S_M = 90112, S_H = 108544, S_VEC = 143360;
static_assert(S_VEC + 6 * 256 <= LDSCTL_OFF, "SSD LDS map");
__device__ __forceinline__ void ssd_chunk_item(const Args& a, LAS unsigned char* lds, int b, int g, int hp, int tid_, int wave, int lane_) {
    const bf16* proj = ws_bf(a, WS_PROJ); bf16* mixed = mixed_buf(a); float* ssqo = ws_f(a, WS_SSQ);
    const int row0 = b * SEQ, h0 = 8 * g + 2 * hp;
    LAS bf16* LC = (LAS bf16*)(lds + S_C); LAS bf16* LB = (LAS bf16*)(lds + S_B); LAS bf16* LBT = (LAS bf16*)(lds + S_BT); LAS bf16* LXT = (LAS bf16*)(lds + S_XT); LAS bf16* LXW = (LAS bf16*)(lds + S_XWT);
    LAS bf16* LM = (LAS bf16*)(lds + S_M); LAS bf16* LH = (LAS bf16*)(lds + S_H);
    LAS float* vdt = (LAS float*)(lds + S_VEC); LAS float* vacs = vdt + 128;
    const int hh = wave >> 2, wq = wave & 3;
    const float A_h = -expf(a.in[I_SALOG][h0 + (lane_ >> 5 ? 1 : 0)]);
    f32x4 hacc[8];
#pragma unroll
    for (int nt = 0; nt < 8; ++nt) hacc[nt] = (f32x4){0.f, 0.f, 0.f, 0.f};
    for (int i = tid_; i < 2 * 64 * P128 / 2; i += NT) ((LAS unsigned*)LH)[i] = 0u;
    for (int ch = 0; ch < SEQ / 64; ++ch) {
        const int t0 = 64 * ch;
        int lane = lane_;
        asm volatile("" : "+v"(lane));
        const int tid = wave * 64 + lane, c16 = lane & 15, q4 = lane >> 4, oct = tid % 48, tg = tid / 48, seg = oct >> 4, c0 = 8 * (oct & 15);
        if (tid < 384) {
            const int chb = (seg == 0 ? h0 * 64 : (seg == 1 ? 1024 + g * 128 : 1280 + g * 128)) + c0;
            v4u R[11]; const bf16* src = (proj + (size_t)(row0 + t0 - 3) * PITCH + PC_XBC) + (unsigned)(8 * tg * PITCH + chb);
#pragma unroll
            for (int i = 0; i < 11; ++i) R[i] = (t0 + 8 * tg - 3 + i >= 0) ? *(const v4u*)(src + (size_t)i * PITCH) : (v4u){0u, 0u, 0u, 0u};
            float cw[4][8], cb[8];
#pragma unroll
            for (int j = 0; j < 4; ++j) { const f32x4 w0 = *(const f32x4*)(a.in[I_SCW] + j * SSD_CONV + chb), w1 = *(const f32x4*)(a.in[I_SCW] + j * SSD_CONV + chb + 4);
                cw[j][0] = w0.x; cw[j][1] = w0.y; cw[j][2] = w0.z; cw[j][3] = w0.w; cw[j][4] = w1.x; cw[j][5] = w1.y; cw[j][6] = w1.z; cw[j][7] = w1.w; }
            { const f32x4 b0 = *(const f32x4*)(a.in[I_SCB] + chb), b1 = *(const f32x4*)(a.in[I_SCB] + chb + 4); cb[0] = b0.x; cb[1] = b0.y; cb[2] = b0.z; cb[3] = b0.w; cb[4] = b1.x; cb[5] = b1.y; cb[6] = b1.z; cb[7] = b1.w; }
            unsigned outp[8][4]; float ssq[8];
            conv8x8(R, cw, cb, outp, ssq);
            if (seg >= 1) { LAS bf16* dst = (seg == 1 ? LB : LC) + (8 * tg) * P128 + c0;
#pragma unroll
                for (int l = 0; l < 8; ++l) *(LAS v4u*)(dst + l * P128) = (v4u){outp[l][0], outp[l][1], outp[l][2], outp[l][3]}; }
            if (seg <= 1) { LAS bf16* dst = (seg == 0 ? LXT : LBT) + c0 * P64 + 8 * tg;
#pragma unroll
                for (int c = 0; c < 8; ++c) *(LAS v4u*)(dst + c * P64) = tpack(outp, c); }
        } else if (wave == 6) {
#pragma unroll
            for (int e = 0; e < 2; ++e) { const float dtv = softplus_acc(bf2f(proj[(size_t)(row0 + t0 + lane) * PITCH + PC_DT + h0 + e]) + a.in[I_SDTB][h0 + e]);
                float ac = dtv * (-expf(a.in[I_SALOG][h0 + e]));
#pragma unroll
                for (int d = 1; d < 64; d <<= 1) { const float v = sup(ac, d, lane); if (lane >= d) ac += v; }
                vdt[64 * e + lane] = dtv; vacs[64 * e + lane] = ac; }
        }
        __syncthreads();
        { const int pr = tid >> 2, l0 = 16 * (tid & 3), e = pr >> 6; const float al = vacs[64 * e + 63];
            const v4u x0 = *(const LAS v4u*)(LXT + pr * P64 + l0), x1 = *(const LAS v4u*)(LXT + pr * P64 + l0 + 8); float xf[16]; { float t8[8]; unpack8(x0, t8);
#pragma unroll
                for (int i = 0; i < 8; ++i) xf[i] = t8[i]; unpack8(x1, t8);
#pragma unroll
                for (int i = 0; i < 8; ++i) xf[8 + i] = t8[i]; }
            unsigned o[8];
#pragma unroll
            for (int i = 0; i < 8; ++i) { const int l = l0 + 2 * i; const float s0 = vdt[64 * e + l] * __expf(al - vacs[64 * e + l]), s1 = vdt[64 * e + l + 1] * __expf(al - vacs[64 * e + l + 1]); o[i] = cvtpk(xf[2 * i] * s0, xf[2 * i + 1] * s1); }
            *(LAS v4u*)(LXW + pr * P64 + l0) = (v4u){o[0], o[1], o[2], o[3]}; *(LAS v4u*)(LXW + pr * P64 + l0 + 8) = (v4u){o[4], o[5], o[6], o[7]}; }
        f32x4 yacc[4];
#pragma unroll
        for (int pt = 0; pt < 4; ++pt) yacc[pt] = (f32x4){0.f, 0.f, 0.f, 0.f};
#pragma unroll
        for (int ks = 0; ks < 4; ++ks) { const bf16x8 cf = ldfrag(LC, P128, 16 * wq, 32 * ks, lane);
#pragma unroll
            for (int pt = 0; pt < 4; ++pt) yacc[pt] = MFMA16(ldfrag(LH + hh * 64 * P128, P128, 16 * pt, 32 * ks, lane), cf, yacc[pt]); }
        for (int job = wave; job < 10; job += 8) { int ti, tj; lower_pair(job, ti, tj);
            f32x4 acc = (f32x4){0.f, 0.f, 0.f, 0.f};
#pragma unroll
            for (int ks = 0; ks < 4; ++ks) acc = MFMA16(ldfrag(LB, P128, 16 * tj, 32 * ks, lane), ldfrag(LC, P128, 16 * ti, 32 * ks, lane), acc);
            const int l = 16 * ti + c16, s0 = 16 * tj + 4 * q4;
#pragma unroll
            for (int e = 0; e < 2; ++e) { const float al = vacs[64 * e + l], Dh = a.in[I_SD][h0 + e]; const f32x4 as = *(const LAS f32x4*)(vacs + 64 * e + s0), ds = *(const LAS f32x4*)(vdt + 64 * e + s0); f32x4 val;
#pragma unroll
                for (int r = 0; r < 4; ++r) val[r] = (s0 + r <= l) ? acc[r] * ds[r] * __expf(al - as[r]) + ((s0 + r == l) ? Dh : 0.f) : 0.f;
                *(LAS u32x2*)(LM + e * 64 * P64 + l * P64 + s0) = pack4(val); } }
        if (wave >= 2 && wave < 6) { const int e = (wave - 2) >> 1, up = (wave - 2) & 1; const int l = (up ? 32 : 0) + c16, s0 = (up ? 48 : 16) + 4 * q4;
            *(LAS u32x2*)(LM + e * 64 * P64 + l * P64 + s0) = (u32x2){0u, 0u}; }
        __syncthreads();
        {
            const float ea = __expf(vacs[64 * hh + 16 * wq + c16]);
#pragma unroll
            for (int pt = 0; pt < 4; ++pt) yacc[pt] = yacc[pt] * ea;
            for (int ks = 0; ks < (wq >= 2 ? 2 : 1); ++ks) { const bf16x8 mf = ldfrag(LM + hh * 64 * P64, P64, 16 * wq, 32 * ks, lane);
#pragma unroll
                for (int pt = 0; pt < 4; ++pt) yacc[pt] = MFMA16(ldfrag(LXT + hh * 64 * P64, P64, 16 * pt, 32 * ks, lane), mf, yacc[pt]); }
            const float el = __expf(vacs[64 * hh + 63]);
#pragma unroll
            for (int nt = 0; nt < 8; ++nt) hacc[nt] = hacc[nt] * el;
#pragma unroll
            for (int ks = 0; ks < 2; ++ks) { const bf16x8 xf = ldfrag(LXW + hh * 64 * P64, P64, 16 * wq, 32 * ks, lane);
#pragma unroll
                for (int nt = 0; nt < 8; ++nt) hacc[nt] = MFMA16(ldfrag(LBT, P64, 16 * nt, 32 * ks, lane), xf, hacc[nt]); }
#pragma unroll
            for (int nt = 0; nt < 8; ++nt) *(LAS u32x2*)(LH + hh * 64 * P128 + (16 * wq + c16) * P128 + 16 * nt + 4 * q4) = pack4(hacc[nt]);
            const size_t row = (size_t)(row0 + t0 + 16 * wq + c16); float sq = 0.f;
#pragma unroll
            for (int pt = 0; pt < 4; ++pt) { const int p0 = (h0 + hh) * 64 + 16 * pt + 4 * q4; const unsigned long long zz = *(const unsigned long long*)(proj + row * PITCH + PC_Z + p0);
                const f32x4 y = yacc[pt] * (f32x4){silu_f(bf2f((unsigned)zz & 0xffffu)), silu_f(bf2f(((unsigned)zz) >> 16)), silu_f(bf2f((unsigned)(zz >> 32) & 0xffffu)), silu_f(bf2f((unsigned)(zz >> 48)))};
                *(u32x2*)(mixed + row * DMIX + p0) = pack4(y); sq += (y[0] * y[0] + y[1] * y[1]) + (y[2] * y[2] + y[3] * y[3]); }
            sq += sx<16>(sq); sq += sx32(sq, lane);
            if (q4 == 0) ssqo[row * 16 + h0 + hh] = sq;
        }
        __syncthreads();
    }
    { const int c16 = lane_ & 15, q4 = lane_ >> 4; float* so = a.out + OFF_SSD_P + ((size_t)b * SSD_H + h0 + hh) * (SSD_P * SSD_N) + (size_t)(16 * wq + c16) * SSD_N + 4 * q4;
#pragma unroll
        for (int nt = 0; nt < 8; ++nt) *(f32x4*)(so + 16 * nt) = hacc[nt]; }
    (void)A_h;
    __syncthreads();
}
constexpr int SS_XS = 0, SS_XW = 49152, SS_ZS = 81920, SS_CBF = 98304, SS_DT = 107008, SS_CUM = 107520, SS_CBM = 108032, SS_MM = 108544;
__device__ __forceinline__ void ssd_sample_item(const Args& a, LAS unsigned char* lds, int sb, int tid, int wave, int lane) {
    const bf16* proj = ws_bf(a, WS_PROJ); bf16* mixed = mixed_buf(a); float* ssqo = ws_f(a, WS_SSQ);
    const int row0 = MP + sb * LS;
    LAS float* xs = (LAS float*)(lds + SS_XS);
    LAS float* xw = (LAS float*)(lds + SS_XW);
    LAS bf16* zs = (LAS bf16*)(lds + SS_ZS);
    LAS bf16* cbf = (LAS bf16*)(lds + SS_CBF);
    LAS float* dtv = (LAS float*)(lds + SS_DT); LAS float* cum = (LAS float*)(lds + SS_CUM); LAS float* cbm = (LAS float*)(lds + SS_CBM); LAS float* mm = (LAS float*)(lds + SS_MM);
    if (tid < 384) { const int ch = 4 * tid;
        f32x4 r[11];
#pragma unroll
        for (int j = 0; j < 3; ++j) r[j] = *(const f32x4*)(a.in[I_SSDC] + ((size_t)sb * 3 + j) * SSD_CONV + ch);
#pragma unroll
        for (int t = 0; t < 8; ++t) { const u32x2 v = *(const u32x2*)(proj + (size_t)(row0 + t) * PITCH + PC_XBC + ch); r[3 + t] = (f32x4){bf2f(v.x & 0xffffu), __uint_as_float(v.x & 0xffff0000u), bf2f(v.y & 0xffffu), __uint_as_float(v.y & 0xffff0000u)}; }
        f32x4 w[4];
#pragma unroll
        for (int j = 0; j < 4; ++j) w[j] = *(const f32x4*)(a.in[I_SCW] + j * SSD_CONV + ch);
        const f32x4 bias = *(const f32x4*)(a.in[I_SCB] + ch);
#pragma unroll
        for (int t = 0; t < 8; ++t) { f32x4 acc = bias + w[0] * r[t] + w[1] * r[t + 1] + w[2] * r[t + 2] + w[3] * r[t + 3];
            acc = (f32x4){silu_f(acc.x), silu_f(acc.y), silu_f(acc.z), silu_f(acc.w)};
            *(LAS f32x4*)(xs + t * SSD_CONV + ch) = acc;
            if (ch >= 1280) { const int g = (ch - 1280) >> 7, n = (ch - 1280) & 127; *(LAS u32x2*)(cbf + (g * 16 + t) * P128 + n) = pack4(acc); *(LAS u32x2*)(cbf + (g * 16 + 8 + t) * P128 + n) = (u32x2){0u, 0u}; } }
    } else { const int i = tid - 384, t = i >> 4, h = i & 15;
        dtv[i] = softplus_acc(bf2f(proj[(size_t)(row0 + t) * PITCH + PC_DT + h]) + a.in[I_SDTB][h]); }
    for (int i = tid; i < 8 * 128; i += NT) { const int t = i >> 7, c = i & 127; *(LAS v4u*)(zs + t * 1024 + 8 * c) = *(const v4u*)(proj + (size_t)(row0 + t) * PITCH + PC_Z + 8 * c); }
    __syncthreads();
    if (tid < 16) { const float A = -expf(a.in[I_SALOG][tid]); float c = 0.f;
#pragma unroll
        for (int t = 0; t < 8; ++t) { c += dtv[t * 16 + tid] * A; cum[tid * 8 + t] = c; } }
    if (tid >= 64 && tid < 192) { const int i = tid - 64, g = i >> 6, t = (i >> 3) & 7, s = i & 7; float acc = 0.f;
        const LAS float* cp = xs + t * SSD_CONV + 1280 + g * 128; const LAS float* bp = xs + s * SSD_CONV + 1024 + g * 128;
        for (int n = 0; n < 128; n += 4) { const f32x4 c4 = *(const LAS f32x4*)(cp + n), b4 = *(const LAS f32x4*)(bp + n); acc += (c4.x * b4.x + c4.y * b4.y) + (c4.z * b4.z + c4.w * b4.w); }
        cbm[i] = acc; }
    __syncthreads();
    for (int i = tid; i < 16 * 64; i += NT) { const int h = i >> 6, t = (i >> 3) & 7, s = i & 7;
        mm[i] = (s <= t) ? cbm[(h >> 3) * 64 + t * 8 + s] * dtv[s * 16 + h] * __expf(cum[h * 8 + t] - cum[h * 8 + s]) + (s == t ? a.in[I_SD][h] : 0.f) : 0.f; }
    for (int i = tid; i < 16 * 64 * 8; i += NT) { const int h = i >> 9, p = (i >> 3) & 63, s = i & 7; xw[i] = xs[s * SSD_CONV + h * 64 + p] * dtv[s * 16 + h] * __expf(cum[h * 8 + 7] - cum[h * 8 + s]); }
    __syncthreads();
#pragma unroll 1
    for (int e = 0; e < 2; ++e) { const int h = 2 * wave + e, g = h >> 3;
        int lane_l = lane; asm volatile("" : "+v"(lane_l)); const int c16 = lane_l & 15, q4 = lane_l >> 4;
        const float* sin = a.in[I_SSD] + ((size_t)sb * SSD_H + h) * (SSD_P * SSD_N); float* sout = a.out + OFF_SSD_S + ((size_t)sb * SSD_H + h) * (SSD_P * SSD_N);
        const float D8 = __expf(cum[h * 8 + 7]);
        f32x4 G[4];
#pragma unroll
        for (int pt = 0; pt < 4; ++pt) G[pt] = (f32x4){0.f, 0.f, 0.f, 0.f};
#pragma unroll 1
        for (int ks = 0; ks < 4; ++ks) { const int n0 = 32 * ks + 8 * q4;
            const bf16x8 cf = ldfrag(cbf + g * 16 * P128, P128, 0, 32 * ks, lane_l);
            f32x4 h0[4][2];
#pragma unroll
            for (int pt = 0; pt < 4; ++pt) { const f32x4* sp = (const f32x4*)(sin + (16 * pt + c16) * SSD_N + n0); h0[pt][0] = sp[0]; h0[pt][1] = sp[1]; }
            f32x4 Bv[8][2];
#pragma unroll
            for (int s = 0; s < 8; ++s) { const LAS f32x4* bp = (const LAS f32x4*)(xs + s * SSD_CONV + 1024 + g * 128 + n0); Bv[s][0] = bp[0]; Bv[s][1] = bp[1]; }
#pragma unroll
            for (int pt = 0; pt < 4; ++pt) { const f32x4 a0 = h0[pt][0], a1 = h0[pt][1];
                const u32x2 lo = pack4(a0), hi = pack4(a1); const v4u yv = (v4u){lo.x, lo.y, hi.x, hi.y};
                G[pt] = MFMA16(cf, __builtin_bit_cast(bf16x8, yv), G[pt]);
                const LAS f32x4* wp = (const LAS f32x4*)(xw + (h * 64 + 16 * pt + c16) * 8); const f32x4 w0 = wp[0], w1 = wp[1];
                f32x4 n0v = a0 * D8, n1v = a1 * D8;
#pragma unroll
                for (int s = 0; s < 8; ++s) { const float ws = s < 4 ? w0[s] : w1[s - 4]; n0v += Bv[s][0] * ws; n1v += Bv[s][1] * ws; }
                f32x4* op = (f32x4*)(sout + (16 * pt + c16) * SSD_N + n0); op[0] = n0v; op[1] = n1v; } }
        if (q4 < 2) {
            float sq[4] = {0.f, 0.f, 0.f, 0.f};
#pragma unroll
            for (int pt = 0; pt < 4; ++pt) { const int p = 16 * pt + c16; float xv[8];
#pragma unroll
                for (int s = 0; s < 8; ++s) xv[s] = xs[s * SSD_CONV + h * 64 + p];
#pragma unroll
                for (int r = 0; r < 4; ++r) { const int t = 4 * q4 + r; float y = __expf(cum[h * 8 + t]) * G[pt][r]; const LAS f32x4* mp = (const LAS f32x4*)(mm + (h * 8 + t) * 8); const f32x4 m0 = mp[0], m1 = mp[1];
                    y += (m0.x * xv[0] + m0.y * xv[1]) + (m0.z * xv[2] + m0.w * xv[3]) + (m1.x * xv[4] + m1.y * xv[5]) + (m1.z * xv[6] + m1.w * xv[7]);
                    y *= silu_f(bf2f(zs[t * 1024 + h * 64 + p])); sq[r] += y * y;
                    mixed[(size_t)(row0 + t) * DMIX + h * 64 + p] = (bf16)(cvtpk(y, 0.f) & 0xffffu); } }
#pragma unroll
            for (int r = 0; r < 4; ++r) { float v = sq[r]; v += sx<1>(v); v += sx<2>(v); v += sx<4>(v); v += sx<8>(v); if (c16 == 0) ssqo[(size_t)(row0 + 4 * q4 + r) * 16 + h] = v; }
        }
    }
    __syncthreads();
}
constexpr int GS_HEAD = 16384, GS_SMALL = 8 * GS_HEAD, GS_SMALL_PER = 1024;
static_assert(GS_SMALL + 8 * GS_SMALL_PER <= LDSCTL_OFF, "GDN sample LDS map");
__device__ __forceinline__ void gdn_sample_item(const Args& a, LAS unsigned char* lds, int sb, int tid, int wave, int lane) {
    const bf16* proj = ws_bf(a, WS_PROJ); bf16* mixed = mixed_buf(a);
    const int row0 = MP + sb * LS;
    for (int u = tid; u < 768; u += NT) { const int ch = 4 * u, which = ch >> 10, hd = (ch & 1023) >> 7, d = ch & 127;
        f32x4 r[11];
#pragma unroll
        for (int j = 0; j < 3; ++j) r[j] = *(const f32x4*)(a.in[I_GDNC] + ((size_t)sb * 3 + j) * GDN_CONV + ch);
#pragma unroll
        for (int t = 0; t < 8; ++t) { const u32x2 v = *(const u32x2*)(proj + (size_t)(row0 + t) * PITCH + PC_QKV + ch); r[3 + t] = (f32x4){bf2f(v.x & 0xffffu), __uint_as_float(v.x & 0xffff0000u), bf2f(v.y & 0xffffu), __uint_as_float(v.y & 0xffff0000u)}; }
        f32x4 w[4];
#pragma unroll
        for (int j = 0; j < 4; ++j) w[j] = *(const f32x4*)(a.in[I_GCW] + j * GDN_CONV + ch);
        LAS float* dst = (LAS float*)(lds + hd * GS_HEAD) + (which == 0 ? 1024 : (which == 1 ? 0 : 2048)) + d;
#pragma unroll
        for (int t = 0; t < 8; ++t) { f32x4 acc = w[0] * r[t] + w[1] * r[t + 1] + w[2] * r[t + 2] + w[3] * r[t + 3];
            *(LAS f32x4*)(dst + t * 128) = (f32x4){silu_f(acc.x), silu_f(acc.y), silu_f(acc.z), silu_f(acc.w)}; } }
    __syncthreads();
    const int h = wave;
    LAS float* Lk = (LAS float*)(lds + h * GS_HEAD); LAS float* Lq = Lk + 1024; LAS float* Lv = Lk + 2048; LAS float* LW = Lk + 3072;
    LAS float* sm = (LAS float*)(lds + GS_SMALL + h * GS_SMALL_PER);
#pragma unroll 1
    for (int t = 0; t < 8; ++t) { const float k0 = Lk[t * 128 + lane], k1 = Lk[t * 128 + 64 + lane], q0 = Lq[t * 128 + lane], q1 = Lq[t * 128 + 64 + lane];
        const float rk = 1.f / sqrtf(wave_sum(k0 * k0 + k1 * k1, lane) + 1e-6f), rq = (1.f / sqrtf(wave_sum(q0 * q0 + q1 * q1, lane) + 1e-6f)) * 0.08838834764831845f;
        Lk[t * 128 + lane] = k0 * rk; Lk[t * 128 + 64 + lane] = k1 * rk; Lq[t * 128 + lane] = q0 * rq; Lq[t * 128 + 64 + lane] = q1 * rq; }
    if (lane < 8) { const size_t r = (size_t)(row0 + lane) * PITCH; const float g = -expf(a.in[I_GALOG][h]) * softplus_acc(bf2f(proj[r + PC_ALPHA + h]) + a.in[I_GDTB][h]);
        float gc = g;
#pragma unroll
        for (int d = 1; d < 8; d <<= 1) { const float v = sup(gc, d, lane); if (lane >= d) gc += v; }
        sm[128 + lane] = gc; sm[136 + lane] = 1.f / (1.f + __expf(-bf2f(proj[r + PC_BETA + h]))); }
    { const int t = lane >> 3, s = lane & 7; float kk = 0.f, qk = 0.f;
#pragma unroll 4
        for (int d = 0; d < 128; d += 4) { const f32x4 ks4 = *(const LAS f32x4*)(Lk + s * 128 + d), kt4 = *(const LAS f32x4*)(Lk + t * 128 + d), qt4 = *(const LAS f32x4*)(Lq + t * 128 + d);
            kk += (kt4.x * ks4.x + kt4.y * ks4.y) + (kt4.z * ks4.z + kt4.w * ks4.w); qk += (qt4.x * ks4.x + qt4.y * ks4.y) + (qt4.z * ks4.z + qt4.w * ks4.w); }
        const float dec = __expf(sm[128 + t] - sm[128 + s]);
        sm[lane] = (s < t) ? sm[136 + t] * kk * dec : 0.f; sm[64 + lane] = (s <= t) ? qk * dec : 0.f; }
    if (lane < 8) { sm[144 + lane] = __expf(sm[128 + 7] - sm[128 + lane]);
        float tc[8];
#pragma unroll
        for (int l = 0; l < 8; ++l) { float acc = (l == lane) ? 1.f : 0.f;
#pragma unroll
            for (int s = 0; s < l; ++s) acc -= sm[l * 8 + s] * tc[s];
            tc[l] = acc; }
        const float be = sm[136 + lane], eg = __expf(sm[128 + lane]);
#pragma unroll
        for (int l = 0; l < 8; ++l) { sm[l * 8 + lane] = tc[l] * be; sm[152 + l * 8 + lane] = tc[l] * be * eg; } }
#pragma unroll 1
    for (int hf = 0; hf < 2; ++hf) { const int d = lane + 64 * hf; float kv[8], vv[8];
#pragma unroll
        for (int s = 0; s < 8; ++s) { kv[s] = Lk[s * 128 + d]; vv[s] = Lv[s * 128 + d]; }
#pragma unroll
        for (int t = 0; t < 8; ++t) { float w = 0.f, u = 0.f;
#pragma unroll
            for (int s = 0; s <= t; ++s) { w += sm[152 + t * 8 + s] * kv[s]; u += sm[t * 8 + s] * vv[s]; }
            LW[t * 128 + d] = w; Lv[t * 128 + d] = u; Lq[t * 128 + d] *= __expf(sm[128 + t]); } }
    const int dvq = lane & 31, rg = lane >> 5;
    const float* sin = a.in[I_GDN] + ((size_t)sb * GDN_H + h) * (GDN_D * GDN_D) + 4 * dvq; float* sout = a.out + OFF_GDN_S + ((size_t)sb * GDN_H + h) * (GDN_D * GDN_D) + 4 * dvq;
    f32x4 ws[8], qs[8];
#pragma unroll
    for (int t = 0; t < 8; ++t) { ws[t] = (f32x4){0.f, 0.f, 0.f, 0.f}; qs[t] = (f32x4){0.f, 0.f, 0.f, 0.f}; }
#pragma unroll 4
    for (int i = 0; i < 64; ++i) { const int dk = 2 * i + rg; const f32x4 s4 = *(const f32x4*)(sin + (size_t)dk * GDN_D);
#pragma unroll
        for (int t = 0; t < 8; ++t) { ws[t] += s4 * LW[t * 128 + dk]; qs[t] += s4 * Lq[t * 128 + dk]; } }
#pragma unroll
    for (int t = 0; t < 8; ++t)
#pragma unroll
        for (int j = 0; j < 4; ++j) { ws[t][j] += sx32(ws[t][j], lane); qs[t][j] += sx32(qs[t][j], lane); }
    f32x4 vn[8];
#pragma unroll
    for (int t = 0; t < 8; ++t) vn[t] = *(const LAS f32x4*)(Lv + t * 128 + 4 * dvq) - ws[t];
#pragma unroll
    for (int t = 0; t < 8; ++t) { f32x4 o = qs[t];
#pragma unroll
        for (int s = 0; s <= t; ++s) o += vn[s] * sm[64 + t * 8 + s];
        float sq = (o.x * o.x + o.y * o.y) + (o.z * o.z + o.w * o.w);
        sq += sx<1>(sq); sq += sx<2>(sq); sq += sx<4>(sq); sq += sx<8>(sq); sq += sx<16>(sq);
        const float rs = 1.f / sqrtf(sq * (1.f / GDN_D) + EPS); const f32x4 w = *(const f32x4*)(a.in[I_GNW] + 4 * dvq);
        const u32x2 gg = *(const u32x2*)(proj + (size_t)(row0 + t) * PITCH + PC_GATE + h * 128 + 4 * dvq);
        const f32x4 gate = (f32x4){silu_f(bf2f(gg.x & 0xffffu)), silu_f(__uint_as_float(gg.x & 0xffff0000u)), silu_f(bf2f(gg.y & 0xffffu)), silu_f(__uint_as_float(gg.y & 0xffff0000u))};
        if (rg == 0) *(u32x2*)(mixed + (size_t)(row0 + t) * DMIX + DM + h * 128 + 4 * dvq) = pack4(o * rs * w * gate); }
#pragma unroll
    for (int t = 0; t < 8; ++t) vn[t] = vn[t] * sm[144 + t];
    const float ge = __expf(sm[128 + 7]);
#pragma unroll 4
    for (int i = 0; i < 64; ++i) { const int dk = 2 * i + rg; f32x4 s4 = *(const f32x4*)(sin + (size_t)dk * GDN_D) * ge;
#pragma unroll
        for (int t = 0; t < 8; ++t) s4 += vn[t] * Lk[t * 128 + dk];
        *(f32x4*)(sout + (size_t)dk * GDN_D) = s4; }
    __syncthreads();
}
__device__ __forceinline__ void convstate_item(const Args& a, int s, int tid) {
    const bool prompt = s < NB_P; const int L = prompt ? SEQ : LS; const int row0 = prompt ? s * SEQ : MP + (s - NB_P) * LS; const bf16* proj = ws_bf(a, WS_PROJ);
    float* o1 = a.out + (prompt ? OFF_SSDC_P + (size_t)s * 3 * SSD_CONV : OFF_SSDC_S + (size_t)(s - NB_P) * 3 * SSD_CONV);
    float* o2 = a.out + (prompt ? OFF_GDNC_P + (size_t)s * 3 * GDN_CONV : OFF_GDNC_S + (size_t)(s - NB_P) * 3 * GDN_CONV);
    for (int idx = tid; idx < 3 * SSD_CONV; idx += NT) { const int j = idx / SSD_CONV, c = idx - j * SSD_CONV; o1[idx] = bf2f(proj[(size_t)(row0 + L - 3 + j) * PITCH + PC_XBC + c]); }
    for (int idx = tid; idx < 3 * GDN_CONV; idx += NT) { const int j = idx / GDN_CONV, c = idx - j * GDN_CONV; o2[idx] = bf2f(proj[(size_t)(row0 + L - 3 + j) * PITCH + PC_QKV + c]); }
}
constexpr int Q_GP = NB_P * GDN_H, Q_SP = Q_GP + NB_P * SSD_H / 2, Q_GS = Q_SP + NB_S, Q_SS = Q_GS + NB_S, Q_ALL = Q_SS + NSEQ;
__device__ __forceinline__ void p3_mixers(const Args& a, LAS unsigned char* lds, volatile LAS unsigned* misc, int rep, int tid_, int wave, int lane_) {
    unsigned* qctr = (unsigned*)(a.ws + WS_CTL) + CW_QUEUE + 64 * rep;
    for (;;) {
        if (tid_ == 0) misc[0] = __hip_atomic_fetch_add(qctr, 1u, __ATOMIC_RELAXED, __HIP_MEMORY_SCOPE_AGENT);
        __syncthreads();
        const int it = (int)misc[0];
        __syncthreads();
        if (it >= Q_ALL) break;
        int tid = tid_, lane = lane_;
        asm volatile("" : "+v"(tid), "+v"(lane));
        if (it < Q_GP) gdn_chunk_item(a, lds, it >> 3, it & 7, tid, wave, lane);
        else if (it < Q_SP) { const int j = it - Q_GP; ssd_chunk_item(a, lds, j >> 3, (j >> 2) & 1, j & 3, tid, wave, lane); }
        else if (it < Q_GS) gdn_sample_item(a, lds, it - Q_SP, tid, wave, lane);
        else if (it < Q_SS) ssd_sample_item(a, lds, it - Q_GS, tid, wave, lane);
        else convstate_item(a, it - Q_SS, tid);
    }
}
__device__ __forceinline__ void p3b_ssdnorm(const Args& a, int gw, int NGW, int lane) {
    bf16* mixed = mixed_buf(a); const float* ssq = ws_f(a, WS_SSQ); const float* nw = a.in[I_SNW] + 16 * lane;
    for (int row = gw; row < M; row += NGW) {
        const f32x4* sp = (const f32x4*)(ssq + (size_t)row * 16 + 8 * (lane >> 5)); const f32x4 s0 = sp[0], s1 = sp[1];
        const float rs = 1.f / sqrtf(((s0.x + s0.y) + (s0.z + s0.w) + (s1.x + s1.y) + (s1.z + s1.w)) * (1.f / 512.f) + EPS);
        v4u* mp = (v4u*)(mixed + (size_t)row * DMIX + 16 * lane);
#pragma unroll
        for (int q = 0; q < 2; ++q) { v4u v = mp[q]; const f32x4 w0 = *(const f32x4*)(nw + 8 * q), w1 = *(const f32x4*)(nw + 8 * q + 4);
            v.x = pk2(bf2f(v.x & 0xffffu) * rs * w0.x, bf2f(v.x >> 16) * rs * w0.y); v.y = pk2(bf2f(v.y & 0xffffu) * rs * w0.z, bf2f(v.y >> 16) * rs * w0.w);
            v.z = pk2(bf2f(v.z & 0xffffu) * rs * w1.x, bf2f(v.z >> 16) * rs * w1.y); v.w = pk2(bf2f(v.w & 0xffffu) * rs * w1.z, bf2f(v.w >> 16) * rs * w1.w);
            mp[q] = v; }
    }
}
__device__ __forceinline__ void p5_mid(const Args& a, int gw, int NGW, int lane) {
    const float* mod = ws_f(a, WS_MOD); const float* T1 = ws_f(a, WS_T1); bf16* XN2 = ws_bf(a, WS_XN2); const float* wpost = a.in[I_NMPOST]; const float* wpre = a.in[I_NFPRE];
    for (int row = gw; row < M; row += NGW) {
        const f32x4* tr = (const f32x4*)(T1 + (size_t)row * DM) + lane; const f32x4* xr = (const f32x4*)x_row(a, row) + lane; const float* mr = mod + (size_t)seq_of_row(row) * NMOD;
        f32x4 v[4]; float s = 0.f;
#pragma unroll
        for (int j = 0; j < 4; ++j) { v[j] = tr[64 * j]; s += (v[j].x * v[j].x + v[j].y * v[j].y) + (v[j].z * v[j].z + v[j].w * v[j].w); }
        const float rs = 1.f / sqrtf(wave_sum(s, lane) * (1.f / DM) + EPS);
        float s2 = 0.f; f32x4* yo = (f32x4*)(a.out + OFF_Y + (size_t)row * DM) + lane;
#pragma unroll
        for (int j = 0; j < 4; ++j) { const int c = 4 * lane + 256 * j; const f32x4 w = *(const f32x4*)(wpost + c), g1 = *(const f32x4*)(mr + 2 * DM + c);
            v[j] = xr[64 * j] + g1 * (v[j] * rs * w); yo[64 * j] = v[j]; s2 += (v[j].x * v[j].x + v[j].y * v[j].y) + (v[j].z * v[j].z + v[j].w * v[j].w); }
        const float rs2 = 1.f / sqrtf(wave_sum(s2, lane) * (1.f / DM) + EPS);
        unsigned long long* o8 = (unsigned long long*)(XN2 + (size_t)row * DM) + lane;
#pragma unroll
        for (int j = 0; j < 4; ++j) { const int c = 4 * lane + 256 * j; const f32x4 w = *(const f32x4*)(wpre + c), sh = *(const f32x4*)(mr + 3 * DM + c), sc = *(const f32x4*)(mr + 4 * DM + c);
            const f32x4 h = v[j] * rs2 * w * (sc + 1.f) + sh;
            o8[64 * j] = (unsigned long long)pk2(h.x, h.y) | ((unsigned long long)pk2(h.z, h.w) << 32); }
    }
}
__device__ __forceinline__ void p8_final(const Args& a, int gw, int NGW, int lane) {
    const float* mod = ws_f(a, WS_MOD); const float* T2 = ws_f(a, WS_T2); const float* wpost = a.in[I_NFPOST];
    for (int row = gw; row < M; row += NGW) {
        const f32x4* tr = (const f32x4*)(T2 + (size_t)row * DM) + lane; const float* mr = mod + (size_t)seq_of_row(row) * NMOD;
        f32x4 v[4]; float s = 0.f;
#pragma unroll
        for (int j = 0; j < 4; ++j) { v[j] = tr[64 * j]; s += (v[j].x * v[j].x + v[j].y * v[j].y) + (v[j].z * v[j].z + v[j].w * v[j].w); }
        const float rs = 1.f / sqrtf(wave_sum(s, lane) * (1.f / DM) + EPS);
        f32x4* yo = (f32x4*)(a.out + OFF_Y + (size_t)row * DM) + lane;
#pragma unroll
        for (int j = 0; j < 4; ++j) { const int c = 4 * lane + 256 * j; const f32x4 w = *(const f32x4*)(wpost + c), g2 = *(const f32x4*)(mr + 5 * DM + c);
            yo[64 * j] = yo[64 * j] + g2 * (v[j] * rs * w); }
    }
}
#ifndef MK_N_LAUNCHES
#define MK_N_LAUNCHES 1
#endif
constexpr int NPH = 10;
constexpr int N_LAUNCHES = MK_N_LAUNCHES;
static_assert(N_LAUNCHES == 1 || N_LAUNCHES == NPH, "MK_N_LAUNCHES is 1 or 10");
#ifndef PG8_SP2
#define PG8_SP2 true
#endif
#ifndef PG8_ALIGN
#define PG8_ALIGN true
#endif
__global__ void __launch_bounds__(NT, 2) hymba_fwd(Args args) {
    extern __shared__ __attribute__((aligned(16))) unsigned char lds_[];
    LAS unsigned char* lds = (LAS unsigned char*)lds_;
    volatile LAS unsigned* MISC = (volatile LAS unsigned*)(lds + MISC_OFF);
    const int tid0 = threadIdx.x, wave = __builtin_amdgcn_readfirstlane(tid0 >> 6);
#define PHASE_IDS int lane = (int)__builtin_amdgcn_mbcnt_hi(~0u, __builtin_amdgcn_mbcnt_lo(~0u, 0u)); asm volatile("" : "+v"(lane)); const int tid = wave * 64 + lane;
    const int G = gridDim.x, bid = blockIdx.x;
    const int gw = bid * NWAVES + wave, NGW = G * NWAVES;
    gu32* ctl = (gu32*)(args.ws + WS_CTL);
    for (int u = tid0; u < (LDS_BYTES - LDSCTL_OFF) / 4; u += NT) ((LAS unsigned*)(lds + LDSCTL_OFF))[u] = 0u;
    __syncthreads();
    XcdBarrier bar; bar.bar = (unsigned*)(ctl + CW_BAR); bar.x = 0; bar.st = nullptr;
    if (N_LAUNCHES == 1) bar = xcd_barrier_post((unsigned*)(ctl + CW_BAR), MISC + 8);
#define GRID_BAR(seam) do { if (N_LAUNCHES != 1) { if (wave == 0 && __builtin_amdgcn_mbcnt_lo(~0u, 0u) == 0u) __hip_atomic_store(ctl + CW_TMO, 0xBADBA0u | (unsigned)(seam), RLX_AGENT); } else { xcd_barrier(bar); } } while (0)
    const int lo = args.ph_lo, hi = args.ph_hi;
#define IN(k) (lo <= (k) && (k) < hi)
#ifndef PROBE_PHASE
#define PROBE_PHASE -1
#endif
#define REPS(k) for (int rep = 0; rep < ((k) == PROBE_PHASE ? 2 : 1); ++rep)
#define REP_BAR(k) do { if ((k) == PROBE_PHASE && rep == 0) GRID_BAR(k); } while (0)
#define BOTH(k) (IN(k) && IN((k) + 1))
    if (IN(0)) { REPS(0) { PHASE_IDS p0_prologue(args, lds, bid, G, tid, wave, lane); REP_BAR(0); } if (BOTH(0)) GRID_BAR(0); }
    if (IN(1)) { REPS(1) { PHASE_IDS p1_xn(args, gw, NGW, lane); REP_BAR(1); } if (BOTH(1)) GRID_BAR(1); }
    if (IN(2)) { REPS(2) {
        pg8::Gemm g{xn_buf(args), win_t(args), M, IN_PAD, DM}; pg8::StaticOrder S; S.init(M, IN_PAD, G, bid);
        pg8::EpiBf16Clip E{ws_bf(args, WS_PROJ), PITCH, IN_DIM};
        pg8::gemm_phase<pg8::EpiBf16Clip, pg8::StaticOrder, PG8_ALIGN, PG8_SP2>(lds + RING_OFF, g, S, E); REP_BAR(2); }
        if (BOTH(2)) GRID_BAR(2);
    }
    if (IN(3)) { REPS(3) { PHASE_IDS p3_mixers(args, lds, MISC, rep, tid, wave, lane); REP_BAR(3); } if (BOTH(3)) GRID_BAR(3); }
    if (IN(4)) { PHASE_IDS p3b_ssdnorm(args, gw, NGW, lane); if (BOTH(4)) GRID_BAR(4); }
    if (IN(5)) { REPS(5) {
        pg8::Gemm g{mixed_buf(args), ws_bf(args, WS_WOUT), M, DM, DMIX}; pg8::StaticOrder S; S.init(M, DM, G, bid);
        pg8::EpiF32 E{ws_f(args, WS_T1), DM};
        pg8::gemm_phase<pg8::EpiF32, pg8::StaticOrder, PG8_ALIGN, PG8_SP2>(lds + RING_OFF, g, S, E); REP_BAR(5); }
        if (BOTH(5)) GRID_BAR(5);
    }
    if (IN(6)) { REPS(6) { PHASE_IDS p5_mid(args, gw, NGW, lane); REP_BAR(6); } if (BOTH(6)) GRID_BAR(6); }
    if (IN(7)) { REPS(7) {
        pg8::Gemm g{ws_bf(args, WS_XN2), ws_bf(args, WS_WGU), M, NGU, DM}; pg8::StaticOrder S; S.init(M, NGU, G, bid);
        pg8::EpiSwiGLU E{ws_bf(args, WS_ACT), DFF};
        pg8::gemm_phase<pg8::EpiSwiGLU, pg8::StaticOrder, PG8_ALIGN, PG8_SP2>(lds + RING_OFF, g, S, E); REP_BAR(7); }
        if (BOTH(7)) GRID_BAR(7);
    }
    if (IN(8)) { REPS(8) {
        pg8::Gemm g{ws_bf(args, WS_ACT), ws_bf(args, WS_WDN), M, DM, DFF}; pg8::StaticOrder S; S.init(M, DM, G, bid);
        pg8::EpiF32 E{ws_f(args, WS_T2), DM};
        pg8::gemm_phase<pg8::EpiF32, pg8::StaticOrder, PG8_ALIGN, PG8_SP2>(lds + RING_OFF, g, S, E); REP_BAR(8); }
        if (BOTH(8)) GRID_BAR(8);
    }
    if (IN(9)) { PHASE_IDS p8_final(args, gw, NGW, lane); }
#undef IN
#undef BOTH
}
extern "C" void kernel_launch(void* const* d_in, const int* in_sizes, int n_in, void* d_out, int out_size, void* d_ws, size_t ws_size, hipStream_t stream) {
    static int grid = 0;
    if (grid == 0) {
        if (n_in != 28 || in_sizes[0] != MP * DM || (size_t)out_size != OUT_TOTAL || ws_size < WS_END) {
            fprintf(stderr, "kernel_launch: shape/workspace mismatch: n_in %d in0 %d out %d ws %zu (need %zu); nothing launched\n", n_in, n_in > 0 ? in_sizes[0] : -1, out_size, ws_size, (size_t)WS_END); grid = -1; return; }
        int dev = 0, cus = 0, per_cu = 0;
        if (hipGetDevice(&dev) != hipSuccess || hipDeviceGetAttribute(&cus, hipDeviceAttributeMultiprocessorCount, dev) != hipSuccess) { fprintf(stderr, "kernel_launch: device query failed\n"); grid = -1; return; }
        if (hipFuncSetAttribute((const void*)hymba_fwd, hipFuncAttributeMaxDynamicSharedMemorySize, LDS_BYTES) != hipSuccess) { fprintf(stderr, "kernel_launch: hipFuncSetAttribute failed\n"); grid = -1; return; }
        if (hipOccupancyMaxActiveBlocksPerMultiprocessor(&per_cu, (const void*)hymba_fwd, NT, LDS_BYTES) != hipSuccess || per_cu < 1)
            fprintf(stderr, "kernel_launch: note: occupancy query reports %d workgroups per CU\n", per_cu);
        (void)hipGetLastError();
        grid = cus;
    }
    if (grid < 0) return;
    if (hipMemsetAsync((char*)d_ws + WS_CTL, 0, CTL_ZERO_BYTES, stream) != hipSuccess) { fprintf(stderr, "kernel_launch: memset failed\n"); return; }
    Args a{};
    for (int i = 0; i < 28; ++i) a.in[i] = (const float*)d_in[i];
    a.out = (float*)d_out; a.ws = (unsigned char*)d_ws;
    for (int li = 0; li < N_LAUNCHES; ++li) {
        a.ph_lo = (N_LAUNCHES == 1) ? 0 : li; a.ph_hi = (N_LAUNCHES == 1) ? NPH : li + 1; a.li = li;
        hipLaunchKernelGGL(hymba_fwd, dim3(grid), dim3(NT), LDS_BYTES, stream, a);
        const hipError_t le = hipPeekAtLastError();
        if (le != hipSuccess) { fprintf(stderr, "kernel_launch: launch %d failed: %s\n", li, hipGetErrorName(le)); break; }
    }
}
```

```cpp
#include <hip/hip_runtime.h>
#include <cstdio>
#include <cstdint>
namespace pg8 {
#define PG8_LAS __attribute__((address_space(3)))
typedef unsigned short bf16_t;
typedef short bf16x8 __attribute__((ext_vector_type(8)));
typedef float f32x4 __attribute__((ext_vector_type(4)));
typedef unsigned u32x4 __attribute__((ext_vector_type(4)));
constexpr int BM = 256, BK = 64, HALF = 128, HTB = HALF * BK * 2  , STAGE_BYTES = 8 * HTB, NXCD = 8, WGM = 8;

__host__ __device__ __forceinline__ int lds_byte(int r, int c) { const int st = (r >> 4) * 2 + (c >> 5), rr = r & 15, cc = c & 31, ob = rr * 64 + cc * 2; return st * 1024 + (ob ^ (((ob >> 9) & 1) << 5)); }
__host__ __device__ __forceinline__ void stage_rc(int b, int& R, int& C) { const int st = b / 1024, sb = b % 1024, swz = sb ^ (((sb >> 9) & 1) << 5); R = (st >> 1) * 16 + swz / 64; C = (st & 1) * 32 + (swz % 64) / 2; }
__host__ __device__ __forceinline__ int perm32(int rho) { const int n = rho >> 4, i = rho & 15; return 8 * (i >> 2) + 4 * n + (i & 3); }

struct Unit { int pm, pn; };
struct Gemm { const bf16_t* A; const bf16_t* Bt; int M, N, K; };

struct StaticOrder {
    int nM, nN, nwg, G, c;
    __host__ __device__ void init(int M, int N, int G_, int c_) { nM = M / BM; nN = N / BM; nwg = nM * nN; G = G_; c = c_; }
    __host__ __device__ bool next(int i, Unit& u) const {
        const long L = (long)i * G + c; if (L >= nwg) return false;
        int wgid = (int)L; { const int q = nwg / NXCD, r = nwg % NXCD, xcd = wgid % NXCD, off = wgid / NXCD; wgid = (xcd < r ? xcd * (q + 1) : r * (q + 1) + (xcd - r) * q) + off; }
        const int nig = WGM * nN, gid = wgid / nig, fm = gid * WGM, gsz = (nM - fm) < WGM ? (nM - fm) : WGM;
        u.pm = fm + ((wgid % nig) % gsz); u.pn = (wgid % nig) / gsz; return true;
    }
    __device__ __forceinline__ void a_ready(const Unit&) const {}
    __device__ __forceinline__ void done(const Unit&) const {}
};

typedef float f32x2c __attribute__((ext_vector_type(2))); typedef __bf16 bf16x2c __attribute__((ext_vector_type(2)));
__device__ __forceinline__ unsigned cvt_pk_bf16(float lo, float hi) { f32x2c v = {lo, hi}; bf16x2c b = __builtin_convertvector(v, bf16x2c); return __builtin_bit_cast(unsigned, b); }
typedef float f32x2 __attribute__((ext_vector_type(2)));
__device__ __forceinline__ float silu_fast(float x) { return x * __builtin_amdgcn_rcpf(1.f + __expf(-x)); }
struct EpiBf16Clip {
    static constexpr bool PERM = true, AFTER_DRAIN = false;
    bf16_t* O; int ldc; int ncols;
    __device__ __forceinline__ void operator()(const f32x4 (&acc)[2][2][4][2], const Unit& u, int wr, int wc, int fr, int fq) const {
        const int row0 = u.pm * BM + wr * 64 + fr; const int col0 = u.pn * BM + wc * 32 + 8 * fq;
#pragma unroll
        for (int ai = 0; ai < 2; ++ai)
#pragma unroll
            for (int m = 0; m < 4; ++m) { bf16_t* rowp = O + (size_t)(row0 + ai * HALF + m * 16) * ldc + col0;
#pragma unroll
                for (int bj = 0; bj < 2; ++bj) { if (col0 + bj * HALF < ncols) { const f32x4 v0 = acc[ai][bj][m][0], v1 = acc[ai][bj][m][1];
                    u32x4 w; w.x = cvt_pk_bf16(v0[0], v0[1]); w.y = cvt_pk_bf16(v0[2], v0[3]); w.z = cvt_pk_bf16(v1[0], v1[1]); w.w = cvt_pk_bf16(v1[2], v1[3]);
                    *(u32x4*)(rowp + bj * HALF) = w; } } }
    }
};
struct EpiF32 {
    static constexpr bool PERM = false, AFTER_DRAIN = false;
    float* O; int ldc;
    __device__ __forceinline__ void operator()(const f32x4 (&acc)[2][2][4][2], const Unit& u, int wr, int wc, int fr, int fq) const {
        const int row0 = u.pm * BM + wr * 64 + fr; const int col0 = u.pn * BM + wc * 32 + 4 * fq;
#pragma unroll
        for (int ai = 0; ai < 2; ++ai)
#pragma unroll
            for (int m = 0; m < 4; ++m) { float* rowp = O + (size_t)(row0 + ai * HALF + m * 16) * ldc + col0;
#pragma unroll
                for (int bj = 0; bj < 2; ++bj)
#pragma unroll
                    for (int n = 0; n < 2; ++n) *(f32x4*)(rowp + bj * HALF + n * 16) = acc[ai][bj][m][n]; }
    }
};
struct EpiSwiGLU {
    static constexpr bool PERM = true, AFTER_DRAIN = false;
    bf16_t* O; int ldc;
    __device__ __forceinline__ void operator()(const f32x4 (&acc)[2][2][4][2], const Unit& u, int wr, int wc, int fr, int fq) const {
        const int row0 = u.pm * BM + wr * 64 + fr; const int col0 = u.pn * HALF + wc * 32 + 8 * fq;
#pragma unroll
        for (int ai = 0; ai < 2; ++ai)
#pragma unroll
            for (int m = 0; m < 4; ++m) { bf16_t* rowp = O + (size_t)(row0 + ai * HALF + m * 16) * ldc + col0;
                f32x4 v[2];
#pragma unroll
                for (int n = 0; n < 2; ++n) { const f32x4 g = acc[ai][0][m][n], up = acc[ai][1][m][n];
                    v[n] = (f32x4){silu_fast(g[0]) * up[0], silu_fast(g[1]) * up[1], silu_fast(g[2]) * up[2], silu_fast(g[3]) * up[3]}; }
                u32x4 w; w.x = cvt_pk_bf16(v[0][0], v[0][1]); w.y = cvt_pk_bf16(v[0][2], v[0][3]); w.z = cvt_pk_bf16(v[1][0], v[1][1]); w.w = cvt_pk_bf16(v[1][2], v[1][3]);
                *(u32x4*)rowp = w; }
    }
};
template <class Epi, class Sched, bool ALIGN_EPI = false, bool SP2 = false>
__device__ __forceinline__ void gemm_phase(PG8_LAS unsigned char* lds, const Gemm g, const Sched& S, const Epi& E) {
    const int tid = threadIdx.x, wid = __builtin_amdgcn_readfirstlane(tid >> 6), lane = tid & 63, wr = wid >> 2, wc = wid & 3, fr = lane & 15, fq = lane >> 4;
    const int K = g.K, nt = K / BK;
    unsigned voffA[2], voffB[2];
#pragma unroll
    for (int i = 0; i < 2; ++i) { int R, C; stage_rc(tid * 16 + i * 8192, R, C); const int Rb = Epi::PERM ? ((R & ~31) + perm32(R & 31)) : R;
        voffA[i] = (unsigned)(R * K + C) * 2u; voffB[i] = (unsigned)(Rb * K + C) * 2u; }
    const size_t kstep = (size_t)(BK * 2);
    const size_t hstep = (size_t)HALF * K * 2;
    const size_t tstep = 2 * hstep;
    const unsigned ldsw = (unsigned)wid * 1024u;
    const int aoff = lds_byte(wr * 64 + fr, fq * 8), boff = lds_byte(wc * 32 + fr, fq * 8);
#define PG8_SA(b, h) (((b) * 2 + (h)) * HTB)
#define PG8_SB(b, h) ((4 + (b) * 2 + (h)) * HTB)
#define PG8_STAGE(bufoff, gbase, voff) do { _Pragma("unroll") for (int _i = 0; _i < 2; ++_i) \
        __builtin_amdgcn_global_load_lds((const unsigned*)((const char*)(gbase) + (voff)[_i]), (PG8_LAS unsigned*)(lds + (bufoff) + ldsw + _i * 8192), 16, 0, 0); } while (0)
#define PG8_LDA(dst, b, h) do { _Pragma("unroll") for (int m = 0; m < 4; ++m) _Pragma("unroll") for (int k = 0; k < 2; ++k) dst[m][k] = *(const PG8_LAS bf16x8*)(lds + PG8_SA(b, h) + aoff + m * 2048 + k * 1024); } while (0)
#define PG8_LDB(dst, b, h) do { _Pragma("unroll") for (int n = 0; n < 2; ++n) _Pragma("unroll") for (int k = 0; k < 2; ++k) dst[n][k] = *(const PG8_LAS bf16x8*)(lds + PG8_SB(b, h) + boff + n * 2048 + k * 1024); } while (0)
#define PG8_MMA(ai, bj, At, Bt) do { __builtin_amdgcn_s_setprio(1); _Pragma("unroll") for (int m = 0; m < 4; ++m) _Pragma("unroll") for (int n = 0; n < 2; ++n) _Pragma("unroll") for (int k = 0; k < 2; ++k) \
        acc[ai][bj][m][n] = __builtin_amdgcn_mfma_f32_16x16x32_bf16(Bt[n][k], At[m][k], acc[ai][bj][m][n], 0, 0, 0); __builtin_amdgcn_s_setprio(0); } while (0)
#define PG8_WAIT_V(n) asm volatile("s_waitcnt vmcnt(" #n ")" ::: "memory")
#define PG8_WAIT_L(n) asm volatile("s_waitcnt lgkmcnt(" #n ")" ::: "memory")
#define PG8_BAR __builtin_amdgcn_s_barrier()
#define PG8_SCHED __builtin_amdgcn_sched_barrier(0)
    Unit cur, nxt; int ui = 0;
    if (!S.next(0, cur)) return;
    f32x4 acc[2][2][4][2];
#pragma unroll
    for (int a = 0; a < 2; ++a)
#pragma unroll
        for (int b = 0; b < 2; ++b)
#pragma unroll
            for (int m = 0; m < 4; ++m)
#pragma unroll
                for (int n = 0; n < 2; ++n) acc[a][b][m][n] = (f32x4){0.f, 0.f, 0.f, 0.f};
    bf16x8 At[4][2], B0[2][2], B1[2][2];
    const char* cA = (const char*)g.A + (size_t)cur.pm * tstep; const char* cB = (const char*)g.Bt + (size_t)cur.pn * tstep;
    S.a_ready(cur);
    if constexpr (SP2) {
        PG8_STAGE(PG8_SB(0, 0), cB, voffB); PG8_STAGE(PG8_SB(0, 1), cB + hstep, voffB); PG8_STAGE(PG8_SA(0, 0), cA, voffA); PG8_STAGE(PG8_SA(0, 1), cA + hstep, voffA);
        if (wr == 1) PG8_BAR;
        PG8_WAIT_V(2); PG8_BAR;
        PG8_STAGE(PG8_SB(1, 0), cB + kstep, voffB); PG8_STAGE(PG8_SA(1, 0), cA + kstep, voffA); PG8_STAGE(PG8_SB(1, 1), cB + hstep + kstep, voffB);
        PG8_WAIT_V(6); PG8_BAR;
    } else {
        PG8_STAGE(PG8_SB(0, 0), cB, voffB); PG8_STAGE(PG8_SA(0, 0), cA, voffA); PG8_STAGE(PG8_SB(0, 1), cB + hstep, voffB); PG8_STAGE(PG8_SA(0, 1), cA + hstep, voffA);
        if (wr == 1) PG8_BAR;
        PG8_WAIT_V(4); PG8_BAR;
        PG8_STAGE(PG8_SB(1, 0), cB + kstep, voffB); PG8_STAGE(PG8_SA(1, 0), cA + kstep, voffA); PG8_STAGE(PG8_SB(1, 1), cB + hstep + kstep, voffB);
        PG8_WAIT_V(6); PG8_BAR;
    }
    for (;;) {
        const bool has_next = S.next(ui + 1, nxt);
        const char* nA = has_next ? (const char*)g.A + (size_t)nxt.pm * tstep : cA; const char* nB = has_next ? (const char*)g.Bt + (size_t)nxt.pn * tstep : cB;
        for (int t = 0; t < nt; t += 2) {
            const bool last = (t == nt - 2);
            const char* a1 = cA + (size_t)(t + 1) * kstep;
            const char* a2 = last ? nA : cA + (size_t)(t + 2) * kstep; const char* b2 = last ? nB : cB + (size_t)(t + 2) * kstep;
            const char* a3 = a2 + kstep; const char* b3 = b2 + kstep;
            if (last && has_next) S.a_ready(nxt);
            if constexpr (SP2) {
            PG8_LDB(B0, 0, 0); PG8_LDB(B1, 0, 1); PG8_SCHED; PG8_LDA(At, 0, 0); PG8_STAGE(PG8_SA(1, 1), a1 + hstep, voffA);
            PG8_WAIT_V(8); PG8_WAIT_L(0); PG8_BAR; PG8_MMA(0, 0, At, B0); PG8_MMA(0, 1, At, B1); PG8_BAR; PG8_SCHED;
            PG8_LDA(At, 0, 1); PG8_STAGE(PG8_SB(0, 0), b2, voffB); PG8_STAGE(PG8_SB(0, 1), b2 + hstep, voffB); PG8_STAGE(PG8_SA(0, 0), a2, voffA);
            PG8_WAIT_V(8); PG8_WAIT_L(0); PG8_BAR; PG8_MMA(1, 0, At, B0); PG8_MMA(1, 1, At, B1); PG8_BAR; PG8_SCHED;
            PG8_LDB(B0, 1, 0); PG8_LDB(B1, 1, 1); PG8_SCHED; PG8_LDA(At, 1, 0); PG8_STAGE(PG8_SA(0, 1), a2 + hstep, voffA);
            PG8_WAIT_V(8); PG8_WAIT_L(0); PG8_BAR; PG8_MMA(0, 0, At, B0); PG8_MMA(0, 1, At, B1); PG8_BAR; PG8_SCHED;
            PG8_LDA(At, 1, 1); PG8_STAGE(PG8_SB(1, 0), b3, voffB); PG8_STAGE(PG8_SB(1, 1), b3 + hstep, voffB); PG8_STAGE(PG8_SA(1, 0), a3, voffA);
            PG8_WAIT_V(8); PG8_WAIT_L(0); PG8_BAR; PG8_MMA(1, 0, At, B0); PG8_MMA(1, 1, At, B1); PG8_BAR; PG8_SCHED;
            } else {
            PG8_LDB(B0, 0, 0); PG8_SCHED; PG8_LDA(At, 0, 0); PG8_STAGE(PG8_SA(1, 1), a1 + hstep, voffA);
            PG8_WAIT_L(8); PG8_BAR; PG8_WAIT_L(0); PG8_MMA(0, 0, At, B0); PG8_BAR; PG8_SCHED;
            PG8_LDB(B1, 0, 1); PG8_STAGE(PG8_SB(0, 0), b2, voffB);
            PG8_BAR; PG8_WAIT_L(0); PG8_MMA(0, 1, At, B1); PG8_BAR;
            PG8_LDA(At, 0, 1); PG8_STAGE(PG8_SA(0, 0), a2, voffA);
            PG8_BAR; PG8_WAIT_L(0); PG8_MMA(1, 0, At, B0); PG8_BAR; PG8_SCHED;
            PG8_STAGE(PG8_SB(0, 1), b2 + hstep, voffB);
            PG8_WAIT_V(6); PG8_BAR; PG8_MMA(1, 1, At, B1); PG8_BAR;
            PG8_LDB(B0, 1, 0); PG8_SCHED; PG8_LDA(At, 1, 0); PG8_STAGE(PG8_SA(0, 1), a2 + hstep, voffA);
            PG8_WAIT_L(8); PG8_BAR; PG8_WAIT_L(0); PG8_MMA(0, 0, At, B0); PG8_BAR; PG8_SCHED;
            PG8_LDB(B1, 1, 1); PG8_STAGE(PG8_SB(1, 0), b3, voffB);
            PG8_BAR; PG8_WAIT_L(0); PG8_MMA(0, 1, At, B1); PG8_BAR;
            PG8_LDA(At, 1, 1); PG8_STAGE(PG8_SA(1, 0), a3, voffA);
            PG8_BAR; PG8_WAIT_L(0); PG8_MMA(1, 0, At, B0); PG8_BAR; PG8_SCHED;
            PG8_STAGE(PG8_SB(1, 1), b3 + hstep, voffB);
            PG8_WAIT_V(6); PG8_BAR; PG8_MMA(1, 1, At, B1); PG8_BAR;
            }
        }
        if constexpr (ALIGN_EPI) { if (wr == 0) PG8_BAR; }
        if constexpr (!Epi::AFTER_DRAIN) { E(acc, cur, wr, wc, fr, fq); S.done(cur); }
        if (!has_next) break;
#pragma unroll
        for (int a = 0; a < 2; ++a)
#pragma unroll
            for (int b = 0; b < 2; ++b)
#pragma unroll
                for (int m = 0; m < 4; ++m)
#pragma unroll
                    for (int n = 0; n < 2; ++n) acc[a][b][m][n] = (f32x4){0.f, 0.f, 0.f, 0.f};
        cur = nxt; cA = nA; cB = nB; ++ui;
        if constexpr (ALIGN_EPI) { if (wr == 1) PG8_BAR; }
    }
    PG8_WAIT_V(0);
    if constexpr (!ALIGN_EPI) { if (wr == 0) PG8_BAR; }
    PG8_BAR;
    if constexpr (Epi::AFTER_DRAIN) { E.fused(acc, cur, wr, wc, fr, fq, lds, wid, lane); S.done(cur); }
#undef PG8_SA
#undef PG8_SB
#undef PG8_STAGE
#undef PG8_LDA
#undef PG8_LDB
#undef PG8_MMA
#undef PG8_WAIT_V
#undef PG8_WAIT_L
#undef PG8_BAR
#undef PG8_SCHED
}
}
#define GAS __attribute__((address_space(1)))
#define LAS __attribute__((address_space(3)))
typedef unsigned short bf16;
typedef unsigned v4u __attribute__((ext_vector_type(4)));
typedef float f32x4 __attribute__((ext_vector_type(4)));
typedef short bf16x8 __attribute__((ext_vector_type(8)));
typedef GAS unsigned gu32;
typedef GAS unsigned long long gu64;
#define RLX_AGENT __ATOMIC_RELAXED, __HIP_MEMORY_SCOPE_AGENT
#define LDS_WAIT() asm volatile("s_waitcnt lgkmcnt(0)" ::: "memory")
#define VM_WAIT() asm volatile("s_waitcnt vmcnt(0)" ::: "memory")
__device__ __forceinline__ unsigned long long rt() { return __builtin_amdgcn_s_memrealtime(); }
__device__ __forceinline__ unsigned f2bf(float f) { unsigned u = __builtin_bit_cast(unsigned, f); return (u + 0x7fffu + ((u >> 16) & 1u)) >> 16; }
__device__ __forceinline__ unsigned pk2(float lo, float hi) { return f2bf(lo) | (f2bf(hi) << 16); }

#define XB_TMO      128
#define XB_XCNT(j)  (256  + 64 * (j))
#define XB_XSUB(j)  (1280 + 64 * (j))
#define XB_XGEN(j)  (2304 + 64 * (j))
#define XB_TOP      3328
#define XB_TOPGEN   3392
#define XCD_BAR_WORDS 3456
#define XB_SPIN_CAP (1u << 18)

__device__ __forceinline__ unsigned xb_ld(unsigned* p)              { return __hip_atomic_load(p, __ATOMIC_RELAXED, __HIP_MEMORY_SCOPE_AGENT); }
__device__ __forceinline__ unsigned xb_add(unsigned* p, unsigned v) { return __hip_atomic_fetch_add(p, v, __ATOMIC_RELAXED, __HIP_MEMORY_SCOPE_AGENT); }
__device__ __forceinline__ unsigned xb_xcc_id() { return (unsigned)__builtin_amdgcn_s_getreg((3 << 11) | 20) & 0xFu; }
#define XB_SPIN(cond, bar) do { unsigned _sp = 0; while (cond) { __builtin_amdgcn_s_sleep(1); \
    if ((++_sp & 255u) == 0u) { if (xb_ld(&(bar)[XB_TMO])) break; if (_sp > XB_SPIN_CAP) { atomicAdd(&(bar)[XB_TMO], 1u); break; } } } } while (0)

struct XcdBarrier {
    unsigned* bar; unsigned x;
    volatile LAS unsigned* st;
};

__device__ __forceinline__ XcdBarrier xcd_barrier_post(unsigned* bar, volatile LAS unsigned* st) {
    XcdBarrier b; b.bar = bar; b.x = xb_xcc_id(); b.st = st;
    if (threadIdx.x == 0) (void)xb_add(&bar[XB_XCNT(b.x)], 1u);
    return b;
}
__device__ __forceinline__ void xcd_barrier_complete(unsigned* bar, unsigned x, unsigned& nloc, unsigned& nx) {
    const unsigned G = gridDim.x * gridDim.y * gridDim.z;
    unsigned sum, cnt, mine, sp = 0u;
    for (;;) {
        sum = 0u; cnt = 0u; mine = 0u;
#pragma unroll
        for (unsigned j = 0; j < 16; ++j) { const unsigned c = xb_ld(&bar[XB_XCNT(j)]); sum += c; cnt += (c > 0u) ? 1u : 0u; mine = (j == x) ? c : mine; }
        if (sum == G) break;
        __builtin_amdgcn_s_sleep(1);
        if ((++sp & 255u) == 0u) { if (xb_ld(&bar[XB_TMO])) break; if (sp > XB_SPIN_CAP) { atomicAdd(&bar[XB_TMO], 1u); break; } }
    }
    nloc = mine > 0u ? mine : 1u; nx = cnt > 0u ? cnt : 1u;
}

__device__ __forceinline__ void xcd_barrier(const XcdBarrier& b) {
    asm volatile("s_waitcnt vmcnt(0)" ::: "memory");
    __syncthreads();
    if (threadIdx.x == 0) {
        unsigned* bar = b.bar;
        __builtin_amdgcn_s_waitcnt(0);
        unsigned nloc = b.st[0], nx = b.st[1];
        if (nloc == 0u) { xcd_barrier_complete(bar, b.x, nloc, nx); b.st[0] = nloc; b.st[1] = nx; }
        const unsigned old = xb_add(&bar[XB_XSUB(b.x)], 1u);
        const unsigned gen = old / nloc;
        if (old + 1u == (gen + 1u) * nloc) {
            __builtin_amdgcn_fence(__ATOMIC_RELEASE, "agent");
            asm volatile("s_waitcnt vmcnt(0)" ::: "memory");
            const unsigned og = xb_add(&bar[XB_TOP], 1u);
            const unsigned tg = og / nx;
            if (og + 1u == (tg + 1u) * nx) xb_add(&bar[XB_TOPGEN], 1u);
            else XB_SPIN(xb_ld(&bar[XB_TOPGEN]) == tg, bar);
            __builtin_amdgcn_fence(__ATOMIC_ACQUIRE, "agent");
            xb_add(&bar[XB_XGEN(b.x)], 1u);
            asm volatile("s_waitcnt vmcnt(0)" ::: "memory");
        } else {
            XB_SPIN(xb_ld(&bar[XB_XGEN(b.x)]) == gen, bar);
            __builtin_amdgcn_fence(__ATOMIC_ACQUIRE, "agent");
            asm volatile("s_waitcnt vmcnt(0)" ::: "memory");
        }
    }
    __syncthreads();
}
constexpr int NWAVES = 8, NT = NWAVES * 64;
constexpr int DM = 1024, NB_P = 8, SEQ = 2048, NB_S = 128, LS = 8;
constexpr int MP = NB_P * SEQ, MS = NB_S * LS, M = MP + MS;
constexpr int NSEQ = NB_P + NB_S;
constexpr int IN_DIM = 6688, IN_PAD = 6912, PITCH = IN_DIM;
constexpr int PC_Z = 0, PC_XBC = 1024, PC_QKV = 2560, PC_GATE = 5632, PC_DT = 6656, PC_BETA = 6672, PC_ALPHA = 6680;
constexpr int DMIX = 2048, DFF = 2816, NGU = 2 * DFF, NMOD = 6 * DM;
constexpr int SSD_H = 16, SSD_P = 64, SSD_N = 128, SSD_CONV = 1536, GDN_H = 8, GDN_D = 128, GDN_CONV = 3072;
constexpr float EPS = 1e-6f;
constexpr size_t OFF_Y = 0, OFF_SSD_P = (size_t)M * DM, OFF_SSDC_P = OFF_SSD_P + (size_t)NB_P * SSD_H * SSD_P * SSD_N, OFF_GDN_P = OFF_SSDC_P + (size_t)NB_P * 3 * SSD_CONV,
                 OFF_GDNC_P = OFF_GDN_P + (size_t)NB_P * GDN_H * GDN_D * GDN_D, OFF_SSD_S = OFF_GDNC_P + (size_t)NB_P * 3 * GDN_CONV, OFF_SSDC_S = OFF_SSD_S + (size_t)NB_S * SSD_H * SSD_P * SSD_N,
                 OFF_GDN_S = OFF_SSDC_S + (size_t)NB_S * 3 * SSD_CONV, OFF_GDNC_S = OFF_GDN_S + (size_t)NB_S * GDN_H * GDN_D * GDN_D, OUT_TOTAL = OFF_GDNC_S + (size_t)NB_S * 3 * GDN_CONV;
static_assert(OUT_TOTAL == 55357440, "output size");
constexpr size_t MiB = 1u << 20;
constexpr size_t WS_CTL = 0, CTL_ZERO_BYTES = 1 * MiB;
constexpr size_t WS_WOUT = 1 * MiB, WS_WGU = 5 * MiB, WS_WDN = 16 * MiB, WS_MOD = 22 * MiB, WS_SSQ = 26 * MiB, WS_PROJ = 28 * MiB;
constexpr size_t PROJ_BYTES = (size_t)M * PITCH * 2;
constexpr size_t WS_T1 = WS_PROJ, WS_XN2 = WS_PROJ + 68 * MiB, WS_ACT = WS_PROJ + 102 * MiB, WS_T2 = WS_PROJ;
constexpr size_t WS_END = 251 * MiB;
static_assert(WS_WOUT + (size_t)DM * DMIX * 2 <= WS_WGU && WS_WGU + (size_t)NGU * DM * 2 <= WS_WDN && WS_WDN + (size_t)DM * DFF * 2 <= WS_MOD && WS_MOD + (size_t)NSEQ * NMOD * 4 <= WS_SSQ && WS_SSQ + (size_t)M * 16 * 4 <= WS_PROJ, "ws map");
static_assert(WS_PROJ + PROJ_BYTES <= WS_END && (size_t)M * DM * 4 <= 68 * MiB && (size_t)M * DM * 2 <= 34 * MiB && WS_ACT + (size_t)M * DFF * 2 <= WS_PROJ + PROJ_BYTES, "ws overlays");
static_assert((size_t)IN_PAD * DM * 2 <= (size_t)NB_S * SSD_H * SSD_P * SSD_N * 4 && (size_t)M * DM * 2 <= (size_t)NB_S * GDN_H * GDN_D * GDN_D * 4 && (size_t)M * DMIX * 2 == (size_t)M * DM * 4, "d_out scratch");
constexpr int CW_TMO = 0, CW_CODE = 1, CW_QUEUE = 64, CW_BAR = 4096;
constexpr int RING_OFF = 0, RING_BYTES = 131072, LDS_BYTES = 163840, LDSCTL_OFF = LDS_BYTES - 1024, MISC_OFF = LDSCTL_OFF + 320;
struct Args { const float* in[28]; float* out; unsigned char* ws; int ph_lo, ph_hi, li, pad; };
enum { I_XP = 0, I_XS, I_CP, I_CS, I_SSD, I_SSDC, I_GDN, I_GDNC, I_WADA, I_BADA, I_NMPRE, I_NMPOST, I_NFPRE, I_NFPOST, I_WIN, I_SCW, I_SCB, I_SDTB, I_SALOG, I_SD, I_SNW, I_GCW, I_GDTB, I_GALOG, I_GNW, I_WOUT, I_WGU, I_WDN };
__device__ __forceinline__ float bf2f(unsigned v) { return __uint_as_float(v << 16); }
__device__ __forceinline__ float silu_acc(float x) { return x / (1.f + expf(-x)); }
__device__ __forceinline__ float softplus_acc(float x) { const float e = __expf(-fabsf(x)); const float l = (e < 0.03125f) ? e * (1.f - e * (0.5f - e * (0.33333334f - 0.25f * e))) : __logf(1.f + e); return fmaxf(x, 0.f) + l; }
template <int MASK> __device__ __forceinline__ float sx(float v) { return __int_as_float(__builtin_amdgcn_ds_swizzle(__float_as_int(v), 0x1f | (MASK << 10))); }
__device__ __forceinline__ float sx32(float v, int lane) { return __int_as_float(__builtin_amdgcn_ds_bpermute((lane ^ 32) << 2, __float_as_int(v))); }
__device__ __forceinline__ float sup(float v, int d, int lane) { return __int_as_float(__builtin_amdgcn_ds_bpermute((lane - d) << 2, __float_as_int(v))); }
__device__ __forceinline__ float wave_sum(float v, int lane) { v += sx<1>(v); v += sx<2>(v); v += sx<4>(v); v += sx<8>(v); v += sx<16>(v); v += sx32(v, lane); return v; }
__device__ __forceinline__ bf16* ws_bf(const Args& a, size_t off) { return (bf16*)(a.ws + off); }
__device__ __forceinline__ float* ws_f(const Args& a, size_t off) { return (float*)(a.ws + off); }
__device__ __forceinline__ bf16* win_t(const Args& a) { return (bf16*)(a.out + OFF_SSD_S); }
__device__ __forceinline__ bf16* xn_buf(const Args& a) { return (bf16*)(a.out + OFF_GDN_S); }
__device__ __forceinline__ bf16* mixed_buf(const Args& a) { return (bf16*)(a.out + OFF_Y); }
__device__ __forceinline__ const float* x_row(const Args& a, int row) { return row < MP ? a.in[I_XP] + (size_t)row * DM : a.in[I_XS] + (size_t)(row - MP) * DM; }
__device__ __forceinline__ int seq_of_row(int row) { return row < MP ? (row >> 11) : NB_P + ((row - MP) >> 3); }

__device__ __forceinline__ int dest_row(int which, int n) {
    if (which == 1) { if (n < 2560) return n; if (n < 2576) return PC_DT + (n - 2560); if (n < 6672) return n - 16; return n; }
    if (which == 2) { const int j = n < DFF ? n : n - DFF; return 256 * (j >> 7) + (n < DFF ? 0 : 128) + (j & 127); }
    return n;
}
__device__ __forceinline__ void p0_transpose_item(const float* W, int K, int N, bf16* WT, int which, LAS float* scr, int item, int lane) {
    const int nblk = N / 32, kb = item / nblk, nb = item % nblk, k0 = 64 * kb, n0 = 32 * nb;
#pragma unroll 8
    for (int i = 0; i < 32; ++i) { const int kk = 2 * i + (lane >> 5); scr[kk * 33 + (lane & 31)] = W[(size_t)(k0 + kk) * N + n0 + (lane & 31)]; }
    LDS_WAIT(); asm volatile("" ::: "memory");
    const int c = lane & 7;
#pragma unroll
    for (int j = 0; j < 4; ++j) { const int n = (lane >> 3) + 8 * j; const LAS float* s = scr + (8 * c) * 33 + n;
        v4u o; o.x = pk2(s[0 * 33], s[1 * 33]); o.y = pk2(s[2 * 33], s[3 * 33]); o.z = pk2(s[4 * 33], s[5 * 33]); o.w = pk2(s[6 * 33], s[7 * 33]);
        *(GAS v4u*)(WT + (size_t)dest_row(which, n0 + n) * K + k0 + 8 * c) = o; }
    LDS_WAIT(); asm volatile("" ::: "memory");
}
constexpr int TI_IN = (DM / 64) * (IN_DIM / 32), TI_OUT = (DMIX / 64) * (DM / 32), TI_GU = (DM / 64) * (NGU / 32), TI_DN = (DFF / 64) * (DM / 32), TI_PAD = IN_PAD - IN_DIM;
constexpr int TI_ALL = TI_IN + TI_OUT + TI_GU + TI_DN + TI_PAD;
constexpr int ADA_RB = 17, ADA_ITEMS = (NSEQ / ADA_RB) * (NMOD / 512);
static_assert(NSEQ % ADA_RB == 0 && IN_DIM % 32 == 0 && NGU % 32 == 0 && DFF % 64 == 0, "P0 tiling");
__device__ __forceinline__ void p0_ada_item(const Args& a, LAS unsigned char* lds, int it, int tid, int wave, int lane) {
    LAS float* cs = (LAS float*)lds;
    const int rb = it / (NMOD / 512), cb = it % (NMOD / 512);
    for (int idx = tid; idx < ADA_RB * DM; idx += NT) { const int r = idx >> 10, k = idx & 1023, row = ADA_RB * rb + r;
        const float c = row < NB_P ? a.in[I_CP][row * DM + k] : a.in[I_CS][(row - NB_P) * DM + k]; cs[idx] = silu_acc(c); }
    __syncthreads();
    const int n = 512 * cb + 64 * wave + lane;
    const float* wp = a.in[I_WADA] + n;
    float acc[ADA_RB];
#pragma unroll
    for (int r = 0; r < ADA_RB; ++r) acc[r] = 0.f;
    for (int k = 0; k < DM; k += 4) {
        const float w0 = wp[(size_t)(k + 0) * NMOD], w1 = wp[(size_t)(k + 1) * NMOD], w2 = wp[(size_t)(k + 2) * NMOD], w3 = wp[(size_t)(k + 3) * NMOD];
#pragma unroll
        for (int r = 0; r < ADA_RB; ++r) { const f32x4 c4 = *(const LAS f32x4*)(cs + r * DM + k); acc[r] += c4.x * w0; acc[r] += c4.y * w1; acc[r] += c4.z * w2; acc[r] += c4.w * w3; }
    }
    float* mod = ws_f(a, WS_MOD); const float b = a.in[I_BADA][n];
#pragma unroll
    for (int r = 0; r < ADA_RB; ++r) mod[(size_t)(ADA_RB * rb + r) * NMOD + n] = acc[r] + b;
    __syncthreads();
}
__device__ __forceinline__ void p0_prologue(const Args& a, LAS unsigned char* lds, int bid, int G, int tid, int wave, int lane) {
    const bool split = G > 128;
    const int ada_lo = 0, ada_G = split ? ADA_ITEMS : G;
    if (!split || bid < ADA_ITEMS) for (int it = bid - ada_lo; it < ADA_ITEMS; it += ada_G) p0_ada_item(a, lds, it, tid, wave, lane);
    if (!split || bid >= ADA_ITEMS) {
        LAS float* scr = (LAS float*)(lds + wave * 16384);
        const int gw = (split ? bid - ADA_ITEMS : bid) * NWAVES + wave, NGW = (split ? G - ADA_ITEMS : G) * NWAVES;
        for (int it = gw; it < TI_ALL; it += NGW) {
            int r = it;
            if (r < TI_IN) { p0_transpose_item(a.in[I_WIN], DM, IN_DIM, win_t(a), 1, scr, r, lane); continue; } r -= TI_IN;
            if (r < TI_OUT) { p0_transpose_item(a.in[I_WOUT], DMIX, DM, ws_bf(a, WS_WOUT), 0, scr, r, lane); continue; } r -= TI_OUT;
            if (r < TI_GU) { p0_transpose_item(a.in[I_WGU], DM, NGU, ws_bf(a, WS_WGU), 2, scr, r, lane); continue; } r -= TI_GU;
            if (r < TI_DN) { p0_transpose_item(a.in[I_WDN], DFF, DM, ws_bf(a, WS_WDN), 0, scr, r, lane); continue; } r -= TI_DN;
            { GAS v4u* o = (GAS v4u*)(win_t(a) + (size_t)(IN_DIM + r) * DM) + lane; o[0] = (v4u){0u, 0u, 0u, 0u}; o[64] = (v4u){0u, 0u, 0u, 0u}; }
        }
    }
}
__device__ __forceinline__ void p1_xn(const Args& a, int gw, int NGW, int lane) {
    const float* mod = ws_f(a, WS_MOD); bf16* XN = xn_buf(a); const float* nw = a.in[I_NMPRE];
    for (int row = gw; row < M; row += NGW) {
        const f32x4* xr = (const f32x4*)x_row(a, row) + lane; const float* mr = mod + (size_t)seq_of_row(row) * NMOD;
        f32x4 v[4]; float s = 0.f;
#pragma unroll
        for (int j = 0; j < 4; ++j) { v[j] = xr[64 * j]; s += (v[j].x * v[j].x + v[j].y * v[j].y) + (v[j].z * v[j].z + v[j].w * v[j].w); }
        const float rs = 1.f / sqrtf(wave_sum(s, lane) * (1.f / DM) + EPS);
        unsigned long long* o8 = (unsigned long long*)(XN + (size_t)row * DM) + lane;
#pragma unroll
        for (int j = 0; j < 4; ++j) { const int c = 4 * lane + 256 * j; const f32x4 w = *(const f32x4*)(nw + c), sh = *(const f32x4*)(mr + c), sc = *(const f32x4*)(mr + DM + c);
            const f32x4 h = v[j] * rs * w * (sc + 1.f) + sh;
            o8[64 * j] = (unsigned long long)pk2(h.x, h.y) | ((unsigned long long)pk2(h.z, h.w) << 32); }
    }
}
typedef short bf16x8 __attribute__((ext_vector_type(8)));
typedef unsigned u32x2 __attribute__((ext_vector_type(2)));
constexpr int P128 = 136, P64 = 72, LP = 68, TP = 36;
#define MFMA16(a, b, c) __builtin_amdgcn_mfma_f32_16x16x32_bf16(a, b, c, 0, 0, 0)
__device__ __forceinline__ bf16x8 ldfrag(const LAS bf16* base, int pitch, int row0, int k0, int lane) { return *(const LAS bf16x8*)(base + (row0 + (lane & 15)) * pitch + k0 + 8 * (lane >> 4)); }
typedef float f32x2_t __attribute__((ext_vector_type(2))); typedef __bf16 bf16x2_t __attribute__((ext_vector_type(2)));
__device__ __forceinline__ unsigned cvtpk(float lo, float hi) { f32x2_t v = {lo, hi}; bf16x2_t b = __builtin_convertvector(v, bf16x2_t); return __builtin_bit_cast(unsigned, b); }
__device__ __forceinline__ u32x2 pack4(f32x4 v) { u32x2 r; r.x = cvtpk(v[0], v[1]); r.y = cvtpk(v[2], v[3]); return r; }
__device__ __forceinline__ float silu_f(float x) { return x * __builtin_amdgcn_rcpf(1.f + __expf(-x)); }
__device__ __forceinline__ void unpack8(v4u r, float (&x)[8]) { x[0] = bf2f(r.x & 0xffffu); x[1] = __uint_as_float(r.x & 0xffff0000u); x[2] = bf2f(r.y & 0xffffu); x[3] = __uint_as_float(r.y & 0xffff0000u);
    x[4] = bf2f(r.z & 0xffffu); x[5] = __uint_as_float(r.z & 0xffff0000u); x[6] = bf2f(r.w & 0xffffu); x[7] = __uint_as_float(r.w & 0xffff0000u); }
__device__ __forceinline__ v4u tpack(const unsigned (&outp)[8][4], int c) { const int cp = c >> 1; const unsigned sel = (c & 1) ? 0x07060302u : 0x05040100u; v4u o;
    o.x = __builtin_amdgcn_perm(outp[1][cp], outp[0][cp], sel); o.y = __builtin_amdgcn_perm(outp[3][cp], outp[2][cp], sel); o.z = __builtin_amdgcn_perm(outp[5][cp], outp[4][cp], sel); o.w = __builtin_amdgcn_perm(outp[7][cp], outp[6][cp], sel); return o; }
__device__ __forceinline__ void conv8x8(const v4u (&R)[11], const float (&cw)[4][8], const float (&cb)[8], unsigned (&outp)[8][4], float (&ssq)[8]) {
    float acc[4][8];
#pragma unroll
    for (int i = 0; i < 11; ++i) { float x[8]; unpack8(R[i], x);
#pragma unroll
        for (int j = 0; j < 4; ++j) { const int l = i - j;
            if (l >= 0 && l < 8) {
#pragma unroll
                for (int c = 0; c < 8; ++c) acc[l & 3][c] = (j == 0 ? cb[c] : acc[l & 3][c]) + cw[j][c] * x[c]; } }
        if (i >= 3) { const int l = i - 3; float s = 0.f;
#pragma unroll
            for (int c = 0; c < 8; ++c) { acc[l & 3][c] = silu_f(acc[l & 3][c]); s += acc[l & 3][c] * acc[l & 3][c]; }
            ssq[l] = s;
#pragma unroll
            for (int cp = 0; cp < 4; ++cp) outp[l][cp] = cvtpk(acc[l & 3][2 * cp], acc[l & 3][2 * cp + 1]); } }
}
__device__ __forceinline__ void lower_pair(int p, int& i, int& j) { i = p >= 6 ? 3 : (p >= 3 ? 2 : (p >= 1 ? 1 : 0)); j = p - (i * (i + 1)) / 2; }
__device__ __forceinline__ void upper_pair(int z, int& i, int& j) { i = z >= 5 ? 2 : (z >= 3 ? 1 : 0); j = z >= 5 ? 3 : (z >= 3 ? z - 1 : z + 1); }
#define SCHED_FENCE() __builtin_amdgcn_sched_barrier(0)
__device__ __forceinline__ void tri_inverse64(LAS float* Lm, LAS float* tmp, int wave, int lane) {
    const int c = lane & 15, q = lane >> 4;
    if (wave == 0) {
        LAS float* Lb = Lm + (16 * q) * LP + 16 * q; f32x4 Lr[16][4];
#pragma unroll
        for (int l = 1; l < 16; ++l)
#pragma unroll
            for (int j = 0; j < (l + 3) / 4; ++j) Lr[l][j] = *(const LAS f32x4*)(Lb + l * LP + 4 * j);
        SCHED_FENCE();
        float t[16];
#pragma unroll
        for (int l = 0; l < 16; ++l) { float acc = (l == c) ? 1.f : 0.f;
#pragma unroll
            for (int s = 0; s < l; ++s) acc -= Lr[l][s >> 2][s & 3] * t[s];
            t[l] = acc; }
#pragma unroll
        for (int l = 0; l < 16; ++l) Lb[l * LP + c] = t[l];
    }
    __syncthreads();
    if (wave < 2) {
        const int o = 32 * wave; f32x4 acc = (f32x4){0.f, 0.f, 0.f, 0.f}; float av[4], bv[4];
#pragma unroll
        for (int kk = 0; kk < 4; ++kk) { av[kk] = Lm[(o + 16 + c) * LP + o + 4 * kk + q]; bv[kk] = Lm[(o + 4 * kk + q) * LP + o + c]; }
        SCHED_FENCE();
#pragma unroll
        for (int kk = 0; kk < 4; ++kk) acc = __builtin_amdgcn_mfma_f32_16x16x4f32(av[kk], bv[kk], acc, 0, 0, 0);
#pragma unroll
        for (int r = 0; r < 4; ++r) tmp[(16 * wave + 4 * q + r) * TP + c] = acc[r];
    }
    __syncthreads();
    if (wave < 2) {
        const int o = 32 * wave; f32x4 acc = (f32x4){0.f, 0.f, 0.f, 0.f}; float av[4], bv[4];
#pragma unroll
        for (int kk = 0; kk < 4; ++kk) { av[kk] = Lm[(o + 16 + c) * LP + o + 16 + 4 * kk + q]; bv[kk] = tmp[(16 * wave + 4 * kk + q) * TP + c]; }
        SCHED_FENCE();
#pragma unroll
        for (int kk = 0; kk < 4; ++kk) acc = __builtin_amdgcn_mfma_f32_16x16x4f32(av[kk], bv[kk], acc, 0, 0, 0);
#pragma unroll
        for (int r = 0; r < 4; ++r) Lm[(o + 16 + 4 * q + r) * LP + o + c] = -acc[r];
    }
    __syncthreads();
    if (wave < 4) {
        const int ti = wave >> 1, tj = wave & 1; f32x4 acc = (f32x4){0.f, 0.f, 0.f, 0.f}; float av[8], bv[8];
#pragma unroll
        for (int kk = 0; kk < 8; ++kk) { av[kk] = Lm[(32 + 16 * ti + c) * LP + 4 * kk + q]; bv[kk] = Lm[(4 * kk + q) * LP + 16 * tj + c]; }
        SCHED_FENCE();
#pragma unroll
        for (int kk = 0; kk < 8; ++kk) acc = __builtin_amdgcn_mfma_f32_16x16x4f32(av[kk], bv[kk], acc, 0, 0, 0);
#pragma unroll
        for (int r = 0; r < 4; ++r) tmp[(16 * ti + 4 * q + r) * TP + 16 * tj + c] = acc[r];
    }
    __syncthreads();
    if (wave < 4) {
        const int ti = wave >> 1, tj = wave & 1; f32x4 acc = (f32x4){0.f, 0.f, 0.f, 0.f}; float av[8], bv[8];
#pragma unroll
        for (int kk = 0; kk < 8; ++kk) { av[kk] = Lm[(32 + 16 * ti + c) * LP + 32 + 4 * kk + q]; bv[kk] = tmp[(4 * kk + q) * TP + 16 * tj + c]; }
        SCHED_FENCE();
#pragma unroll
        for (int kk = 0; kk < 8; ++kk) acc = __builtin_amdgcn_mfma_f32_16x16x4f32(av[kk], bv[kk], acc, 0, 0, 0);
#pragma unroll
        for (int r = 0; r < 4; ++r) Lm[(32 + 16 * ti + 4 * q + r) * LP + 16 * tj + c] = -acc[r];
    }
    __syncthreads();
}
constexpr int G_Q = 0, G_T1 = 0, G_T2 = 9216, G_K = 18432, G_W = 18432, G_KT = 35840, G_VT = 54272, G_VN = 54272, G_L = 72704, G_VNS = 72704, G_PART = 72704, G_ATT = 91136, G_TMP = 100352, G_ST = 104960, G_VEC = 139776, G_CW = 142592;
static_assert(G_CW + 3 * 128 * 4 * 4 <= LDSCTL_OFF, "GDN LDS map");
__device__ __forceinline__ void gdn_chunk_item(const Args& a, LAS unsigned char* lds, int b, int h, int tid_, int wave, int lane_) {
    const bf16* proj = ws_bf(a, WS_PROJ); bf16* mixed = mixed_buf(a);
    const int row0 = b * SEQ;
    LAS bf16* Lq = (LAS bf16*)(lds + G_Q); LAS bf16* Lk = (LAS bf16*)(lds + G_K); LAS bf16* LkT = (LAS bf16*)(lds + G_KT); LAS bf16* LvT = (LAS bf16*)(lds + G_VT);
    LAS bf16* LT1 = (LAS bf16*)(lds + G_T1); LAS bf16* LT2 = (LAS bf16*)(lds + G_T2); LAS bf16* LW = (LAS bf16*)(lds + G_W); LAS bf16* Lvn = (LAS bf16*)(lds + G_VN); LAS bf16* Lvns = (LAS bf16*)(lds + G_VNS);
    LAS bf16* Latt = (LAS bf16*)(lds + G_ATT); LAS bf16* LST = (LAS bf16*)(lds + G_ST); LAS float* LL = (LAS float*)(lds + G_L); LAS float* Ltmp = (LAS float*)(lds + G_TMP); LAS float* Lpart = (LAS float*)(lds + G_PART);
    LAS float* vgc = (LAS float*)(lds + G_VEC); LAS float* vbeta = vgc + 64; LAS float* vrq = vgc + 128; LAS float* vrk = vgc + 192; LAS float* vqs = vgc + 256; LAS float* vvsc = vgc + 320; LAS float* vt2s = vgc + 384; LAS float* vossq = vgc + 448; LAS float* vmisc = vgc + 576;
    LAS float* Lcw = (LAS float*)(lds + G_CW);
    const float Ag = -expf(a.in[I_GALOG][h]), dtb = a.in[I_GDTB][h];
    const float cb[8] = {0.f, 0.f, 0.f, 0.f, 0.f, 0.f, 0.f, 0.f};
    for (int i = tid_; i < 4 * 384; i += NT) { const int j = i / 384, c = i - j * 384; Lcw[i] = a.in[I_GCW][j * GDN_CONV + (c >> 7) * 1024 + h * 128 + (c & 127)]; }
    f32x4 Sacc[4][2];
#pragma unroll
    for (int x = 0; x < 4; ++x)
#pragma unroll
        for (int d = 0; d < 2; ++d) Sacc[x][d] = (f32x4){0.f, 0.f, 0.f, 0.f};
    for (int i = tid_; i < 128 * P128 / 2; i += NT) ((LAS unsigned*)LST)[i] = 0u;
    const int li = wave >> 1, dvh = wave & 1;
    __syncthreads();
#pragma unroll 1
    for (int ch = 0; ch < SEQ / 64; ++ch) {
        const int t0 = 64 * ch;
        int lane = lane_;
        asm volatile("" : "+v"(lane));
        const int tid = wave * 64 + lane, c16 = lane & 15, q4 = lane >> 4, oct = tid % 48, tg = tid / 48, seg = oct >> 4, c0 = 8 * (oct & 15);
        if (tid < 384) {
            v4u R[11]; const bf16* src = (proj + (size_t)(row0 + t0 - 3) * PITCH + PC_QKV + h * 128) + (unsigned)(8 * tg * PITCH + seg * 1024 + c0);
#pragma unroll
            for (int i = 0; i < 11; ++i) R[i] = (t0 + 8 * tg - 3 + i >= 0) ? *(const v4u*)(src + (size_t)i * PITCH) : (v4u){0u, 0u, 0u, 0u};
            float cw[4][8];
#pragma unroll
            for (int j = 0; j < 4; ++j) { const f32x4 w0 = *(const LAS f32x4*)(Lcw + j * 384 + seg * 128 + c0), w1 = *(const LAS f32x4*)(Lcw + j * 384 + seg * 128 + c0 + 4);
                cw[j][0] = w0.x; cw[j][1] = w0.y; cw[j][2] = w0.z; cw[j][3] = w0.w; cw[j][4] = w1.x; cw[j][5] = w1.y; cw[j][6] = w1.z; cw[j][7] = w1.w; }
            unsigned outp[8][4]; float ssq[8];
            conv8x8(R, cw, cb, outp, ssq);
            if (seg < 2) { LAS bf16* dst = (seg == 0 ? Lq : Lk) + (8 * tg) * P128 + c0;
#pragma unroll
                for (int l = 0; l < 8; ++l) { *(LAS v4u*)(dst + l * P128) = (v4u){outp[l][0], outp[l][1], outp[l][2], outp[l][3]}; Lpart[(seg * 64 + 8 * tg + l) * 16 + (oct & 15)] = ssq[l]; } }
            if (seg >= 1) { LAS bf16* dst = (seg == 1 ? LkT : LvT) + c0 * P64 + 8 * tg;
#pragma unroll
                for (int c = 0; c < 8; ++c) *(LAS v4u*)(dst + c * P64) = tpack(outp, c); }
        } else if (wave == 6) {
            const size_t r = (size_t)(row0 + t0 + lane) * PITCH;
            const float g = Ag * softplus_acc(bf2f(proj[r + PC_ALPHA + h]) + dtb), be = 1.f / (1.f + __expf(-bf2f(proj[r + PC_BETA + h])));
            float gc = g;
#pragma unroll
            for (int d = 1; d < 64; d <<= 1) { const float v = sup(gc, d, lane); if (lane >= d) gc += v; }
            vgc[lane] = gc; vbeta[lane] = be;
        }
        __syncthreads();
        if (tid < 64) { f32x4 pq[4], pk[4];
#pragma unroll
            for (int o = 0; o < 4; ++o) { pq[o] = *(const LAS f32x4*)(Lpart + tid * 16 + 4 * o); pk[o] = *(const LAS f32x4*)(Lpart + (64 + tid) * 16 + 4 * o); }
            float sq = 0.f, sk = 0.f;
#pragma unroll
            for (int o = 0; o < 4; ++o) { sq += (pq[o].x + pq[o].y) + (pq[o].z + pq[o].w); sk += (pk[o].x + pk[o].y) + (pk[o].z + pk[o].w); }
            const float rq = __builtin_amdgcn_rsqf(sq + 1e-6f), rk = __builtin_amdgcn_rsqf(sk + 1e-6f), gc = vgc[tid], gl = vgc[63], be = vbeta[tid];
            vrq[tid] = rq; vrk[tid] = rk; vqs[tid] = __expf(gc) * rq * 0.08838834764831845f; vvsc[tid] = __expf(gl - gc) * rk; vt2s[tid] = be * __expf(gc) * rk;
            if (tid == 0) vmisc[0] = __expf(gl); }
        __syncthreads();
        const size_t orow = (size_t)(row0 + t0 + 16 * li + c16);
        unsigned long long gg[4];
#pragma unroll
        for (int tt = 0; tt < 4; ++tt) gg[tt] = *(const unsigned long long*)(proj + orow * PITCH + PC_GATE + h * 128 + 16 * (4 * dvh + tt) + 4 * q4);
        f32x4 oacc[4];
        { bf16x8 qf[4], sf[4][4];
#pragma unroll
            for (int ks = 0; ks < 4; ++ks) { qf[ks] = ldfrag(Lq, P128, 16 * li, 32 * ks, lane);
#pragma unroll
                for (int tt = 0; tt < 4; ++tt) sf[ks][tt] = ldfrag(LST, P128, 16 * (4 * dvh + tt), 32 * ks, lane); }
            SCHED_FENCE();
#pragma unroll
            for (int tt = 0; tt < 4; ++tt) oacc[tt] = (f32x4){0.f, 0.f, 0.f, 0.f};
#pragma unroll
            for (int ks = 0; ks < 4; ++ks)
#pragma unroll
                for (int tt = 0; tt < 4; ++tt) oacc[tt] = MFMA16(sf[ks][tt], qf[ks], oacc[tt]); }
#pragma unroll 1
        for (int job = wave; job < 20; job += 8) { const int type = job >= 10 ? 1 : 0; int ti, tj; lower_pair(job - 10 * type, ti, tj);
            const LAS bf16* Y = type ? Lq : Lk; bf16x8 xf[4], yf[4];
#pragma unroll
            for (int ks = 0; ks < 4; ++ks) { xf[ks] = ldfrag(Lk, P128, 16 * tj, 32 * ks, lane); yf[ks] = ldfrag(Y, P128, 16 * ti, 32 * ks, lane); }
            const int l = 16 * ti + c16, s0 = 16 * tj + 4 * q4; const float gcl = vgc[l]; const f32x4 gcs = *(const LAS f32x4*)(vgc + s0), rks = *(const LAS f32x4*)(vrk + s0);
            const float rowf = type ? vrq[l] * 0.08838834764831845f : vbeta[l] * vrk[l];
            SCHED_FENCE();
            f32x4 acc = (f32x4){0.f, 0.f, 0.f, 0.f};
#pragma unroll
            for (int ks = 0; ks < 4; ++ks) acc = MFMA16(xf[ks], yf[ks], acc);
            f32x4 val;
#pragma unroll
            for (int r = 0; r < 4; ++r) { const bool ok = type ? (s0 + r <= l) : (s0 + r < l); val[r] = ok ? acc[r] * rowf * rks[r] * __expf(gcl - gcs[r]) : 0.f; }
            if (type == 0) *(LAS f32x4*)(LL + l * LP + s0) = val; else *(LAS u32x2*)(Latt + l * P64 + s0) = pack4(val); }
        for (int z = wave; z < 12; z += 8) { int ti, tj; upper_pair(z >= 6 ? z - 6 : z, ti, tj); const int l = 16 * ti + c16, s0 = 16 * tj + 4 * q4;
            if (z < 6) *(LAS f32x4*)(LL + l * LP + s0) = (f32x4){0.f, 0.f, 0.f, 0.f}; else *(LAS u32x2*)(Latt + l * P64 + s0) = (u32x2){0u, 0u}; }
        __syncthreads();
        tri_inverse64(LL, Ltmp, wave, lane);
        { const int l = tid >> 3, s0 = 8 * (tid & 7); const f32x4 ta = *(const LAS f32x4*)(LL + l * LP + s0), tb = *(const LAS f32x4*)(LL + l * LP + s0 + 4);
            const f32x4 ba = *(const LAS f32x4*)(vbeta + s0), bb = *(const LAS f32x4*)(vbeta + s0 + 4), sa = *(const LAS f32x4*)(vt2s + s0), sb = *(const LAS f32x4*)(vt2s + s0 + 4);
            const u32x2 p0 = pack4(ta * ba), p1 = pack4(tb * bb), r0 = pack4(ta * sa), r1 = pack4(tb * sb);
            *(LAS v4u*)(LT1 + l * P64 + s0) = (v4u){p0.x, p0.y, p1.x, p1.y}; *(LAS v4u*)(LT2 + l * P64 + s0) = (v4u){r0.x, r0.y, r1.x, r1.y}; }
        __syncthreads();
        f32x4 uacc[4];
        { bf16x8 vf[2], kf[2], t1f[2][4], t2f[2][4];
#pragma unroll
            for (int ks = 0; ks < 2; ++ks) { vf[ks] = ldfrag(LvT, P64, 16 * wave, 32 * ks, lane); kf[ks] = ldfrag(LkT, P64, 16 * wave, 32 * ks, lane);
#pragma unroll
                for (int lt = 2 * ks; lt < 4; ++lt) { t1f[ks][lt] = ldfrag(LT1, P64, 16 * lt, 32 * ks, lane); t2f[ks][lt] = ldfrag(LT2, P64, 16 * lt, 32 * ks, lane); } }
            SCHED_FENCE();
            f32x4 wacc[4];
#pragma unroll
            for (int lt = 0; lt < 4; ++lt) { uacc[lt] = (f32x4){0.f, 0.f, 0.f, 0.f}; wacc[lt] = (f32x4){0.f, 0.f, 0.f, 0.f}; }
#pragma unroll
            for (int ks = 0; ks < 2; ++ks)
#pragma unroll
                for (int lt = 2 * ks; lt < 4; ++lt) { uacc[lt] = MFMA16(t1f[ks][lt], vf[ks], uacc[lt]); wacc[lt] = MFMA16(kf[ks], t2f[ks][lt], wacc[lt]); }
#pragma unroll
            for (int lt = 0; lt < 4; ++lt) *(LAS u32x2*)(LW + (16 * lt + c16) * P128 + 16 * wave + 4 * q4) = pack4(wacc[lt]); }
        __syncthreads();
        { bf16x8 sf[4], wf[4][4]; f32x4 sc[4];
#pragma unroll
            for (int ks = 0; ks < 4; ++ks) { sf[ks] = ldfrag(LST, P128, 16 * wave, 32 * ks, lane);
#pragma unroll
                for (int lt = 0; lt < 4; ++lt) wf[ks][lt] = ldfrag(LW, P128, 16 * lt, 32 * ks, lane); }
#pragma unroll
            for (int lt = 0; lt < 4; ++lt) sc[lt] = *(const LAS f32x4*)(vvsc + 16 * lt + 4 * q4);
            SCHED_FENCE();
            f32x4 ws[4];
#pragma unroll
            for (int lt = 0; lt < 4; ++lt) ws[lt] = (f32x4){0.f, 0.f, 0.f, 0.f};
#pragma unroll
            for (int ks = 0; ks < 4; ++ks)
#pragma unroll
                for (int lt = 0; lt < 4; ++lt) ws[lt] = MFMA16(wf[ks][lt], sf[ks], ws[lt]);
#pragma unroll
            for (int lt = 0; lt < 4; ++lt) { const f32x4 vn = uacc[lt] - ws[lt];
                *(LAS u32x2*)(Lvn + (16 * wave + c16) * P64 + 16 * lt + 4 * q4) = pack4(vn); *(LAS u32x2*)(Lvns + (16 * wave + c16) * P64 + 16 * lt + 4 * q4) = pack4(vn * sc[lt]); } }
        __syncthreads();
        {
            bf16x8 kf[2][4], nf[2][2], af[2], vf[2][4];
#pragma unroll
            for (int ks = 0; ks < 2; ++ks) {
#pragma unroll
                for (int x = 0; x < 4; ++x) { kf[ks][x] = ldfrag(LkT, P64, 16 * (4 * dvh + x), 32 * ks, lane); vf[ks][x] = ldfrag(Lvn, P64, 16 * (4 * dvh + x), 32 * ks, lane); }
#pragma unroll
                for (int d = 0; d < 2; ++d) nf[ks][d] = ldfrag(Lvns, P64, 16 * (2 * li + d), 32 * ks, lane);
                af[ks] = ldfrag(Latt, P64, 16 * li, 32 * ks, lane); }
            const float ge = vmisc[0], qsl = vqs[16 * li + c16];
            SCHED_FENCE();
#pragma unroll
            for (int x = 0; x < 4; ++x)
#pragma unroll
                for (int d = 0; d < 2; ++d) Sacc[x][d] = Sacc[x][d] * ge;
#pragma unroll
            for (int tt = 0; tt < 4; ++tt) oacc[tt] = oacc[tt] * qsl;
#pragma unroll
            for (int ks = 0; ks < 2; ++ks) {
#pragma unroll
                for (int d = 0; d < 2; ++d)
#pragma unroll
                    for (int x = 0; x < 4; ++x) Sacc[x][d] = MFMA16(kf[ks][x], nf[ks][d], Sacc[x][d]);
                if (ks == 0 || li >= 2) {
#pragma unroll
                    for (int tt = 0; tt < 4; ++tt) oacc[tt] = MFMA16(vf[ks][tt], af[ks], oacc[tt]); } }
#pragma unroll
            for (int x = 0; x < 4; ++x)
#pragma unroll
                for (int d = 0; d < 2; ++d) *(LAS u32x2*)(LST + (16 * (2 * li + d) + c16) * P128 + 16 * (4 * dvh + x) + 4 * q4) = pack4(Sacc[x][d]);
            float sq = 0.f;
#pragma unroll
            for (int tt = 0; tt < 4; ++tt) sq += (oacc[tt][0] * oacc[tt][0] + oacc[tt][1] * oacc[tt][1]) + (oacc[tt][2] * oacc[tt][2] + oacc[tt][3] * oacc[tt][3]);
            sq += sx<16>(sq); sq += sx32(sq, lane);
            if (q4 == 0) vossq[(16 * li + c16) * 2 + dvh] = sq;
            __syncthreads();
            const float rs = __builtin_amdgcn_rsqf((vossq[(16 * li + c16) * 2] + vossq[(16 * li + c16) * 2 + 1]) * (1.f / GDN_D) + EPS);
#pragma unroll
            for (int tt = 0; tt < 4; ++tt) { const int dv0 = 16 * (4 * dvh + tt) + 4 * q4; const f32x4 w = *(const f32x4*)(a.in[I_GNW] + dv0);
                const float g0 = silu_f(bf2f((unsigned)gg[tt] & 0xffffu)), g1 = silu_f(bf2f(((unsigned)gg[tt]) >> 16)), g2 = silu_f(bf2f((unsigned)(gg[tt] >> 32) & 0xffffu)), g3 = silu_f(bf2f((unsigned)(gg[tt] >> 48)));
                const f32x4 o = oacc[tt] * rs * w * (f32x4){g0, g1, g2, g3};
                *(u32x2*)(mixed + orow * DMIX + DM + h * 128 + dv0) = pack4(o); }
        }
    }
    const int c16 = lane_ & 15, q4 = lane_ >> 4;
    float* so = a.out + OFF_GDN_P + ((size_t)b * GDN_H + h) * (GDN_D * GDN_D);
#pragma unroll
    for (int x = 0; x < 4; ++x)
#pragma unroll
        for (int d = 0; d < 2; ++d)
#pragma unroll
            for (int r = 0; r < 4; ++r) so[(size_t)(16 * (4 * dvh + x) + 4 * q4 + r) * GDN_D + 16 * (2 * li + d) + c16] = Sacc[x][d][r];
    __syncthreads();
}
constexpr int S_C = 0, S_B = 17408, S_BT = 34816, S_XT = 53248, S_XWT = 71680, S_M = 90112, S_H = 108544, S_VEC = 143360;
static_assert(S_VEC + 6 * 256 <= LDSCTL_OFF, "SSD LDS map");
__device__ __forceinline__ void ssd_chunk_item(const Args& a, LAS unsigned char* lds, int b, int g, int hp, int tid_, int wave, int lane_) {
    const bf16* proj = ws_bf(a, WS_PROJ); bf16* mixed = mixed_buf(a); float* ssqo = ws_f(a, WS_SSQ);
    const int row0 = b * SEQ, h0 = 8 * g + 2 * hp;
    LAS bf16* LC = (LAS bf16*)(lds + S_C); LAS bf16* LB = (LAS bf16*)(lds + S_B); LAS bf16* LBT = (LAS bf16*)(lds + S_BT); LAS bf16* LXT = (LAS bf16*)(lds + S_XT); LAS bf16* LXW = (LAS bf16*)(lds + S_XWT);
    LAS bf16* LM = (LAS bf16*)(lds + S_M); LAS bf16* LH = (LAS bf16*)(lds + S_H);
    LAS float* vdt = (LAS float*)(lds + S_VEC); LAS float* vacs = vdt + 128;
    const int hh = wave >> 2, wq = wave & 3;
    const float A_h = -expf(a.in[I_SALOG][h0 + (lane_ >> 5 ? 1 : 0)]);
    f32x4 hacc[8];
#pragma unroll
    for (int nt = 0; nt < 8; ++nt) hacc[nt] = (f32x4){0.f, 0.f, 0.f, 0.f};
    for (int i = tid_; i < 2 * 64 * P128 / 2; i += NT) ((LAS unsigned*)LH)[i] = 0u;
    for (int ch = 0; ch < SEQ / 64; ++ch) {
        const int t0 = 64 * ch;
        int lane = lane_;
        asm volatile("" : "+v"(lane));
        const int tid = wave * 64 + lane, c16 = lane & 15, q4 = lane >> 4, oct = tid % 48, tg = tid / 48, seg = oct >> 4, c0 = 8 * (oct & 15);
        if (tid < 384) {
            const int chb = (seg == 0 ? h0 * 64 : (seg == 1 ? 1024 + g * 128 : 1280 + g * 128)) + c0;
            v4u R[11]; const bf16* src = (proj + (size_t)(row0 + t0 - 3) * PITCH + PC_XBC) + (unsigned)(8 * tg * PITCH + chb);
#pragma unroll
            for (int i = 0; i < 11; ++i) R[i] = (t0 + 8 * tg - 3 + i >= 0) ? *(const v4u*)(src + (size_t)i * PITCH) : (v4u){0u, 0u, 0u, 0u};
            float cw[4][8], cb[8];
#pragma unroll
            for (int j = 0; j < 4; ++j) { const f32x4 w0 = *(const f32x4*)(a.in[I_SCW] + j * SSD_CONV + chb), w1 = *(const f32x4*)(a.in[I_SCW] + j * SSD_CONV + chb + 4);
                cw[j][0] = w0.x; cw[j][1] = w0.y; cw[j][2] = w0.z; cw[j][3] = w0.w; cw[j][4] = w1.x; cw[j][5] = w1.y; cw[j][6] = w1.z; cw[j][7] = w1.w; }
            { const f32x4 b0 = *(const f32x4*)(a.in[I_SCB] + chb), b1 = *(const f32x4*)(a.in[I_SCB] + chb + 4); cb[0] = b0.x; cb[1] = b0.y; cb[2] = b0.z; cb[3] = b0.w; cb[4] = b1.x; cb[5] = b1.y; cb[6] = b1.z; cb[7] = b1.w; }
            unsigned outp[8][4]; float ssq[8];
            conv8x8(R, cw, cb, outp, ssq);
            if (seg >= 1) { LAS bf16* dst = (seg == 1 ? LB : LC) + (8 * tg) * P128 + c0;
#pragma unroll
                for (int l = 0; l < 8; ++l) *(LAS v4u*)(dst + l * P128) = (v4u){outp[l][0], outp[l][1], outp[l][2], outp[l][3]}; }
            if (seg <= 1) { LAS bf16* dst = (seg == 0 ? LXT : LBT) + c0 * P64 + 8 * tg;
#pragma unroll
                for (int c = 0; c < 8; ++c) *(LAS v4u*)(dst + c * P64) = tpack(outp, c); }
        } else if (wave == 6) {
#pragma unroll
            for (int e = 0; e < 2; ++e) { const float dtv = softplus_acc(bf2f(proj[(size_t)(row0 + t0 + lane) * PITCH + PC_DT + h0 + e]) + a.in[I_SDTB][h0 + e]);
                float ac = dtv * (-expf(a.in[I_SALOG][h0 + e]));
#pragma unroll
                for (int d = 1; d < 64; d <<= 1) { const float v = sup(ac, d, lane); if (lane >= d) ac += v; }
                vdt[64 * e + lane] = dtv; vacs[64 * e + lane] = ac; }
        }
        __syncthreads();
        { const int pr = tid >> 2, l0 = 16 * (tid & 3), e = pr >> 6; const float al = vacs[64 * e + 63];
            const v4u x0 = *(const LAS v4u*)(LXT + pr * P64 + l0), x1 = *(const LAS v4u*)(LXT + pr * P64 + l0 + 8); float xf[16]; { float t8[8]; unpack8(x0, t8);
#pragma unroll
                for (int i = 0; i < 8; ++i) xf[i] = t8[i]; unpack8(x1, t8);
#pragma unroll
                for (int i = 0; i < 8; ++i) xf[8 + i] = t8[i]; }
            unsigned o[8];
#pragma unroll
            for (int i = 0; i < 8; ++i) { const int l = l0 + 2 * i; const float s0 = vdt[64 * e + l] * __expf(al - vacs[64 * e + l]), s1 = vdt[64 * e + l + 1] * __expf(al - vacs[64 * e + l + 1]); o[i] = cvtpk(xf[2 * i] * s0, xf[2 * i + 1] * s1); }
            *(LAS v4u*)(LXW + pr * P64 + l0) = (v4u){o[0], o[1], o[2], o[3]}; *(LAS v4u*)(LXW + pr * P64 + l0 + 8) = (v4u){o[4], o[5], o[6], o[7]}; }
        f32x4 yacc[4];
#pragma unroll
        for (int pt = 0; pt < 4; ++pt) yacc[pt] = (f32x4){0.f, 0.f, 0.f, 0.f};
#pragma unroll
        for (int ks = 0; ks < 4; ++ks) { const bf16x8 cf = ldfrag(LC, P128, 16 * wq, 32 * ks, lane);
#pragma unroll
            for (int pt = 0; pt < 4; ++pt) yacc[pt] = MFMA16(ldfrag(LH + hh * 64 * P128, P128, 16 * pt, 32 * ks, lane), cf, yacc[pt]); }
        for (int job = wave; job < 10; job += 8) { int ti, tj; lower_pair(job, ti, tj);
            f32x4 acc = (f32x4){0.f, 0.f, 0.f, 0.f};
#pragma unroll
            for (int ks = 0; ks < 4; ++ks) acc = MFMA16(ldfrag(LB, P128, 16 * tj, 32 * ks, lane), ldfrag(LC, P128, 16 * ti, 32 * ks, lane), acc);
            const int l = 16 * ti + c16, s0 = 16 * tj + 4 * q4;
#pragma unroll
            for (int e = 0; e < 2; ++e) { const float al = vacs[64 * e + l], Dh = a.in[I_SD][h0 + e]; const f32x4 as = *(const LAS f32x4*)(vacs + 64 * e + s0), ds = *(const LAS f32x4*)(vdt + 64 * e + s0); f32x4 val;
#pragma unroll
                for (int r = 0; r < 4; ++r) val[r] = (s0 + r <= l) ? acc[r] * ds[r] * __expf(al - as[r]) + ((s0 + r == l) ? Dh : 0.f) : 0.f;
                *(LAS u32x2*)(LM + e * 64 * P64 + l * P64 + s0) = pack4(val); } }
        if (wave >= 2 && wave < 6) { const int e = (wave - 2) >> 1, up = (wave - 2) & 1; const int l = (up ? 32 : 0) + c16, s0 = (up ? 48 : 16) + 4 * q4;
            *(LAS u32x2*)(LM + e * 64 * P64 + l * P64 + s0) = (u32x2){0u, 0u}; }
        __syncthreads();
        {
            const float ea = __expf(vacs[64 * hh + 16 * wq + c16]);
#pragma unroll
            for (int pt = 0; pt < 4; ++pt) yacc[pt] = yacc[pt] * ea;
            for (int ks = 0; ks < (wq >= 2 ? 2 : 1); ++ks) { const bf16x8 mf = ldfrag(LM + hh * 64 * P64, P64, 16 * wq, 32 * ks, lane);
#pragma unroll
                for (int pt = 0; pt < 4; ++pt) yacc[pt] = MFMA16(ldfrag(LXT + hh * 64 * P64, P64, 16 * pt, 32 * ks, lane), mf, yacc[pt]); }
            const float el = __expf(vacs[64 * hh + 63]);
#pragma unroll
            for (int nt = 0; nt < 8; ++nt) hacc[nt] = hacc[nt] * el;
#pragma unroll
            for (int ks = 0; ks < 2; ++ks) { const bf16x8 xf = ldfrag(LXW + hh * 64 * P64, P64, 16 * wq, 32 * ks, lane);
#pragma unroll
                for (int nt = 0; nt < 8; ++nt) hacc[nt] = MFMA16(ldfrag(LBT, P64, 16 * nt, 32 * ks, lane), xf, hacc[nt]); }
#pragma unroll
            for (int nt = 0; nt < 8; ++nt) *(LAS u32x2*)(LH + hh * 64 * P128 + (16 * wq + c16) * P128 + 16 * nt + 4 * q4) = pack4(hacc[nt]);
            const size_t row = (size_t)(row0 + t0 + 16 * wq + c16); float sq = 0.f;
#pragma unroll
            for (int pt = 0; pt < 4; ++pt) { const int p0 = (h0 + hh) * 64 + 16 * pt + 4 * q4; const unsigned long long zz = *(const unsigned long long*)(proj + row * PITCH + PC_Z + p0);
                const f32x4 y = yacc[pt] * (f32x4){silu_f(bf2f((unsigned)zz & 0xffffu)), silu_f(bf2f(((unsigned)zz) >> 16)), silu_f(bf2f((unsigned)(zz >> 32) & 0xffffu)), silu_f(bf2f((unsigned)(zz >> 48)))};
                *(u32x2*)(mixed + row * DMIX + p0) = pack4(y); sq += (y[0] * y[0] + y[1] * y[1]) + (y[2] * y[2] + y[3] * y[3]); }
            sq += sx<16>(sq); sq += sx32(sq, lane);
            if (q4 == 0) ssqo[row * 16 + h0 + hh] = sq;
        }
        __syncthreads();
    }
    { const int c16 = lane_ & 15, q4 = lane_ >> 4; float* so = a.out + OFF_SSD_P + ((size_t)b * SSD_H + h0 + hh) * (SSD_P * SSD_N) + (size_t)(16 * wq + c16) * SSD_N + 4 * q4;
#pragma unroll
        for (int nt = 0; nt < 8; ++nt) *(f32x4*)(so + 16 * nt) = hacc[nt]; }
    (void)A_h;
    __syncthreads();
}
constexpr int SS_XS = 0, SS_XW = 49152, SS_ZS = 81920, SS_CBF = 98304, SS_DT = 107008, SS_CUM = 107520, SS_CBM = 108032, SS_MM = 108544;
__device__ __forceinline__ void ssd_sample_item(const Args& a, LAS unsigned char* lds, int sb, int tid, int wave, int lane) {
    const bf16* proj = ws_bf(a, WS_PROJ); bf16* mixed = mixed_buf(a); float* ssqo = ws_f(a, WS_SSQ);
    const int row0 = MP + sb * LS;
    LAS float* xs = (LAS float*)(lds + SS_XS);
    LAS float* xw = (LAS float*)(lds + SS_XW);
    LAS bf16* zs = (LAS bf16*)(lds + SS_ZS);
    LAS bf16* cbf = (LAS bf16*)(lds + SS_CBF);
    LAS float* dtv = (LAS float*)(lds + SS_DT); LAS float* cum = (LAS float*)(lds + SS_CUM); LAS float* cbm = (LAS float*)(lds + SS_CBM); LAS float* mm = (LAS float*)(lds + SS_MM);
    if (tid < 384) { const int ch = 4 * tid;
        f32x4 r[11];
#pragma unroll
        for (int j = 0; j < 3; ++j) r[j] = *(const f32x4*)(a.in[I_SSDC] + ((size_t)sb * 3 + j) * SSD_CONV + ch);
#pragma unroll
        for (int t = 0; t < 8; ++t) { const u32x2 v = *(const u32x2*)(proj + (size_t)(row0 + t) * PITCH + PC_XBC + ch); r[3 + t] = (f32x4){bf2f(v.x & 0xffffu), __uint_as_float(v.x & 0xffff0000u), bf2f(v.y & 0xffffu), __uint_as_float(v.y & 0xffff0000u)}; }
        f32x4 w[4];
#pragma unroll
        for (int j = 0; j < 4; ++j) w[j] = *(const f32x4*)(a.in[I_SCW] + j * SSD_CONV + ch);
        const f32x4 bias = *(const f32x4*)(a.in[I_SCB] + ch);
#pragma unroll
        for (int t = 0; t < 8; ++t) { f32x4 acc = bias + w[0] * r[t] + w[1] * r[t + 1] + w[2] * r[t + 2] + w[3] * r[t + 3];
            acc = (f32x4){silu_f(acc.x), silu_f(acc.y), silu_f(acc.z), silu_f(acc.w)};
            *(LAS f32x4*)(xs + t * SSD_CONV + ch) = acc;
            if (ch >= 1280) { const int g = (ch - 1280) >> 7, n = (ch - 1280) & 127; *(LAS u32x2*)(cbf + (g * 16 + t) * P128 + n) = pack4(acc); *(LAS u32x2*)(cbf + (g * 16 + 8 + t) * P128 + n) = (u32x2){0u, 0u}; } }
    } else { const int i = tid - 384, t = i >> 4, h = i & 15;
        dtv[i] = softplus_acc(bf2f(proj[(size_t)(row0 + t) * PITCH + PC_DT + h]) + a.in[I_SDTB][h]); }
    for (int i = tid; i < 8 * 128; i += NT) { const int t = i >> 7, c = i & 127; *(LAS v4u*)(zs + t * 1024 + 8 * c) = *(const v4u*)(proj + (size_t)(row0 + t) * PITCH + PC_Z + 8 * c); }
    __syncthreads();
    if (tid < 16) { const float A = -expf(a.in[I_SALOG][tid]); float c = 0.f;
#pragma unroll
        for (int t = 0; t < 8; ++t) { c += dtv[t * 16 + tid] * A; cum[tid * 8 + t] = c; } }
    if (tid >= 64 && tid < 192) { const int i = tid - 64, g = i >> 6, t = (i >> 3) & 7, s = i & 7; float acc = 0.f;
        const LAS float* cp = xs + t * SSD_CONV + 1280 + g * 128; const LAS float* bp = xs + s * SSD_CONV + 1024 + g * 128;
        for (int n = 0; n < 128; n += 4) { const f32x4 c4 = *(const LAS f32x4*)(cp + n), b4 = *(const LAS f32x4*)(bp + n); acc += (c4.x * b4.x + c4.y * b4.y) + (c4.z * b4.z + c4.w * b4.w); }
        cbm[i] = acc; }
    __syncthreads();
    for (int i = tid; i < 16 * 64; i += NT) { const int h = i >> 6, t = (i >> 3) & 7, s = i & 7;
        mm[i] = (s <= t) ? cbm[(h >> 3) * 64 + t * 8 + s] * dtv[s * 16 + h] * __expf(cum[h * 8 + t] - cum[h * 8 + s]) + (s == t ? a.in[I_SD][h] : 0.f) : 0.f; }
    for (int i = tid; i < 16 * 64 * 8; i += NT) { const int h = i >> 9, p = (i >> 3) & 63, s = i & 7; xw[i] = xs[s * SSD_CONV + h * 64 + p] * dtv[s * 16 + h] * __expf(cum[h * 8 + 7] - cum[h * 8 + s]); }
    __syncthreads();
#pragma unroll 1
    for (int e = 0; e < 2; ++e) { const int h = 2 * wave + e, g = h >> 3;
        int lane_l = lane; asm volatile("" : "+v"(lane_l)); const int c16 = lane_l & 15, q4 = lane_l >> 4;
        const float* sin = a.in[I_SSD] + ((size_t)sb * SSD_H + h) * (SSD_P * SSD_N); float* sout = a.out + OFF_SSD_S + ((size_t)sb * SSD_H + h) * (SSD_P * SSD_N);
        const float D8 = __expf(cum[h * 8 + 7]);
        f32x4 G[4];
#pragma unroll
        for (int pt = 0; pt < 4; ++pt) G[pt] = (f32x4){0.f, 0.f, 0.f, 0.f};
#pragma unroll 1
        for (int ks = 0; ks < 4; ++ks) { const int n0 = 32 * ks + 8 * q4;
            const bf16x8 cf = ldfrag(cbf + g * 16 * P128, P128, 0, 32 * ks, lane_l);
            f32x4 h0[4][2];
#pragma unroll
            for (int pt = 0; pt < 4; ++pt) { const f32x4* sp = (const f32x4*)(sin + (16 * pt + c16) * SSD_N + n0); h0[pt][0] = sp[0]; h0[pt][1] = sp[1]; }
            f32x4 Bv[8][2];
#pragma unroll
            for (int s = 0; s < 8; ++s) { const LAS f32x4* bp = (const LAS f32x4*)(xs + s * SSD_CONV + 1024 + g * 128 + n0); Bv[s][0] = bp[0]; Bv[s][1] = bp[1]; }
#pragma unroll
            for (int pt = 0; pt < 4; ++pt) { const f32x4 a0 = h0[pt][0], a1 = h0[pt][1];
                const u32x2 lo = pack4(a0), hi = pack4(a1); const v4u yv = (v4u){lo.x, lo.y, hi.x, hi.y};
                G[pt] = MFMA16(cf, __builtin_bit_cast(bf16x8, yv), G[pt]);
                const LAS f32x4* wp = (const LAS f32x4*)(xw + (h * 64 + 16 * pt + c16) * 8); const f32x4 w0 = wp[0], w1 = wp[1];
                f32x4 n0v = a0 * D8, n1v = a1 * D8;
#pragma unroll
                for (int s = 0; s < 8; ++s) { const float ws = s < 4 ? w0[s] : w1[s - 4]; n0v += Bv[s][0] * ws; n1v += Bv[s][1] * ws; }
                f32x4* op = (f32x4*)(sout + (16 * pt + c16) * SSD_N + n0); op[0] = n0v; op[1] = n1v; } }
        if (q4 < 2) {
            float sq[4] = {0.f, 0.f, 0.f, 0.f};
#pragma unroll
            for (int pt = 0; pt < 4; ++pt) { const int p = 16 * pt + c16; float xv[8];
#pragma unroll
                for (int s = 0; s < 8; ++s) xv[s] = xs[s * SSD_CONV + h * 64 + p];
#pragma unroll
                for (int r = 0; r < 4; ++r) { const int t = 4 * q4 + r; float y = __expf(cum[h * 8 + t]) * G[pt][r]; const LAS f32x4* mp = (const LAS f32x4*)(mm + (h * 8 + t) * 8); const f32x4 m0 = mp[0], m1 = mp[1];
                    y += (m0.x * xv[0] + m0.y * xv[1]) + (m0.z * xv[2] + m0.w * xv[3]) + (m1.x * xv[4] + m1.y * xv[5]) + (m1.z * xv[6] + m1.w * xv[7]);
                    y *= silu_f(bf2f(zs[t * 1024 + h * 64 + p])); sq[r] += y * y;
                    mixed[(size_t)(row0 + t) * DMIX + h * 64 + p] = (bf16)(cvtpk(y, 0.f) & 0xffffu); } }
#pragma unroll
            for (int r = 0; r < 4; ++r) { float v = sq[r]; v += sx<1>(v); v += sx<2>(v); v += sx<4>(v); v += sx<8>(v); if (c16 == 0) ssqo[(size_t)(row0 + 4 * q4 + r) * 16 + h] = v; }
        }
    }
    __syncthreads();
}
constexpr int GS_HEAD = 16384, GS_SMALL = 8 * GS_HEAD, GS_SMALL_PER = 1024;
static_assert(GS_SMALL + 8 * GS_SMALL_PER <= LDSCTL_OFF, "GDN sample LDS map");
__device__ __forceinline__ void gdn_sample_item(const Args& a, LAS unsigned char* lds, int sb, int tid, int wave, int lane) {
    const bf16* proj = ws_bf(a, WS_PROJ); bf16* mixed = mixed_buf(a);
    const int row0 = MP + sb * LS;
    for (int u = tid; u < 768; u += NT) { const int ch = 4 * u, which = ch >> 10, hd = (ch & 1023) >> 7, d = ch & 127;
        f32x4 r[11];
#pragma unroll
        for (int j = 0; j < 3; ++j) r[j] = *(const f32x4*)(a.in[I_GDNC] + ((size_t)sb * 3 + j) * GDN_CONV + ch);
#pragma unroll
        for (int t = 0; t < 8; ++t) { const u32x2 v = *(const u32x2*)(proj + (size_t)(row0 + t) * PITCH + PC_QKV + ch); r[3 + t] = (f32x4){bf2f(v.x & 0xffffu), __uint_as_float(v.x & 0xffff0000u), bf2f(v.y & 0xffffu), __uint_as_float(v.y & 0xffff0000u)}; }
        f32x4 w[4];
#pragma unroll
        for (int j = 0; j < 4; ++j) w[j] = *(const f32x4*)(a.in[I_GCW] + j * GDN_CONV + ch);
        LAS float* dst = (LAS float*)(lds + hd * GS_HEAD) + (which == 0 ? 1024 : (which == 1 ? 0 : 2048)) + d;
#pragma unroll
        for (int t = 0; t < 8; ++t) { f32x4 acc = w[0] * r[t] + w[1] * r[t + 1] + w[2] * r[t + 2] + w[3] * r[t + 3];
            *(LAS f32x4*)(dst + t * 128) = (f32x4){silu_f(acc.x), silu_f(acc.y), silu_f(acc.z), silu_f(acc.w)}; } }
    __syncthreads();
    const int h = wave;
    LAS float* Lk = (LAS float*)(lds + h * GS_HEAD); LAS float* Lq = Lk + 1024; LAS float* Lv = Lk + 2048; LAS float* LW = Lk + 3072;
    LAS float* sm = (LAS float*)(lds + GS_SMALL + h * GS_SMALL_PER);
#pragma unroll 1
    for (int t = 0; t < 8; ++t) { const float k0 = Lk[t * 128 + lane], k1 = Lk[t * 128 + 64 + lane], q0 = Lq[t * 128 + lane], q1 = Lq[t * 128 + 64 + lane];
        const float rk = 1.f / sqrtf(wave_sum(k0 * k0 + k1 * k1, lane) + 1e-6f), rq = (1.f / sqrtf(wave_sum(q0 * q0 + q1 * q1, lane) + 1e-6f)) * 0.08838834764831845f;
        Lk[t * 128 + lane] = k0 * rk; Lk[t * 128 + 64 + lane] = k1 * rk; Lq[t * 128 + lane] = q0 * rq; Lq[t * 128 + 64 + lane] = q1 * rq; }
    if (lane < 8) { const size_t r = (size_t)(row0 + lane) * PITCH; const float g = -expf(a.in[I_GALOG][h]) * softplus_acc(bf2f(proj[r + PC_ALPHA + h]) + a.in[I_GDTB][h]);
        float gc = g;
#pragma unroll
        for (int d = 1; d < 8; d <<= 1) { const float v = sup(gc, d, lane); if (lane >= d) gc += v; }
        sm[128 + lane] = gc; sm[136 + lane] = 1.f / (1.f + __expf(-bf2f(proj[r + PC_BETA + h]))); }
    { const int t = lane >> 3, s = lane & 7; float kk = 0.f, qk = 0.f;
#pragma unroll 4
        for (int d = 0; d < 128; d += 4) { const f32x4 ks4 = *(const LAS f32x4*)(Lk + s * 128 + d), kt4 = *(const LAS f32x4*)(Lk + t * 128 + d), qt4 = *(const LAS f32x4*)(Lq + t * 128 + d);
            kk += (kt4.x * ks4.x + kt4.y * ks4.y) + (kt4.z * ks4.z + kt4.w * ks4.w); qk += (qt4.x * ks4.x + qt4.y * ks4.y) + (qt4.z * ks4.z + qt4.w * ks4.w); }
        const float dec = __expf(sm[128 + t] - sm[128 + s]);
        sm[lane] = (s < t) ? sm[136 + t] * kk * dec : 0.f; sm[64 + lane] = (s <= t) ? qk * dec : 0.f; }
    if (lane < 8) { sm[144 + lane] = __expf(sm[128 + 7] - sm[128 + lane]);
        float tc[8];
#pragma unroll
        for (int l = 0; l < 8; ++l) { float acc = (l == lane) ? 1.f : 0.f;
#pragma unroll
            for (int s = 0; s < l; ++s) acc -= sm[l * 8 + s] * tc[s];
            tc[l] = acc; }
        const float be = sm[136 + lane], eg = __expf(sm[128 + lane]);
#pragma unroll
        for (int l = 0; l < 8; ++l) { sm[l * 8 + lane] = tc[l] * be; sm[152 + l * 8 + lane] = tc[l] * be * eg; } }
#pragma unroll 1
    for (int hf = 0; hf < 2; ++hf) { const int d = lane + 64 * hf; float kv[8], vv[8];
#pragma unroll
        for (int s = 0; s < 8; ++s) { kv[s] = Lk[s * 128 + d]; vv[s] = Lv[s * 128 + d]; }
#pragma unroll
        for (int t = 0; t < 8; ++t) { float w = 0.f, u = 0.f;
#pragma unroll
            for (int s = 0; s <= t; ++s) { w += sm[152 + t * 8 + s] * kv[s]; u += sm[t * 8 + s] * vv[s]; }
            LW[t * 128 + d] = w; Lv[t * 128 + d] = u; Lq[t * 128 + d] *= __expf(sm[128 + t]); } }
    const int dvq = lane & 31, rg = lane >> 5;
    const float* sin = a.in[I_GDN] + ((size_t)sb * GDN_H + h) * (GDN_D * GDN_D) + 4 * dvq; float* sout = a.out + OFF_GDN_S + ((size_t)sb * GDN_H + h) * (GDN_D * GDN_D) + 4 * dvq;
    f32x4 ws[8], qs[8];
#pragma unroll
    for (int t = 0; t < 8; ++t) { ws[t] = (f32x4){0.f, 0.f, 0.f, 0.f}; qs[t] = (f32x4){0.f, 0.f, 0.f, 0.f}; }
#pragma unroll 4
    for (int i = 0; i < 64; ++i) { const int dk = 2 * i + rg; const f32x4 s4 = *(const f32x4*)(sin + (size_t)dk * GDN_D);
#pragma unroll
        for (int t = 0; t < 8; ++t) { ws[t] += s4 * LW[t * 128 + dk]; qs[t] += s4 * Lq[t * 128 + dk]; } }
#pragma unroll
    for (int t = 0; t < 8; ++t)
#pragma unroll
        for (int j = 0; j < 4; ++j) { ws[t][j] += sx32(ws[t][j], lane); qs[t][j] += sx32(qs[t][j], lane); }
    f32x4 vn[8];
#pragma unroll
    for (int t = 0; t < 8; ++t) vn[t] = *(const LAS f32x4*)(Lv + t * 128 + 4 * dvq) - ws[t];
#pragma unroll
    for (int t = 0; t < 8; ++t) { f32x4 o = qs[t];
#pragma unroll
        for (int s = 0; s <= t; ++s) o += vn[s] * sm[64 + t * 8 + s];
        float sq = (o.x * o.x + o.y * o.y) + (o.z * o.z + o.w * o.w);
        sq += sx<1>(sq); sq += sx<2>(sq); sq += sx<4>(sq); sq += sx<8>(sq); sq += sx<16>(sq);
        const float rs = 1.f / sqrtf(sq * (1.f / GDN_D) + EPS); const f32x4 w = *(const f32x4*)(a.in[I_GNW] + 4 * dvq);
        const u32x2 gg = *(const u32x2*)(proj + (size_t)(row0 + t) * PITCH + PC_GATE + h * 128 + 4 * dvq);
        const f32x4 gate = (f32x4){silu_f(bf2f(gg.x & 0xffffu)), silu_f(__uint_as_float(gg.x & 0xffff0000u)), silu_f(bf2f(gg.y & 0xffffu)), silu_f(__uint_as_float(gg.y & 0xffff0000u))};
        if (rg == 0) *(u32x2*)(mixed + (size_t)(row0 + t) * DMIX + DM + h * 128 + 4 * dvq) = pack4(o * rs * w * gate); }
#pragma unroll
    for (int t = 0; t < 8; ++t) vn[t] = vn[t] * sm[144 + t];
    const float ge = __expf(sm[128 + 7]);
#pragma unroll 4
    for (int i = 0; i < 64; ++i) { const int dk = 2 * i + rg; f32x4 s4 = *(const f32x4*)(sin + (size_t)dk * GDN_D) * ge;
#pragma unroll
        for (int t = 0; t < 8; ++t) s4 += vn[t] * Lk[t * 128 + dk];
        *(f32x4*)(sout + (size_t)dk * GDN_D) = s4; }
    __syncthreads();
}
__device__ __forceinline__ void convstate_item(const Args& a, int s, int tid) {
    const bool prompt = s < NB_P; const int L = prompt ? SEQ : LS; const int row0 = prompt ? s * SEQ : MP + (s - NB_P) * LS; const bf16* proj = ws_bf(a, WS_PROJ);
    float* o1 = a.out + (prompt ? OFF_SSDC_P + (size_t)s * 3 * SSD_CONV : OFF_SSDC_S + (size_t)(s - NB_P) * 3 * SSD_CONV);
    float* o2 = a.out + (prompt ? OFF_GDNC_P + (size_t)s * 3 * GDN_CONV : OFF_GDNC_S + (size_t)(s - NB_P) * 3 * GDN_CONV);
    for (int idx = tid; idx < 3 * SSD_CONV; idx += NT) { const int j = idx / SSD_CONV, c = idx - j * SSD_CONV; o1[idx] = bf2f(proj[(size_t)(row0 + L - 3 + j) * PITCH + PC_XBC + c]); }
    for (int idx = tid; idx < 3 * GDN_CONV; idx += NT) { const int j = idx / GDN_CONV, c = idx - j * GDN_CONV; o2[idx] = bf2f(proj[(size_t)(row0 + L - 3 + j) * PITCH + PC_QKV + c]); }
}
constexpr int Q_GP = NB_P * GDN_H, Q_SP = Q_GP + NB_P * SSD_H / 2, Q_GS = Q_SP + NB_S, Q_SS = Q_GS + NB_S, Q_ALL = Q_SS + NSEQ;
__device__ __forceinline__ void p3_mixers(const Args& a, LAS unsigned char* lds, volatile LAS unsigned* misc, int rep, int tid_, int wave, int lane_) {
    unsigned* qctr = (unsigned*)(a.ws + WS_CTL) + CW_QUEUE + 64 * rep;
    for (;;) {
        if (tid_ == 0) misc[0] = __hip_atomic_fetch_add(qctr, 1u, __ATOMIC_RELAXED, __HIP_MEMORY_SCOPE_AGENT);
        __syncthreads();
        const int it = (int)misc[0];
        __syncthreads();
        if (it >= Q_ALL) break;
        int tid = tid_, lane = lane_;
        asm volatile("" : "+v"(tid), "+v"(lane));
#ifndef PROBE_DUP
#define PROBE_DUP 0
#endif
        if (it < Q_GP) {
#pragma unroll 1
            for (int dup = 0; dup < (PROBE_DUP == 1 ? 2 : 1); ++dup) gdn_chunk_item(a, lds, it >> 3, it & 7, tid, wave, lane); }
        else if (it < Q_SP) { const int j = it - Q_GP;
#pragma unroll 1
            for (int dup = 0; dup < (PROBE_DUP == 2 ? 2 : 1); ++dup) ssd_chunk_item(a, lds, j >> 3, (j >> 2) & 1, j & 3, tid, wave, lane); }
        else if (it < Q_GS) gdn_sample_item(a, lds, it - Q_SP, tid, wave, lane);
        else if (it < Q_SS) ssd_sample_item(a, lds, it - Q_GS, tid, wave, lane);
        else convstate_item(a, it - Q_SS, tid);
    }
}
__device__ __forceinline__ void p3b_ssdnorm(const Args& a, int gw, int NGW, int lane) {
    bf16* mixed = mixed_buf(a); const float* ssq = ws_f(a, WS_SSQ); const float* nw = a.in[I_SNW] + 16 * lane;
    for (int row = gw; row < M; row += NGW) {
        const f32x4* sp = (const f32x4*)(ssq + (size_t)row * 16 + 8 * (lane >> 5)); const f32x4 s0 = sp[0], s1 = sp[1];
        const float rs = 1.f / sqrtf(((s0.x + s0.y) + (s0.z + s0.w) + (s1.x + s1.y) + (s1.z + s1.w)) * (1.f / 512.f) + EPS);
        v4u* mp = (v4u*)(mixed + (size_t)row * DMIX + 16 * lane);
#pragma unroll
        for (int q = 0; q < 2; ++q) { v4u v = mp[q]; const f32x4 w0 = *(const f32x4*)(nw + 8 * q), w1 = *(const f32x4*)(nw + 8 * q + 4);
            v.x = pk2(bf2f(v.x & 0xffffu) * rs * w0.x, bf2f(v.x >> 16) * rs * w0.y); v.y = pk2(bf2f(v.y & 0xffffu) * rs * w0.z, bf2f(v.y >> 16) * rs * w0.w);
            v.z = pk2(bf2f(v.z & 0xffffu) * rs * w1.x, bf2f(v.z >> 16) * rs * w1.y); v.w = pk2(bf2f(v.w & 0xffffu) * rs * w1.z, bf2f(v.w >> 16) * rs * w1.w);
            mp[q] = v; }
    }
}
__device__ __forceinline__ void p5_mid(const Args& a, int gw, int NGW, int lane) {
    const float* mod = ws_f(a, WS_MOD); const float* T1 = ws_f(a, WS_T1); bf16* XN2 = ws_bf(a, WS_XN2); const float* wpost = a.in[I_NMPOST]; const float* wpre = a.in[I_NFPRE];
    for (int row = gw; row < M; row += NGW) {
        const f32x4* tr = (const f32x4*)(T1 + (size_t)row * DM) + lane; const f32x4* xr = (const f32x4*)x_row(a, row) + lane; const float* mr = mod + (size_t)seq_of_row(row) * NMOD;
        f32x4 v[4]; float s = 0.f;
#pragma unroll
        for (int j = 0; j < 4; ++j) { v[j] = tr[64 * j]; s += (v[j].x * v[j].x + v[j].y * v[j].y) + (v[j].z * v[j].z + v[j].w * v[j].w); }
        const float rs = 1.f / sqrtf(wave_sum(s, lane) * (1.f / DM) + EPS);
        float s2 = 0.f; f32x4* yo = (f32x4*)(a.out + OFF_Y + (size_t)row * DM) + lane;
#pragma unroll
        for (int j = 0; j < 4; ++j) { const int c = 4 * lane + 256 * j; const f32x4 w = *(const f32x4*)(wpost + c), g1 = *(const f32x4*)(mr + 2 * DM + c);
            v[j] = xr[64 * j] + g1 * (v[j] * rs * w); yo[64 * j] = v[j]; s2 += (v[j].x * v[j].x + v[j].y * v[j].y) + (v[j].z * v[j].z + v[j].w * v[j].w); }
        const float rs2 = 1.f / sqrtf(wave_sum(s2, lane) * (1.f / DM) + EPS);
        unsigned long long* o8 = (unsigned long long*)(XN2 + (size_t)row * DM) + lane;
#pragma unroll
        for (int j = 0; j < 4; ++j) { const int c = 4 * lane + 256 * j; const f32x4 w = *(const f32x4*)(wpre + c), sh = *(const f32x4*)(mr + 3 * DM + c), sc = *(const f32x4*)(mr + 4 * DM + c);
            const f32x4 h = v[j] * rs2 * w * (sc + 1.f) + sh;
            o8[64 * j] = (unsigned long long)pk2(h.x, h.y) | ((unsigned long long)pk2(h.z, h.w) << 32); }
    }
}
__device__ __forceinline__ void p8_final(const Args& a, int gw, int NGW, int lane) {
    const float* mod = ws_f(a, WS_MOD); const float* T2 = ws_f(a, WS_T2); const float* wpost = a.in[I_NFPOST];
    for (int row = gw; row < M; row += NGW) {
        const f32x4* tr = (const f32x4*)(T2 + (size_t)row * DM) + lane; const float* mr = mod + (size_t)seq_of_row(row) * NMOD;
        f32x4 v[4]; float s = 0.f;
#pragma unroll
        for (int j = 0; j < 4; ++j) { v[j] = tr[64 * j]; s += (v[j].x * v[j].x + v[j].y * v[j].y) + (v[j].z * v[j].z + v[j].w * v[j].w); }
        const float rs = 1.f / sqrtf(wave_sum(s, lane) * (1.f / DM) + EPS);
        f32x4* yo = (f32x4*)(a.out + OFF_Y + (size_t)row * DM) + lane;
#pragma unroll
        for (int j = 0; j < 4; ++j) { const int c = 4 * lane + 256 * j; const f32x4 w = *(const f32x4*)(wpost + c), g2 = *(const f32x4*)(mr + 5 * DM + c);
            yo[64 * j] = yo[64 * j] + g2 * (v[j] * rs * w); }
    }
}
#ifndef MK_N_LAUNCHES
#define MK_N_LAUNCHES 1
#endif
constexpr int NPH = 10;
constexpr int N_LAUNCHES = MK_N_LAUNCHES;
static_assert(N_LAUNCHES == 1 || N_LAUNCHES == NPH, "MK_N_LAUNCHES is 1 or 10");
#ifndef PG8_SP2
#define PG8_SP2 true
#endif
#ifndef PG8_ALIGN
#define PG8_ALIGN true
#endif
__global__ void __launch_bounds__(NT, 2) hymba_fwd(Args args) {
    extern __shared__ __attribute__((aligned(16))) unsigned char lds_[];
    LAS unsigned char* lds = (LAS unsigned char*)lds_;
    volatile LAS unsigned* MISC = (volatile LAS unsigned*)(lds + MISC_OFF);
    const int tid0 = threadIdx.x, wave = __builtin_amdgcn_readfirstlane(tid0 >> 6);
#define PHASE_IDS int lane = (int)__builtin_amdgcn_mbcnt_hi(~0u, __builtin_amdgcn_mbcnt_lo(~0u, 0u)); asm volatile("" : "+v"(lane)); const int tid = wave * 64 + lane;
    const int G = gridDim.x, bid = blockIdx.x;
    const int gw = bid * NWAVES + wave, NGW = G * NWAVES;
    gu32* ctl = (gu32*)(args.ws + WS_CTL);
    for (int u = tid0; u < (LDS_BYTES - LDSCTL_OFF) / 4; u += NT) ((LAS unsigned*)(lds + LDSCTL_OFF))[u] = 0u;
    __syncthreads();
    XcdBarrier bar; bar.bar = (unsigned*)(ctl + CW_BAR); bar.x = 0; bar.st = nullptr;
    if (N_LAUNCHES == 1) bar = xcd_barrier_post((unsigned*)(ctl + CW_BAR), MISC + 8);
#define GRID_BAR(seam) do { if (N_LAUNCHES != 1) { if (wave == 0 && __builtin_amdgcn_mbcnt_lo(~0u, 0u) == 0u) __hip_atomic_store(ctl + CW_TMO, 0xBADBA0u | (unsigned)(seam), RLX_AGENT); } else { xcd_barrier(bar); } } while (0)
    const int lo = args.ph_lo, hi = args.ph_hi;
#define IN(k) (lo <= (k) && (k) < hi)
#ifndef PROBE_PHASE
#define PROBE_PHASE -1
#endif
#define REPS(k) for (int rep = 0; rep < ((k) == PROBE_PHASE ? 2 : 1); ++rep)
#define REP_BAR(k) do { if ((k) == PROBE_PHASE && rep == 0) GRID_BAR(k); } while (0)
#define BOTH(k) (IN(k) && IN((k) + 1))
    if (IN(0)) { REPS(0) { PHASE_IDS p0_prologue(args, lds, bid, G, tid, wave, lane); REP_BAR(0); } if (BOTH(0)) GRID_BAR(0); }
    if (IN(1)) { REPS(1) { PHASE_IDS p1_xn(args, gw, NGW, lane); REP_BAR(1); } if (BOTH(1)) GRID_BAR(1); }
    if (IN(2)) { REPS(2) {
        pg8::Gemm g{xn_buf(args), win_t(args), M, IN_PAD, DM}; pg8::StaticOrder S; S.init(M, IN_PAD, G, bid);
        pg8::EpiBf16Clip E{ws_bf(args, WS_PROJ), PITCH, IN_DIM};
        pg8::gemm_phase<pg8::EpiBf16Clip, pg8::StaticOrder, PG8_ALIGN, PG8_SP2>(lds + RING_OFF, g, S, E); REP_BAR(2); }
        if (BOTH(2)) GRID_BAR(2);
    }
    if (IN(3)) { REPS(3) { PHASE_IDS p3_mixers(args, lds, MISC, rep, tid, wave, lane); REP_BAR(3); } if (BOTH(3)) GRID_BAR(3); }
    if (IN(4)) { PHASE_IDS p3b_ssdnorm(args, gw, NGW, lane); if (BOTH(4)) GRID_BAR(4); }
    if (IN(5)) { REPS(5) {
        pg8::Gemm g{mixed_buf(args), ws_bf(args, WS_WOUT), M, DM, DMIX}; pg8::StaticOrder S; S.init(M, DM, G, bid);
        pg8::EpiF32 E{ws_f(args, WS_T1), DM};
        pg8::gemm_phase<pg8::EpiF32, pg8::StaticOrder, PG8_ALIGN, PG8_SP2>(lds + RING_OFF, g, S, E); REP_BAR(5); }
        if (BOTH(5)) GRID_BAR(5);
    }
    if (IN(6)) { REPS(6) { PHASE_IDS p5_mid(args, gw, NGW, lane); REP_BAR(6); } if (BOTH(6)) GRID_BAR(6); }
    if (IN(7)) { REPS(7) {
        pg8::Gemm g{ws_bf(args, WS_XN2), ws_bf(args, WS_WGU), M, NGU, DM}; pg8::StaticOrder S; S.init(M, NGU, G, bid);
        pg8::EpiSwiGLU E{ws_bf(args, WS_ACT), DFF};
        pg8::gemm_phase<pg8::EpiSwiGLU, pg8::StaticOrder, PG8_ALIGN, PG8_SP2>(lds + RING_OFF, g, S, E); REP_BAR(7); }
        if (BOTH(7)) GRID_BAR(7);
    }
    if (IN(8)) { REPS(8) {
        pg8::Gemm g{ws_bf(args, WS_ACT), ws_bf(args, WS_WDN), M, DM, DFF}; pg8::StaticOrder S; S.init(M, DM, G, bid);
        pg8::EpiF32 E{ws_f(args, WS_T2), DM};
        pg8::gemm_phase<pg8::EpiF32, pg8::StaticOrder, PG8_ALIGN, PG8_SP2>(lds + RING_OFF, g, S, E); REP_BAR(8); }
        if (BOTH(8)) GRID_BAR(8);
    }
    if (IN(9)) { PHASE_IDS p8_final(args, gw, NGW, lane); }
#undef IN
#undef BOTH
}
extern "C" void kernel_launch(void* const* d_in, const int* in_sizes, int n_in, void* d_out, int out_size, void* d_ws, size_t ws_size, hipStream_t stream) {
    static int grid = 0;
    if (grid == 0) {
        if (n_in != 28 || in_sizes[0] != MP * DM || (size_t)out_size != OUT_TOTAL || ws_size < WS_END) {
            fprintf(stderr, "kernel_launch: shape/workspace mismatch: n_in %d in0 %d out %d ws %zu (need %zu); nothing launched\n", n_in, n_in > 0 ? in_sizes[0] : -1, out_size, ws_size, (size_t)WS_END); grid = -1; return; }
        int dev = 0, cus = 0, per_cu = 0;
        if (hipGetDevice(&dev) != hipSuccess || hipDeviceGetAttribute(&cus, hipDeviceAttributeMultiprocessorCount, dev) != hipSuccess) { fprintf(stderr, "kernel_launch: device query failed\n"); grid = -1; return; }
        if (hipFuncSetAttribute((const void*)hymba_fwd, hipFuncAttributeMaxDynamicSharedMemorySize, LDS_BYTES) != hipSuccess) { fprintf(stderr, "kernel_launch: hipFuncSetAttribute failed\n"); grid = -1; return; }
        if (hipOccupancyMaxActiveBlocksPerMultiprocessor(&per_cu, (const void*)hymba_fwd, NT, LDS_BYTES) != hipSuccess || per_cu < 1)
            fprintf(stderr, "kernel_launch: note: occupancy query reports %d workgroups per CU\n", per_cu);
        (void)hipGetLastError();
        grid = cus;
    }
    if (grid < 0) return;
    if (hipMemsetAsync((char*)d_ws + WS_CTL, 0, CTL_ZERO_BYTES, stream) != hipSuccess) { fprintf(stderr, "kernel_launch: memset failed\n"); return; }
    Args a{};
    for (int i = 0; i < 28; ++i) a.in[i] = (const float*)d_in[i];
    a.out = (float*)d_out; a.ws = (unsigned char*)d_ws;
    for (int li = 0; li < N_LAUNCHES; ++li) {
        a.ph_lo = (N_LAUNCHES == 1) ? 0 : li; a.ph_hi = (N_LAUNCHES == 1) ? NPH : li + 1; a.li = li;
        hipLaunchKernelGGL(hymba_fwd, dim3(grid), dim3(NT), LDS_BYTES, stream, a);
        const hipError_t le = hipPeekAtLastError();
        if (le != hipSuccess) { fprintf(stderr, "kernel_launch: launch %d failed: %s\n", li, hipGetErrorName(le)); break; }
    }
}
```

```cpp
#include <hip/hip_runtime.h>
#include <cstdio>
#include <cstdint>
namespace pg8 {
#define PG8_LAS __attribute__((address_space(3)))
typedef unsigned short bf16_t;
typedef short bf16x8 __attribute__((ext_vector_type(8)));
typedef float f32x4 __attribute__((ext_vector_type(4)));
typedef unsigned u32x4 __attribute__((ext_vector_type(4)));
constexpr int BM = 256, BK = 64, HALF = 128, HTB = HALF * BK * 2  , STAGE_BYTES = 8 * HTB, NXCD = 8, WGM = 8;

__host__ __device__ __forceinline__ int lds_byte(int r, int c) { const int st = (r >> 4) * 2 + (c >> 5), rr = r & 15, cc = c & 31, ob = rr * 64 + cc * 2; return st * 1024 + (ob ^ (((ob >> 9) & 1) << 5)); }
__host__ __device__ __forceinline__ void stage_rc(int b, int& R, int& C) { const int st = b / 1024, sb = b % 1024, swz = sb ^ (((sb >> 9) & 1) << 5); R = (st >> 1) * 16 + swz / 64; C = (st & 1) * 32 + (swz % 64) / 2; }
__host__ __device__ __forceinline__ int perm32(int rho) { const int n = rho >> 4, i = rho & 15; return 8 * (i >> 2) + 4 * n + (i & 3); }

struct Unit { int pm, pn; };
struct Gemm { const bf16_t* A; const bf16_t* Bt; int M, N, K; };

struct StaticOrder {
    int nM, nN, nwg, G, c;
    __host__ __device__ void init(int M, int N, int G_, int c_) { nM = M / BM; nN = N / BM; nwg = nM * nN; G = G_; c = c_; }
    __host__ __device__ bool next(int i, Unit& u) const {
        const long L = (long)i * G + c; if (L >= nwg) return false;
        int wgid = (int)L; { const int q = nwg / NXCD, r = nwg % NXCD, xcd = wgid % NXCD, off = wgid / NXCD; wgid = (xcd < r ? xcd * (q + 1) : r * (q + 1) + (xcd - r) * q) + off; }
        const int nig = WGM * nN, gid = wgid / nig, fm = gid * WGM, gsz = (nM - fm) < WGM ? (nM - fm) : WGM;
        u.pm = fm + ((wgid % nig) % gsz); u.pn = (wgid % nig) / gsz; return true;
    }
    __device__ __forceinline__ void a_ready(const Unit&) const {}
    __device__ __forceinline__ void done(const Unit&) const {}
};

typedef float f32x2c __attribute__((ext_vector_type(2))); typedef __bf16 bf16x2c __attribute__((ext_vector_type(2)));
__device__ __forceinline__ unsigned cvt_pk_bf16(float lo, float hi) { f32x2c v = {lo, hi}; bf16x2c b = __builtin_convertvector(v, bf16x2c); return __builtin_bit_cast(unsigned, b); }
typedef float f32x2 __attribute__((ext_vector_type(2)));
__device__ __forceinline__ float silu_fast(float x) { return x * __builtin_amdgcn_rcpf(1.f + __expf(-x)); }
struct EpiBf16Clip {
    static constexpr bool PERM = true, AFTER_DRAIN = false;
    bf16_t* O; int ldc; int ncols;
    __device__ __forceinline__ void operator()(const f32x4 (&acc)[2][2][4][2], const Unit& u, int wr, int wc, int fr, int fq) const {
        const int row0 = u.pm * BM + wr * 64 + fr; const int col0 = u.pn * BM + wc * 32 + 8 * fq;
#pragma unroll
        for (int ai = 0; ai < 2; ++ai)
#pragma unroll
            for (int m = 0; m < 4; ++m) { bf16_t* rowp = O + (size_t)(row0 + ai * HALF + m * 16) * ldc + col0;
#pragma unroll
                for (int bj = 0; bj < 2; ++bj) { if (col0 + bj * HALF < ncols) { const f32x4 v0 = acc[ai][bj][m][0], v1 = acc[ai][bj][m][1];
                    u32x4 w; w.x = cvt_pk_bf16(v0[0], v0[1]); w.y = cvt_pk_bf16(v0[2], v0[3]); w.z = cvt_pk_bf16(v1[0], v1[1]); w.w = cvt_pk_bf16(v1[2], v1[3]);
                    *(u32x4*)(rowp + bj * HALF) = w; } } }
    }
};
struct EpiF32 {
    static constexpr bool PERM = false, AFTER_DRAIN = false;
    float* O; int ldc;
    __device__ __forceinline__ void operator()(const f32x4 (&acc)[2][2][4][2], const Unit& u, int wr, int wc, int fr, int fq) const {
        const int row0 = u.pm * BM + wr * 64 + fr; const int col0 = u.pn * BM + wc * 32 + 4 * fq;
#pragma unroll
        for (int ai = 0; ai < 2; ++ai)
#pragma unroll
            for (int m = 0; m < 4; ++m) { float* rowp = O + (size_t)(row0 + ai * HALF + m * 16) * ldc + col0;
#pragma unroll
                for (int bj = 0; bj < 2; ++bj)
#pragma unroll
                    for (int n = 0; n < 2; ++n) *(f32x4*)(rowp + bj * HALF + n * 16) = acc[ai][bj][m][n]; }
    }
};
struct EpiSwiGLU {
    static constexpr bool PERM = true, AFTER_DRAIN = false;
    bf16_t* O; int ldc;
    __device__ __forceinline__ void operator()(const f32x4 (&acc)[2][2][4][2], const Unit& u, int wr, int wc, int fr, int fq) const {
        const int row0 = u.pm * BM + wr * 64 + fr; const int col0 = u.pn * HALF + wc * 32 + 8 * fq;
#pragma unroll
        for (int ai = 0; ai < 2; ++ai)
#pragma unroll
            for (int m = 0; m < 4; ++m) { bf16_t* rowp = O + (size_t)(row0 + ai * HALF + m * 16) * ldc + col0;
                f32x4 v[2];
#pragma unroll
                for (int n = 0; n < 2; ++n) { const f32x4 g = acc[ai][0][m][n], up = acc[ai][1][m][n];
                    v[n] = (f32x4){silu_fast(g[0]) * up[0], silu_fast(g[1]) * up[1], silu_fast(g[2]) * up[2], silu_fast(g[3]) * up[3]}; }
                u32x4 w; w.x = cvt_pk_bf16(v[0][0], v[0][1]); w.y = cvt_pk_bf16(v[0][2], v[0][3]); w.z = cvt_pk_bf16(v[1][0], v[1][1]); w.w = cvt_pk_bf16(v[1][2], v[1][3]);
                *(u32x4*)rowp = w; }
    }
};
struct EpiF32BiasRows {
    static constexpr bool PERM = false, AFTER_DRAIN = false;
    float* O; int ldc; const float* bias; int nrows;
    __device__ __forceinline__ void operator()(const f32x4 (&acc)[2][2][4][2], const Unit& u, int wr, int wc, int fr, int fq) const {
        const int row0 = u.pm * BM + wr * 64 + fr; const int col0 = u.pn * BM + wc * 32 + 4 * fq;
#pragma unroll
        for (int ai = 0; ai < 2; ++ai)
#pragma unroll
            for (int m = 0; m < 4; ++m) { const int row = row0 + ai * HALF + m * 16; if (row < nrows) { float* rowp = O + (size_t)row * ldc + col0;
#pragma unroll
                for (int bj = 0; bj < 2; ++bj)
#pragma unroll
                    for (int n = 0; n < 2; ++n) *(f32x4*)(rowp + bj * HALF + n * 16) = acc[ai][bj][m][n] + *(const f32x4*)(bias + col0 + bj * HALF + n * 16); } }
    }
};
template <class Epi, class Sched, bool ALIGN_EPI = false, bool SP2 = false>
__device__ __forceinline__ void gemm_phase(PG8_LAS unsigned char* lds, const Gemm g, const Sched& S, const Epi& E) {
    const int tid = threadIdx.x, wid = __builtin_amdgcn_readfirstlane(tid >> 6), lane = tid & 63, wr = wid >> 2, wc = wid & 3, fr = lane & 15, fq = lane >> 4;
    const int K = g.K, nt = K / BK;
    unsigned voffA[2], voffB[2];
#pragma unroll
    for (int i = 0; i < 2; ++i) { int R, C; stage_rc(tid * 16 + i * 8192, R, C); const int Rb = Epi::PERM ? ((R & ~31) + perm32(R & 31)) : R;
        voffA[i] = (unsigned)(R * K + C) * 2u; voffB[i] = (unsigned)(Rb * K + C) * 2u; }
    const size_t kstep = (size_t)(BK * 2);
    const size_t hstep = (size_t)HALF * K * 2;
    const size_t tstep = 2 * hstep;
    const unsigned ldsw = (unsigned)wid * 1024u;
    const int aoff = lds_byte(wr * 64 + fr, fq * 8), boff = lds_byte(wc * 32 + fr, fq * 8);
#define PG8_SA(b, h) (((b) * 2 + (h)) * HTB)
#define PG8_SB(b, h) ((4 + (b) * 2 + (h)) * HTB)
#define PG8_STAGE(bufoff, gbase, voff) do { _Pragma("unroll") for (int _i = 0; _i < 2; ++_i) \
        __builtin_amdgcn_global_load_lds((const unsigned*)((const char*)(gbase) + (voff)[_i]), (PG8_LAS unsigned*)(lds + (bufoff) + ldsw + _i * 8192), 16, 0, 0); } while (0)
#define PG8_LDA(dst, b, h) do { _Pragma("unroll") for (int m = 0; m < 4; ++m) _Pragma("unroll") for (int k = 0; k < 2; ++k) dst[m][k] = *(const PG8_LAS bf16x8*)(lds + PG8_SA(b, h) + aoff + m * 2048 + k * 1024); } while (0)
#define PG8_LDB(dst, b, h) do { _Pragma("unroll") for (int n = 0; n < 2; ++n) _Pragma("unroll") for (int k = 0; k < 2; ++k) dst[n][k] = *(const PG8_LAS bf16x8*)(lds + PG8_SB(b, h) + boff + n * 2048 + k * 1024); } while (0)
#define PG8_MMA(ai, bj, At, Bt) do { __builtin_amdgcn_s_setprio(1); _Pragma("unroll") for (int m = 0; m < 4; ++m) _Pragma("unroll") for (int n = 0; n < 2; ++n) _Pragma("unroll") for (int k = 0; k < 2; ++k) \
        acc[ai][bj][m][n] = __builtin_amdgcn_mfma_f32_16x16x32_bf16(Bt[n][k], At[m][k], acc[ai][bj][m][n], 0, 0, 0); __builtin_amdgcn_s_setprio(0); } while (0)
#define PG8_WAIT_V(n) asm volatile("s_waitcnt vmcnt(" #n ")" ::: "memory")
#define PG8_WAIT_L(n) asm volatile("s_waitcnt lgkmcnt(" #n ")" ::: "memory")
#define PG8_BAR __builtin_amdgcn_s_barrier()
#define PG8_SCHED __builtin_amdgcn_sched_barrier(0)
    Unit cur, nxt; int ui = 0;
    if (!S.next(0, cur)) return;
    f32x4 acc[2][2][4][2];
#pragma unroll
    for (int a = 0; a < 2; ++a)
#pragma unroll
        for (int b = 0; b < 2; ++b)
#pragma unroll
            for (int m = 0; m < 4; ++m)
#pragma unroll
                for (int n = 0; n < 2; ++n) acc[a][b][m][n] = (f32x4){0.f, 0.f, 0.f, 0.f};
    bf16x8 At[4][2], B0[2][2], B1[2][2];
    const char* cA = (const char*)g.A + (size_t)cur.pm * tstep; const char* cB = (const char*)g.Bt + (size_t)cur.pn * tstep;
    S.a_ready(cur);
    if constexpr (SP2) {
        PG8_STAGE(PG8_SB(0, 0), cB, voffB); PG8_STAGE(PG8_SB(0, 1), cB + hstep, voffB); PG8_STAGE(PG8_SA(0, 0), cA, voffA); PG8_STAGE(PG8_SA(0, 1), cA + hstep, voffA);
        if (wr == 1) PG8_BAR;
        PG8_WAIT_V(2); PG8_BAR;
        PG8_STAGE(PG8_SB(1, 0), cB + kstep, voffB); PG8_STAGE(PG8_SA(1, 0), cA + kstep, voffA); PG8_STAGE(PG8_SB(1, 1), cB + hstep + kstep, voffB);
        PG8_WAIT_V(6); PG8_BAR;
    } else {
        PG8_STAGE(PG8_SB(0, 0), cB, voffB); PG8_STAGE(PG8_SA(0, 0), cA, voffA); PG8_STAGE(PG8_SB(0, 1), cB + hstep, voffB); PG8_STAGE(PG8_SA(0, 1), cA + hstep, voffA);
        if (wr == 1) PG8_BAR;
        PG8_WAIT_V(4); PG8_BAR;
        PG8_STAGE(PG8_SB(1, 0), cB + kstep, voffB); PG8_STAGE(PG8_SA(1, 0), cA + kstep, voffA); PG8_STAGE(PG8_SB(1, 1), cB + hstep + kstep, voffB);
        PG8_WAIT_V(6); PG8_BAR;
    }
    for (;;) {
        const bool has_next = S.next(ui + 1, nxt);
        const char* nA = has_next ? (const char*)g.A + (size_t)nxt.pm * tstep : cA; const char* nB = has_next ? (const char*)g.Bt + (size_t)nxt.pn * tstep : cB;
        for (int t = 0; t < nt; t += 2) {
            const bool last = (t == nt - 2);
            const char* a1 = cA + (size_t)(t + 1) * kstep;
            const char* a2 = last ? nA : cA + (size_t)(t + 2) * kstep; const char* b2 = last ? nB : cB + (size_t)(t + 2) * kstep;
            const char* a3 = a2 + kstep; const char* b3 = b2 + kstep;
            if (last && has_next) S.a_ready(nxt);
            if constexpr (SP2) {
            PG8_LDB(B0, 0, 0); PG8_LDB(B1, 0, 1); PG8_SCHED; PG8_LDA(At, 0, 0); PG8_STAGE(PG8_SA(1, 1), a1 + hstep, voffA);
            PG8_WAIT_V(8); PG8_WAIT_L(0); PG8_BAR; PG8_MMA(0, 0, At, B0); PG8_MMA(0, 1, At, B1); PG8_BAR; PG8_SCHED;
            PG8_LDA(At, 0, 1); PG8_STAGE(PG8_SB(0, 0), b2, voffB); PG8_STAGE(PG8_SB(0, 1), b2 + hstep, voffB); PG8_STAGE(PG8_SA(0, 0), a2, voffA);
            PG8_WAIT_V(8); PG8_WAIT_L(0); PG8_BAR; PG8_MMA(1, 0, At, B0); PG8_MMA(1, 1, At, B1); PG8_BAR; PG8_SCHED;
            PG8_LDB(B0, 1, 0); PG8_LDB(B1, 1, 1); PG8_SCHED; PG8_LDA(At, 1, 0); PG8_STAGE(PG8_SA(0, 1), a2 + hstep, voffA);
            PG8_WAIT_V(8); PG8_WAIT_L(0); PG8_BAR; PG8_MMA(0, 0, At, B0); PG8_MMA(0, 1, At, B1); PG8_BAR; PG8_SCHED;
            PG8_LDA(At, 1, 1); PG8_STAGE(PG8_SB(1, 0), b3, voffB); PG8_STAGE(PG8_SB(1, 1), b3 + hstep, voffB); PG8_STAGE(PG8_SA(1, 0), a3, voffA);
            PG8_WAIT_V(8); PG8_WAIT_L(0); PG8_BAR; PG8_MMA(1, 0, At, B0); PG8_MMA(1, 1, At, B1); PG8_BAR; PG8_SCHED;
            } else {
            PG8_LDB(B0, 0, 0); PG8_SCHED; PG8_LDA(At, 0, 0); PG8_STAGE(PG8_SA(1, 1), a1 + hstep, voffA);
            PG8_WAIT_L(8); PG8_BAR; PG8_WAIT_L(0); PG8_MMA(0, 0, At, B0); PG8_BAR; PG8_SCHED;
            PG8_LDB(B1, 0, 1); PG8_STAGE(PG8_SB(0, 0), b2, voffB);
            PG8_BAR; PG8_WAIT_L(0); PG8_MMA(0, 1, At, B1); PG8_BAR;
            PG8_LDA(At, 0, 1); PG8_STAGE(PG8_SA(0, 0), a2, voffA);
            PG8_BAR; PG8_WAIT_L(0); PG8_MMA(1, 0, At, B0); PG8_BAR; PG8_SCHED;
            PG8_STAGE(PG8_SB(0, 1), b2 + hstep, voffB);
            PG8_WAIT_V(6); PG8_BAR; PG8_MMA(1, 1, At, B1); PG8_BAR;
            PG8_LDB(B0, 1, 0); PG8_SCHED; PG8_LDA(At, 1, 0); PG8_STAGE(PG8_SA(0, 1), a2 + hstep, voffA);
            PG8_WAIT_L(8); PG8_BAR; PG8_WAIT_L(0); PG8_MMA(0, 0, At, B0); PG8_BAR; PG8_SCHED;
            PG8_LDB(B1, 1, 1); PG8_STAGE(PG8_SB(1, 0), b3, voffB);
            PG8_BAR; PG8_WAIT_L(0); PG8_MMA(0, 1, At, B1); PG8_BAR;
            PG8_LDA(At, 1, 1); PG8_STAGE(PG8_SA(1, 0), a3, voffA);
            PG8_BAR; PG8_WAIT_L(0); PG8_MMA(1, 0, At, B0); PG8_BAR; PG8_SCHED;
            PG8_STAGE(PG8_SB(1, 1), b3 + hstep, voffB);
            PG8_WAIT_V(6); PG8_BAR; PG8_MMA(1, 1, At, B1); PG8_BAR;
            }
        }
        if constexpr (ALIGN_EPI) { if (wr == 0) PG8_BAR; }
        if constexpr (!Epi::AFTER_DRAIN) { E(acc, cur, wr, wc, fr, fq); S.done(cur); }
        if (!has_next) break;
#pragma unroll
        for (int a = 0; a < 2; ++a)
#pragma unroll
            for (int b = 0; b < 2; ++b)
#pragma unroll
                for (int m = 0; m < 4; ++m)
#pragma unroll
                    for (int n = 0; n < 2; ++n) acc[a][b][m][n] = (f32x4){0.f, 0.f, 0.f, 0.f};
        cur = nxt; cA = nA; cB = nB; ++ui;
        if constexpr (ALIGN_EPI) { if (wr == 1) PG8_BAR; }
    }
    PG8_WAIT_V(0);
    if constexpr (!ALIGN_EPI) { if (wr == 0) PG8_BAR; }
    PG8_BAR;
    if constexpr (Epi::AFTER_DRAIN) { E.fused(acc, cur, wr, wc, fr, fq, lds, wid, lane); S.done(cur); }
#undef PG8_SA
#undef PG8_SB
#undef PG8_STAGE
#undef PG8_LDA
#undef PG8_LDB
#undef PG8_MMA
#undef PG8_WAIT_V
#undef PG8_WAIT_L
#undef PG8_BAR
#undef PG8_SCHED
}
}
#define GAS __attribute__((address_space(1)))
#define LAS __attribute__((address_space(3)))
typedef unsigned short bf16;
typedef unsigned v4u __attribute__((ext_vector_type(4)));
typedef float f32x4 __attribute__((ext_vector_type(4)));
typedef short bf16x8 __attribute__((ext_vector_type(8)));
typedef GAS unsigned gu32;
typedef GAS unsigned long long gu64;
#define RLX_AGENT __ATOMIC_RELAXED, __HIP_MEMORY_SCOPE_AGENT
#define LDS_WAIT() asm volatile("s_waitcnt lgkmcnt(0)" ::: "memory")
#define VM_WAIT() asm volatile("s_waitcnt vmcnt(0)" ::: "memory")
__device__ __forceinline__ unsigned long long rt() { return __builtin_amdgcn_s_memrealtime(); }
__device__ __forceinline__ unsigned f2bf(float f) { unsigned u = __builtin_bit_cast(unsigned, f); return (u + 0x7fffu + ((u >> 16) & 1u)) >> 16; }
__device__ __forceinline__ unsigned pk2(float lo, float hi) { return f2bf(lo) | (f2bf(hi) << 16); }

#define XB_TMO      128
#define XB_XCNT(j)  (256  + 64 * (j))
#define XB_XSUB(j)  (1280 + 64 * (j))
#define XB_XGEN(j)  (2304 + 64 * (j))
#define XB_TOP      3328
#define XB_TOPGEN   3392
#define XCD_BAR_WORDS 3456
#define XB_SPIN_CAP (1u << 18)

__device__ __forceinline__ unsigned xb_ld(unsigned* p)              { return __hip_atomic_load(p, __ATOMIC_RELAXED, __HIP_MEMORY_SCOPE_AGENT); }
__device__ __forceinline__ unsigned xb_add(unsigned* p, unsigned v) { return __hip_atomic_fetch_add(p, v, __ATOMIC_RELAXED, __HIP_MEMORY_SCOPE_AGENT); }
__device__ __forceinline__ unsigned xb_xcc_id() { return (unsigned)__builtin_amdgcn_s_getreg((3 << 11) | 20) & 0xFu; }
#define XB_SPIN(cond, bar) do { unsigned _sp = 0; while (cond) { __builtin_amdgcn_s_sleep(1); \
    if ((++_sp & 255u) == 0u) { if (xb_ld(&(bar)[XB_TMO])) break; if (_sp > XB_SPIN_CAP) { atomicAdd(&(bar)[XB_TMO], 1u); break; } } } } while (0)

struct XcdBarrier {
    unsigned* bar; unsigned x;
    volatile LAS unsigned* st;
};

__device__ __forceinline__ XcdBarrier xcd_barrier_post(unsigned* bar, volatile LAS unsigned* st) {
    XcdBarrier b; b.bar = bar; b.x = xb_xcc_id(); b.st = st;
    if (threadIdx.x == 0) (void)xb_add(&bar[XB_XCNT(b.x)], 1u);
    return b;
}
__device__ __forceinline__ void xcd_barrier_complete(unsigned* bar, unsigned x, unsigned& nloc, unsigned& nx) {
    const unsigned G = gridDim.x * gridDim.y * gridDim.z;
    unsigned sum, cnt, mine, sp = 0u;
    for (;;) {
        sum = 0u; cnt = 0u; mine = 0u;
#pragma unroll
        for (unsigned j = 0; j < 16; ++j) { const unsigned c = xb_ld(&bar[XB_XCNT(j)]); sum += c; cnt += (c > 0u) ? 1u : 0u; mine = (j == x) ? c : mine; }
        if (sum == G) break;
        __builtin_amdgcn_s_sleep(1);
        if ((++sp & 255u) == 0u) { if (xb_ld(&bar[XB_TMO])) break; if (sp > XB_SPIN_CAP) { atomicAdd(&bar[XB_TMO], 1u); break; } }
    }
    nloc = mine > 0u ? mine : 1u; nx = cnt > 0u ? cnt : 1u;
}

__device__ __forceinline__ void xcd_barrier(const XcdBarrier& b) {
    asm volatile("s_waitcnt vmcnt(0)" ::: "memory");
    __syncthreads();
    if (threadIdx.x == 0) {
        unsigned* bar = b.bar;
        __builtin_amdgcn_s_waitcnt(0);
        unsigned nloc = b.st[0], nx = b.st[1];
        if (nloc == 0u) { xcd_barrier_complete(bar, b.x, nloc, nx); b.st[0] = nloc; b.st[1] = nx; }
        const unsigned old = xb_add(&bar[XB_XSUB(b.x)], 1u);
        const unsigned gen = old / nloc;
        if (old + 1u == (gen + 1u) * nloc) {
            __builtin_amdgcn_fence(__ATOMIC_RELEASE, "agent");
            asm volatile("s_waitcnt vmcnt(0)" ::: "memory");
            const unsigned og = xb_add(&bar[XB_TOP], 1u);
            const unsigned tg = og / nx;
            if (og + 1u == (tg + 1u) * nx) xb_add(&bar[XB_TOPGEN], 1u);
            else XB_SPIN(xb_ld(&bar[XB_TOPGEN]) == tg, bar);
            __builtin_amdgcn_fence(__ATOMIC_ACQUIRE, "agent");
            xb_add(&bar[XB_XGEN(b.x)], 1u);
            asm volatile("s_waitcnt vmcnt(0)" ::: "memory");
        } else {
            XB_SPIN(xb_ld(&bar[XB_XGEN(b.x)]) == gen, bar);
            __builtin_amdgcn_fence(__ATOMIC_ACQUIRE, "agent");
            asm volatile("s_waitcnt vmcnt(0)" ::: "memory");
        }
    }
    __syncthreads();
}
constexpr int NWAVES = 8, NT = NWAVES * 64;
constexpr int DM = 1024, NB_P = 8, SEQ = 2048, NB_S = 128, LS = 8;
constexpr int MP = NB_P * SEQ, MS = NB_S * LS, M = MP + MS;
constexpr int NSEQ = NB_P + NB_S;
constexpr int IN_DIM = 6688, IN_PAD = 6912, PITCH = IN_DIM;
constexpr int PC_Z = 0, PC_XBC = 1024, PC_QKV = 2560, PC_GATE = 5632, PC_DT = 6656, PC_BETA = 6672, PC_ALPHA = 6680;
constexpr int DMIX = 2048, DFF = 2816, NGU = 2 * DFF, NMOD = 6 * DM;
constexpr int SSD_H = 16, SSD_P = 64, SSD_N = 128, SSD_CONV = 1536, GDN_H = 8, GDN_D = 128, GDN_CONV = 3072;
constexpr float EPS = 1e-6f;
constexpr size_t OFF_Y = 0, OFF_SSD_P = (size_t)M * DM, OFF_SSDC_P = OFF_SSD_P + (size_t)NB_P * SSD_H * SSD_P * SSD_N, OFF_GDN_P = OFF_SSDC_P + (size_t)NB_P * 3 * SSD_CONV,
                 OFF_GDNC_P = OFF_GDN_P + (size_t)NB_P * GDN_H * GDN_D * GDN_D, OFF_SSD_S = OFF_GDNC_P + (size_t)NB_P * 3 * GDN_CONV, OFF_SSDC_S = OFF_SSD_S + (size_t)NB_S * SSD_H * SSD_P * SSD_N,
                 OFF_GDN_S = OFF_SSDC_S + (size_t)NB_S * 3 * SSD_CONV, OFF_GDNC_S = OFF_GDN_S + (size_t)NB_S * GDN_H * GDN_D * GDN_D, OUT_TOTAL = OFF_GDNC_S + (size_t)NB_S * 3 * GDN_CONV;
static_assert(OUT_TOTAL == 55357440, "output size");
constexpr size_t MiB = 1u << 20;
constexpr size_t WS_CTL = 0, CTL_ZERO_BYTES = 1 * MiB;
constexpr size_t WS_WOUT = 1 * MiB, WS_WGU = 5 * MiB, WS_WDN = 16 * MiB, WS_MOD = 22 * MiB, WS_SSQ = 26 * MiB, WS_PROJ = 28 * MiB;
constexpr size_t PROJ_BYTES = (size_t)M * PITCH * 2;
constexpr size_t WS_T1 = WS_PROJ, WS_XN2 = WS_PROJ + 68 * MiB, WS_ACT = WS_PROJ + 102 * MiB, WS_T2 = WS_PROJ;
constexpr size_t WS_END = 251 * MiB;
static_assert(WS_WOUT + (size_t)DM * DMIX * 2 <= WS_WGU && WS_WGU + (size_t)NGU * DM * 2 <= WS_WDN && WS_WDN + (size_t)DM * DFF * 2 <= WS_MOD && WS_MOD + (size_t)NSEQ * NMOD * 4 <= WS_SSQ && WS_SSQ + (size_t)M * 16 * 4 <= WS_PROJ, "ws map");
static_assert(WS_PROJ + PROJ_BYTES <= WS_END && (size_t)M * DM * 4 <= 68 * MiB && (size_t)M * DM * 2 <= 34 * MiB && WS_ACT + (size_t)M * DFF * 2 <= WS_PROJ + PROJ_BYTES, "ws overlays");
static_assert((size_t)IN_PAD * DM * 2 <= (size_t)NB_S * SSD_H * SSD_P * SSD_N * 4 && (size_t)M * DM * 2 <= (size_t)NB_S * GDN_H * GDN_D * GDN_D * 4 && (size_t)M * DMIX * 2 == (size_t)M * DM * 4, "d_out scratch");
constexpr int CW_TMO = 0, CW_CODE = 1, CW_QUEUE = 64, CW_BAR = 4096;
constexpr int RING_OFF = 0, RING_BYTES = 131072, LDS_BYTES = 163840, LDSCTL_OFF = LDS_BYTES - 1024, MISC_OFF = LDSCTL_OFF + 320;
struct Args { const float* in[28]; float* out; unsigned char* ws; int ph_lo, ph_hi, li, pad; };
enum { I_XP = 0, I_XS, I_CP, I_CS, I_SSD, I_SSDC, I_GDN, I_GDNC, I_WADA, I_BADA, I_NMPRE, I_NMPOST, I_NFPRE, I_NFPOST, I_WIN, I_SCW, I_SCB, I_SDTB, I_SALOG, I_SD, I_SNW, I_GCW, I_GDTB, I_GALOG, I_GNW, I_WOUT, I_WGU, I_WDN };
__device__ __forceinline__ float bf2f(unsigned v) { return __uint_as_float(v << 16); }
__device__ __forceinline__ float silu_acc(float x) { return x / (1.f + expf(-x)); }
__device__ __forceinline__ float softplus_acc(float x) { const float e = __expf(-fabsf(x)); const float l = (e < 0.03125f) ? e * (1.f - e * (0.5f - e * (0.33333334f - 0.25f * e))) : __logf(1.f + e); return fmaxf(x, 0.f) + l; }
template <int MASK> __device__ __forceinline__ float sx(float v) { return __int_as_float(__builtin_amdgcn_ds_swizzle(__float_as_int(v), 0x1f | (MASK << 10))); }
__device__ __forceinline__ float sx32(float v, int lane) { return __int_as_float(__builtin_amdgcn_ds_bpermute((lane ^ 32) << 2, __float_as_int(v))); }
__device__ __forceinline__ float sup(float v, int d, int lane) { return __int_as_float(__builtin_amdgcn_ds_bpermute((lane - d) << 2, __float_as_int(v))); }
__device__ __forceinline__ float wave_sum(float v, int lane) { v += sx<1>(v); v += sx<2>(v); v += sx<4>(v); v += sx<8>(v); v += sx<16>(v); v += sx32(v, lane); return v; }
__device__ __forceinline__ bf16* ws_bf(const Args& a, size_t off) { return (bf16*)(a.ws + off); }
__device__ __forceinline__ float* ws_f(const Args& a, size_t off) { return (float*)(a.ws + off); }
__device__ __forceinline__ bf16* win_t(const Args& a) { return (bf16*)(a.out + OFF_SSD_S); }
__device__ __forceinline__ bf16* xn_buf(const Args& a) { return (bf16*)(a.out + OFF_GDN_S); }
__device__ __forceinline__ bf16* mixed_buf(const Args& a) { return (bf16*)(a.out + OFF_Y); }
__device__ __forceinline__ const float* x_row(const Args& a, int row) { return row < MP ? a.in[I_XP] + (size_t)row * DM : a.in[I_XS] + (size_t)(row - MP) * DM; }
__device__ __forceinline__ int seq_of_row(int row) { return row < MP ? (row >> 11) : NB_P + ((row - MP) >> 3); }

__device__ __forceinline__ int dest_row(int which, int n) {
    if (which == 1) { if (n < 2560) return n; if (n < 2576) return PC_DT + (n - 2560); if (n < 6672) return n - 16; return n; }
    if (which == 2) { const int j = n < DFF ? n : n - DFF; return 256 * (j >> 7) + (n < DFF ? 0 : 128) + (j & 127); }
    return n;
}
__device__ __forceinline__ void p0_transpose_item(const float* W, int K, int N, bf16* WT, int which, LAS float* scr, int item, int lane) {
    const int nblk = N / 32, kb = item / nblk, nb = item % nblk, k0 = 64 * kb, n0 = 32 * nb;
#pragma unroll 8
    for (int i = 0; i < 32; ++i) { const int kk = 2 * i + (lane >> 5); scr[kk * 33 + (lane & 31)] = W[(size_t)(k0 + kk) * N + n0 + (lane & 31)]; }
    LDS_WAIT(); asm volatile("" ::: "memory");
    const int c = lane & 7;
#pragma unroll
    for (int j = 0; j < 4; ++j) { const int n = (lane >> 3) + 8 * j; const LAS float* s = scr + (8 * c) * 33 + n;
        v4u o; o.x = pk2(s[0 * 33], s[1 * 33]); o.y = pk2(s[2 * 33], s[3 * 33]); o.z = pk2(s[4 * 33], s[5 * 33]); o.w = pk2(s[6 * 33], s[7 * 33]);
        *(GAS v4u*)(WT + (size_t)dest_row(which, n0 + n) * K + k0 + 8 * c) = o; }
    LDS_WAIT(); asm volatile("" ::: "memory");
}
constexpr int TI_IN = (DM / 64) * (IN_DIM / 32), TI_OUT = (DMIX / 64) * (DM / 32), TI_GU = (DM / 64) * (NGU / 32), TI_DN = (DFF / 64) * (DM / 32), TI_PAD = IN_PAD - IN_DIM, TI_ADA = (DM / 64) * (NMOD / 32), TI_SC = 256;
constexpr int TI_A = TI_IN + TI_PAD + TI_ADA + TI_SC, TI_B = TI_OUT + TI_GU + TI_DN;
constexpr int ADA_UNITS = NMOD / 256;
static_assert(IN_DIM % 32 == 0 && NGU % 32 == 0 && DFF % 64 == 0, "P0 tiling");
__device__ __forceinline__ bf16* wada_t(const Args& a) { return (bf16*)((unsigned char*)(a.out + OFF_SSD_S) + 16 * MiB); }
__device__ __forceinline__ bf16* sc_buf(const Args& a) { return (bf16*)((unsigned char*)(a.out + OFF_SSD_S) + 32 * MiB); }
__device__ __forceinline__ void p0a_prologue(const Args& a, LAS unsigned char* lds, int gw, int NGW, int wave, int lane) {
    LAS float* scr = (LAS float*)(lds + wave * 16384);
    for (int it = gw; it < TI_A; it += NGW) {
        int r = it;
        if (r < TI_IN) { p0_transpose_item(a.in[I_WIN], DM, IN_DIM, win_t(a), 1, scr, r, lane); continue; } r -= TI_IN;
        if (r < TI_PAD) { GAS v4u* o = (GAS v4u*)(win_t(a) + (size_t)(IN_DIM + r) * DM) + lane; o[0] = (v4u){0u, 0u, 0u, 0u}; o[64] = (v4u){0u, 0u, 0u, 0u}; continue; } r -= TI_PAD;
        if (r < TI_ADA) { p0_transpose_item(a.in[I_WADA], DM, NMOD, wada_t(a), 0, scr, r, lane); continue; } r -= TI_ADA;
        { unsigned long long* o8 = (unsigned long long*)(sc_buf(a) + (size_t)r * DM) + lane;
            if (r < NSEQ) { const f32x4* cr = (const f32x4*)(r < NB_P ? a.in[I_CP] + (size_t)r * DM : a.in[I_CS] + (size_t)(r - NB_P) * DM) + lane;
#pragma unroll
                for (int j = 0; j < 4; ++j) { const f32x4 c = cr[64 * j]; o8[64 * j] = (unsigned long long)pk2(silu_acc(c.x), silu_acc(c.y)) | ((unsigned long long)pk2(silu_acc(c.z), silu_acc(c.w)) << 32); } }
            else {
#pragma unroll
                for (int j = 0; j < 4; ++j) o8[64 * j] = 0ull; } }
    }
}
__device__ __forceinline__ void p0b_transposes(const Args& a, LAS unsigned char* lds, int gw, int NGW, int wave, int lane) {
    LAS float* scr = (LAS float*)(lds + wave * 16384);
    for (int it = gw; it < TI_B; it += NGW) {
        int r = it;
        if (r < TI_OUT) { p0_transpose_item(a.in[I_WOUT], DMIX, DM, ws_bf(a, WS_WOUT), 0, scr, r, lane); continue; } r -= TI_OUT;
        if (r < TI_GU) { p0_transpose_item(a.in[I_WGU], DM, NGU, ws_bf(a, WS_WGU), 2, scr, r, lane); continue; } r -= TI_GU;
        p0_transpose_item(a.in[I_WDN], DFF, DM, ws_bf(a, WS_WDN), 0, scr, r, lane);
    }
}
__device__ __forceinline__ void p1_xn(const Args& a, int gw, int NGW, int lane) {
    const float* mod = ws_f(a, WS_MOD); bf16* XN = xn_buf(a); const float* nw = a.in[I_NMPRE];
    for (int row = gw; row < M; row += NGW) {
        const f32x4* xr = (const f32x4*)x_row(a, row) + lane; const float* mr = mod + (size_t)seq_of_row(row) * NMOD;
        f32x4 v[4]; float s = 0.f;
#pragma unroll
        for (int j = 0; j < 4; ++j) { v[j] = xr[64 * j]; s += (v[j].x * v[j].x + v[j].y * v[j].y) + (v[j].z * v[j].z + v[j].w * v[j].w); }
        const float rs = 1.f / sqrtf(wave_sum(s, lane) * (1.f / DM) + EPS);
        unsigned long long* o8 = (unsigned long long*)(XN + (size_t)row * DM) + lane;
#pragma unroll
        for (int j = 0; j < 4; ++j) { const int c = 4 * lane + 256 * j; const f32x4 w = *(const f32x4*)(nw + c), sh = *(const f32x4*)(mr + c), sc = *(const f32x4*)(mr + DM + c);
            const f32x4 h = v[j] * rs * w * (sc + 1.f) + sh;
            o8[64 * j] = (unsigned long long)pk2(h.x, h.y) | ((unsigned long long)pk2(h.z, h.w) << 32); }
    }
}
typedef short bf16x8 __attribute__((ext_vector_type(8)));
typedef unsigned u32x2 __attribute__((ext_vector_type(2)));
constexpr int P128 = 136, P64 = 72, LP = 68, TP = 36;
#define MFMA16(a, b, c) __builtin_amdgcn_mfma_f32_16x16x32_bf16(a, b, c, 0, 0, 0)
__device__ __forceinline__ bf16x8 ldfrag(const LAS bf16* base, int pitch, int row0, int k0, int lane) { return *(const LAS bf16x8*)(base + (row0 + (lane & 15)) * pitch + k0 + 8 * (lane >> 4)); }
typedef float f32x2_t __attribute__((ext_vector_type(2))); typedef __bf16 bf16x2_t __attribute__((ext_vector_type(2)));
__device__ __forceinline__ unsigned cvtpk(float lo, float hi) { f32x2_t v = {lo, hi}; bf16x2_t b = __builtin_convertvector(v, bf16x2_t); return __builtin_bit_cast(unsigned, b); }
__device__ __forceinline__ u32x2 pack4(f32x4 v) { u32x2 r; r.x = cvtpk(v[0], v[1]); r.y = cvtpk(v[2], v[3]); return r; }
__device__ __forceinline__ float silu_f(float x) { return x * __builtin_amdgcn_rcpf(1.f + __expf(-x)); }
__device__ __forceinline__ void unpack8(v4u r, float (&x)[8]) { x[0] = bf2f(r.x & 0xffffu); x[1] = __uint_as_float(r.x & 0xffff0000u); x[2] = bf2f(r.y & 0xffffu); x[3] = __uint_as_float(r.y & 0xffff0000u);
    x[4] = bf2f(r.z & 0xffffu); x[5] = __uint_as_float(r.z & 0xffff0000u); x[6] = bf2f(r.w & 0xffffu); x[7] = __uint_as_float(r.w & 0xffff0000u); }
__device__ __forceinline__ v4u tpack(const unsigned (&outp)[8][4], int c) { const int cp = c >> 1; const unsigned sel = (c & 1) ? 0x07060302u : 0x05040100u; v4u o;
    o.x = __builtin_amdgcn_perm(outp[1][cp], outp[0][cp], sel); o.y = __builtin_amdgcn_perm(outp[3][cp], outp[2][cp], sel); o.z = __builtin_amdgcn_perm(outp[5][cp], outp[4][cp], sel); o.w = __builtin_amdgcn_perm(outp[7][cp], outp[6][cp], sel); return o; }
__device__ __forceinline__ void conv8x8(const v4u (&R)[11], const float (&cw)[4][8], const float (&cb)[8], unsigned (&outp)[8][4], float (&ssq)[8]) {
    float acc[4][8];
#pragma unroll
    for (int i = 0; i < 11; ++i) { float x[8]; unpack8(R[i], x);
#pragma unroll
        for (int j = 0; j < 4; ++j) { const int l = i - j;
            if (l >= 0 && l < 8) {
#pragma unroll
                for (int c = 0; c < 8; ++c) acc[l & 3][c] = (j == 0 ? cb[c] : acc[l & 3][c]) + cw[j][c] * x[c]; } }
        if (i >= 3) { const int l = i - 3; float s = 0.f;
#pragma unroll
            for (int c = 0; c < 8; ++c) { acc[l & 3][c] = silu_f(acc[l & 3][c]); s += acc[l & 3][c] * acc[l & 3][c]; }
            ssq[l] = s;
#pragma unroll
            for (int cp = 0; cp < 4; ++cp) outp[l][cp] = cvtpk(acc[l & 3][2 * cp], acc[l & 3][2 * cp + 1]); } }
}
__device__ __forceinline__ void lower_pair(int p, int& i, int& j) { i = p >= 6 ? 3 : (p >= 3 ? 2 : (p >= 1 ? 1 : 0)); j = p - (i * (i + 1)) / 2; }
__device__ __forceinline__ void upper_pair(int z, int& i, int& j) { i = z >= 5 ? 2 : (z >= 3 ? 1 : 0); j = z >= 5 ? 3 : (z >= 3 ? z - 1 : z + 1); }
#define SCHED_FENCE() __builtin_amdgcn_sched_barrier(0)
__device__ __forceinline__ void tri_inverse64(LAS float* Lm, LAS float* tmp, int wave, int lane) {
    const int c = lane & 15, q = lane >> 4;
    if (wave == 0) {
        LAS float* Lb = Lm + (16 * q) * LP + 16 * q; f32x4 Lr[16][4];
#pragma unroll
        for (int l = 1; l < 16; ++l)
#pragma unroll
            for (int j = 0; j < (l + 3) / 4; ++j) Lr[l][j] = *(const LAS f32x4*)(Lb + l * LP + 4 * j);
        SCHED_FENCE();
        float t[16];
#pragma unroll
        for (int l = 0; l < 16; ++l) { float acc = (l == c) ? 1.f : 0.f;
#pragma unroll
            for (int s = 0; s < l; ++s) acc -= Lr[l][s >> 2][s & 3] * t[s];
            t[l] = acc; }
#pragma unroll
        for (int l = 0; l < 16; ++l) Lb[l * LP + c] = t[l];
    }
    __syncthreads();
    if (wave < 2) {
        const int o = 32 * wave; f32x4 acc = (f32x4){0.f, 0.f, 0.f, 0.f}; float av[4], bv[4];
#pragma unroll
        for (int kk = 0; kk < 4; ++kk) { av[kk] = Lm[(o + 16 + c) * LP + o + 4 * kk + q]; bv[kk] = Lm[(o + 4 * kk + q) * LP + o + c]; }
        SCHED_FENCE();
#pragma unroll
        for (int kk = 0; kk < 4; ++kk) acc = __builtin_amdgcn_mfma_f32_16x16x4f32(av[kk], bv[kk], acc, 0, 0, 0);
#pragma unroll
        for (int r = 0; r < 4; ++r) tmp[(16 * wave + 4 * q + r) * TP + c] = acc[r];
    }
    __syncthreads();
    if (wave < 2) {
        const int o = 32 * wave; f32x4 acc = (f32x4){0.f, 0.f, 0.f, 0.f}; float av[4], bv[4];
#pragma unroll
        for (int kk = 0; kk < 4; ++kk) { av[kk] = Lm[(o + 16 + c) * LP + o + 16 + 4 * kk + q]; bv[kk] = tmp[(16 * wave + 4 * kk + q) * TP + c]; }
        SCHED_FENCE();
#pragma unroll
        for (int kk = 0; kk < 4; ++kk) acc = __builtin_amdgcn_mfma_f32_16x16x4f32(av[kk], bv[kk], acc, 0, 0, 0);
#pragma unroll
        for (int r = 0; r < 4; ++r) Lm[(o + 16 + 4 * q + r) * LP + o + c] = -acc[r];
    }
    __syncthreads();
    if (wave < 4) {
        const int ti = wave >> 1, tj = wave & 1; f32x4 acc = (f32x4){0.f, 0.f, 0.f, 0.f}; float av[8], bv[8];
#pragma unroll
        for (int kk = 0; kk < 8; ++kk) { av[kk] = Lm[(32 + 16 * ti + c) * LP + 4 * kk + q]; bv[kk] = Lm[(4 * kk + q) * LP + 16 * tj + c]; }
        SCHED_FENCE();
#pragma unroll
        for (int kk = 0; kk < 8; ++kk) acc = __builtin_amdgcn_mfma_f32_16x16x4f32(av[kk], bv[kk], acc, 0, 0, 0);
#pragma unroll
        for (int r = 0; r < 4; ++r) tmp[(16 * ti + 4 * q + r) * TP + 16 * tj + c] = acc[r];
    }
    __syncthreads();
    if (wave < 4) {
        const int ti = wave >> 1, tj = wave & 1; f32x4 acc = (f32x4){0.f, 0.f, 0.f, 0.f}; float av[8], bv[8];
#pragma unroll
        for (int kk = 0; kk < 8; ++kk) { av[kk] = Lm[(32 + 16 * ti + c) * LP + 32 + 4 * kk + q]; bv[kk] = tmp[(4 * kk + q) * TP + 16 * tj + c]; }
        SCHED_FENCE();
#pragma unroll
        for (int kk = 0; kk < 8; ++kk) acc = __builtin_amdgcn_mfma_f32_16x16x4f32(av[kk], bv[kk], acc, 0, 0, 0);
#pragma unroll
        for (int r = 0; r < 4; ++r) Lm[(32 + 16 * ti + 4 * q + r) * LP + 16 * tj + c] = -acc[r];
    }
    __syncthreads();
}
constexpr int G_Q = 0, G_T1 = 0, G_T2 = 9216, G_K = 18432, G_W = 18432, G_KT = 35840, G_VT = 54272, G_VN = 54272, G_L = 72704, G_VNS = 72704, G_PART = 72704, G_ATT = 91136, G_TMP = 100352, G_ST = 104960, G_VEC = 139776, G_CW = 142592;
static_assert(G_CW + 3 * 128 * 4 * 4 <= LDSCTL_OFF, "GDN LDS map");
__device__ __forceinline__ void gdn_chunk_item(const Args& a, LAS unsigned char* lds, int b, int h, int tid_, int wave, int lane_) {
    const bf16* proj = ws_bf(a, WS_PROJ); bf16* mixed = mixed_buf(a);
    const int row0 = b * SEQ;
    LAS bf16* Lq = (LAS bf16*)(lds + G_Q); LAS bf16* Lk = (LAS bf16*)(lds + G_K); LAS bf16* LkT = (LAS bf16*)(lds + G_KT); LAS bf16* LvT = (LAS bf16*)(lds + G_VT);
    LAS bf16* LT1 = (LAS bf16*)(lds + G_T1); LAS bf16* LT2 = (LAS bf16*)(lds + G_T2); LAS bf16* LW = (LAS bf16*)(lds + G_W); LAS bf16* Lvn = (LAS bf16*)(lds + G_VN); LAS bf16* Lvns = (LAS bf16*)(lds + G_VNS);
    LAS bf16* Latt = (LAS bf16*)(lds + G_ATT); LAS bf16* LST = (LAS bf16*)(lds + G_ST); LAS float* LL = (LAS float*)(lds + G_L); LAS float* Ltmp = (LAS float*)(lds + G_TMP); LAS float* Lpart = (LAS float*)(lds + G_PART);
    LAS float* vgc = (LAS float*)(lds + G_VEC); LAS float* vbeta = vgc + 64; LAS float* vrq = vgc + 128; LAS float* vrk = vgc + 192; LAS float* vqs = vgc + 256; LAS float* vvsc = vgc + 320; LAS float* vt2s = vgc + 384; LAS float* vossq = vgc + 448; LAS float* vmisc = vgc + 576;
    LAS float* Lcw = (LAS float*)(lds + G_CW);
    const float Ag = -expf(a.in[I_GALOG][h]), dtb = a.in[I_GDTB][h];
    const float cb[8] = {0.f, 0.f, 0.f, 0.f, 0.f, 0.f, 0.f, 0.f};
    for (int i = tid_; i < 4 * 384; i += NT) { const int j = i / 384, c = i - j * 384; Lcw[i] = a.in[I_GCW][j * GDN_CONV + (c >> 7) * 1024 + h * 128 + (c & 127)]; }
    f32x4 Sacc[4][2];
#pragma unroll
    for (int x = 0; x < 4; ++x)
#pragma unroll
        for (int d = 0; d < 2; ++d) Sacc[x][d] = (f32x4){0.f, 0.f, 0.f, 0.f};
    for (int i = tid_; i < 128 * P128 / 2; i += NT) ((LAS unsigned*)LST)[i] = 0u;
    const int li = wave >> 1, dvh = wave & 1;
    __syncthreads();
#pragma unroll 1
    for (int ch = 0; ch < SEQ / 64; ++ch) {
        const int t0 = 64 * ch;
        int lane = lane_;
        asm volatile("" : "+v"(lane));
        const int tid = wave * 64 + lane, c16 = lane & 15, q4 = lane >> 4, oct = tid % 48, tg = tid / 48, seg = oct >> 4, c0 = 8 * (oct & 15);
        if (tid < 384) {
            v4u R[11]; const bf16* src = (proj + (size_t)(row0 + t0 - 3) * PITCH + PC_QKV + h * 128) + (unsigned)(8 * tg * PITCH + seg * 1024 + c0);
#pragma unroll
            for (int i = 0; i < 11; ++i) R[i] = (t0 + 8 * tg - 3 + i >= 0) ? *(const v4u*)(src + (size_t)i * PITCH) : (v4u){0u, 0u, 0u, 0u};
            float cw[4][8];
#pragma unroll
            for (int j = 0; j < 4; ++j) { const f32x4 w0 = *(const LAS f32x4*)(Lcw + j * 384 + seg * 128 + c0), w1 = *(const LAS f32x4*)(Lcw + j * 384 + seg * 128 + c0 + 4);
                cw[j][0] = w0.x; cw[j][1] = w0.y; cw[j][2] = w0.z; cw[j][3] = w0.w; cw[j][4] = w1.x; cw[j][5] = w1.y; cw[j][6] = w1.z; cw[j][7] = w1.w; }
            unsigned outp[8][4]; float ssq[8];
            conv8x8(R, cw, cb, outp, ssq);
            if (seg < 2) { LAS bf16* dst = (seg == 0 ? Lq : Lk) + (8 * tg) * P128 + c0;
#pragma unroll
                for (int l = 0; l < 8; ++l) { *(LAS v4u*)(dst + l * P128) = (v4u){outp[l][0], outp[l][1], outp[l][2], outp[l][3]}; Lpart[(seg * 64 + 8 * tg + l) * 16 + (oct & 15)] = ssq[l]; } }
            if (seg >= 1) { LAS bf16* dst = (seg == 1 ? LkT : LvT) + c0 * P64 + 8 * tg;
#pragma unroll
                for (int c = 0; c < 8; ++c) *(LAS v4u*)(dst + c * P64) = tpack(outp, c); }
        } else if (wave == 6) {
            const size_t r = (size_t)(row0 + t0 + lane) * PITCH;
            const float g = Ag * softplus_acc(bf2f(proj[r + PC_ALPHA + h]) + dtb), be = 1.f / (1.f + __expf(-bf2f(proj[r + PC_BETA + h])));
            float gc = g;
#pragma unroll
            for (int d = 1; d < 64; d <<= 1) { const float v = sup(gc, d, lane); if (lane >= d) gc += v; }
            vgc[lane] = gc; vbeta[lane] = be;
        }
        __syncthreads();
        if (tid < 64) { f32x4 pq[4], pk[4];
#pragma unroll
            for (int o = 0; o < 4; ++o) { pq[o] = *(const LAS f32x4*)(Lpart + tid * 16 + 4 * o); pk[o] = *(const LAS f32x4*)(Lpart + (64 + tid) * 16 + 4 * o); }
            float sq = 0.f, sk = 0.f;
#pragma unroll
            for (int o = 0; o < 4; ++o) { sq += (pq[o].x + pq[o].y) + (pq[o].z + pq[o].w); sk += (pk[o].x + pk[o].y) + (pk[o].z + pk[o].w); }
            const float rq = __builtin_amdgcn_rsqf(sq + 1e-6f), rk = __builtin_amdgcn_rsqf(sk + 1e-6f), gc = vgc[tid], gl = vgc[63], be = vbeta[tid];
            vrq[tid] = rq; vrk[tid] = rk; vqs[tid] = __expf(gc) * rq * 0.08838834764831845f; vvsc[tid] = __expf(gl - gc) * rk; vt2s[tid] = be * __expf(gc) * rk;
            if (tid == 0) vmisc[0] = __expf(gl); }
        __syncthreads();
        const size_t orow = (size_t)(row0 + t0 + 16 * li + c16);
        unsigned long long gg[4];
#pragma unroll
        for (int tt = 0; tt < 4; ++tt) gg[tt] = *(const unsigned long long*)(proj + orow * PITCH + PC_GATE + h * 128 + 16 * (4 * dvh + tt) + 4 * q4);
        f32x4 oacc[4];
        { bf16x8 qf[4], sf[4][4];
#pragma unroll
            for (int ks = 0; ks < 4; ++ks) { qf[ks] = ldfrag(Lq, P128, 16 * li, 32 * ks, lane);
#pragma unroll
                for (int tt = 0; tt < 4; ++tt) sf[ks][tt] = ldfrag(LST, P128, 16 * (4 * dvh + tt), 32 * ks, lane); }
            SCHED_FENCE();
#pragma unroll
            for (int tt = 0; tt < 4; ++tt) oacc[tt] = (f32x4){0.f, 0.f, 0.f, 0.f};
#pragma unroll
            for (int ks = 0; ks < 4; ++ks)
#pragma unroll
                for (int tt = 0; tt < 4; ++tt) oacc[tt] = MFMA16(sf[ks][tt], qf[ks], oacc[tt]); }
#pragma unroll 1
        for (int job = wave; job < 20; job += 8) { const int type = job >= 10 ? 1 : 0; int ti, tj; lower_pair(job - 10 * type, ti, tj);
            const LAS bf16* Y = type ? Lq : Lk; bf16x8 xf[4], yf[4];
#pragma unroll
            for (int ks = 0; ks < 4; ++ks) { xf[ks] = ldfrag(Lk, P128, 16 * tj, 32 * ks, lane); yf[ks] = ldfrag(Y, P128, 16 * ti, 32 * ks, lane); }
            const int l = 16 * ti + c16, s0 = 16 * tj + 4 * q4; const float gcl = vgc[l]; const f32x4 gcs = *(const LAS f32x4*)(vgc + s0), rks = *(const LAS f32x4*)(vrk + s0);
            const float rowf = type ? vrq[l] * 0.08838834764831845f : vbeta[l] * vrk[l];
            SCHED_FENCE();
            f32x4 acc = (f32x4){0.f, 0.f, 0.f, 0.f};
#pragma unroll
            for (int ks = 0; ks < 4; ++ks) acc = MFMA16(xf[ks], yf[ks], acc);
            f32x4 val;
#pragma unroll
            for (int r = 0; r < 4; ++r) { const bool ok = type ? (s0 + r <= l) : (s0 + r < l); val[r] = ok ? acc[r] * rowf * rks[r] * __expf(gcl - gcs[r]) : 0.f; }
            if (type == 0) *(LAS f32x4*)(LL + l * LP + s0) = val; else *(LAS u32x2*)(Latt + l * P64 + s0) = pack4(val); }
        for (int z = wave; z < 12; z += 8) { int ti, tj; upper_pair(z >= 6 ? z - 6 : z, ti, tj); const int l = 16 * ti + c16, s0 = 16 * tj + 4 * q4;
            if (z < 6) *(LAS f32x4*)(LL + l * LP + s0) = (f32x4){0.f, 0.f, 0.f, 0.f}; else *(LAS u32x2*)(Latt + l * P64 + s0) = (u32x2){0u, 0u}; }
        __syncthreads();
        tri_inverse64(LL, Ltmp, wave, lane);
        { const int l = tid >> 3, s0 = 8 * (tid & 7); const f32x4 ta = *(const LAS f32x4*)(LL + l * LP + s0), tb = *(const LAS f32x4*)(LL + l * LP + s0 + 4);
            const f32x4 ba = *(const LAS f32x4*)(vbeta + s0), bb = *(const LAS f32x4*)(vbeta + s0 + 4), sa = *(const LAS f32x4*)(vt2s + s0), sb = *(const LAS f32x4*)(vt2s + s0 + 4);
            const u32x2 p0 = pack4(ta * ba), p1 = pack4(tb * bb), r0 = pack4(ta * sa), r1 = pack4(tb * sb);
            *(LAS v4u*)(LT1 + l * P64 + s0) = (v4u){p0.x, p0.y, p1.x, p1.y}; *(LAS v4u*)(LT2 + l * P64 + s0) = (v4u){r0.x, r0.y, r1.x, r1.y}; }
        __syncthreads();
        f32x4 uacc[4];
        { bf16x8 vf[2], kf[2], t1f[2][4], t2f[2][4];
#pragma unroll
            for (int ks = 0; ks < 2; ++ks) { vf[ks] = ldfrag(LvT, P64, 16 * wave, 32 * ks, lane); kf[ks] = ldfrag(LkT, P64, 16 * wave, 32 * ks, lane);
#pragma unroll
                for (int lt = 2 * ks; lt < 4; ++lt) { t1f[ks][lt] = ldfrag(LT1, P64, 16 * lt, 32 * ks, lane); t2f[ks][lt] = ldfrag(LT2, P64, 16 * lt, 32 * ks, lane); } }
            SCHED_FENCE();
            f32x4 wacc[4];
#pragma unroll
            for (int lt = 0; lt < 4; ++lt) { uacc[lt] = (f32x4){0.f, 0.f, 0.f, 0.f}; wacc[lt] = (f32x4){0.f, 0.f, 0.f, 0.f}; }
#pragma unroll
            for (int ks = 0; ks < 2; ++ks)
#pragma unroll
                for (int lt = 2 * ks; lt < 4; ++lt) { uacc[lt] = MFMA16(t1f[ks][lt], vf[ks], uacc[lt]); wacc[lt] = MFMA16(kf[ks], t2f[ks][lt], wacc[lt]); }
#pragma unroll
            for (int lt = 0; lt < 4; ++lt) *(LAS u32x2*)(LW + (16 * lt + c16) * P128 + 16 * wave + 4 * q4) = pack4(wacc[lt]); }
        __syncthreads();
        { bf16x8 sf[4], wf[4][4]; f32x4 sc[4];
#pragma unroll
            for (int ks = 0; ks < 4; ++ks) { sf[ks] = ldfrag(LST, P128, 16 * wave, 32 * ks, lane);
#pragma unroll
                for (int lt = 0; lt < 4; ++lt) wf[ks][lt] = ldfrag(LW, P128, 16 * lt, 32 * ks, lane); }
#pragma unroll
            for (int lt = 0; lt < 4; ++lt) sc[lt] = *(const LAS f32x4*)(vvsc + 16 * lt + 4 * q4);
            SCHED_FENCE();
            f32x4 ws[4];
#pragma unroll
            for (int lt = 0; lt < 4; ++lt) ws[lt] = (f32x4){0.f, 0.f, 0.f, 0.f};
#pragma unroll
            for (int ks = 0; ks < 4; ++ks)
#pragma unroll
                for (int lt = 0; lt < 4; ++lt) ws[lt] = MFMA16(wf[ks][lt], sf[ks], ws[lt]);
#pragma unroll
            for (int lt = 0; lt < 4; ++lt) { const f32x4 vn = uacc[lt] - ws[lt];
                *(LAS u32x2*)(Lvn + (16 * wave + c16) * P64 + 16 * lt + 4 * q4) = pack4(vn); *(LAS u32x2*)(Lvns + (16 * wave + c16) * P64 + 16 * lt + 4 * q4) = pack4(vn * sc[lt]); } }
        __syncthreads();
        {
            bf16x8 kf[2][4], nf[2][2], af[2], vf[2][4];
#pragma unroll
            for (int ks = 0; ks < 2; ++ks) {
#pragma unroll
                for (int x = 0; x < 4; ++x) { kf[ks][x] = ldfrag(LkT, P64, 16 * (4 * dvh + x), 32 * ks, lane); vf[ks][x] = ldfrag(Lvn, P64, 16 * (4 * dvh + x), 32 * ks, lane); }
#pragma unroll
                for (int d = 0; d < 2; ++d) nf[ks][d] = ldfrag(Lvns, P64, 16 * (2 * li + d), 32 * ks, lane);
                af[ks] = ldfrag(Latt, P64, 16 * li, 32 * ks, lane); }
            const float ge = vmisc[0], qsl = vqs[16 * li + c16];
            SCHED_FENCE();
#pragma unroll
            for (int x = 0; x < 4; ++x)
#pragma unroll
                for (int d = 0; d < 2; ++d) Sacc[x][d] = Sacc[x][d] * ge;
#pragma unroll
            for (int tt = 0; tt < 4; ++tt) oacc[tt] = oacc[tt] * qsl;
#pragma unroll
            for (int ks = 0; ks < 2; ++ks) {
#pragma unroll
                for (int d = 0; d < 2; ++d)
#pragma unroll
                    for (int x = 0; x < 4; ++x) Sacc[x][d] = MFMA16(kf[ks][x], nf[ks][d], Sacc[x][d]);
                if (ks == 0 || li >= 2) {
#pragma unroll
                    for (int tt = 0; tt < 4; ++tt) oacc[tt] = MFMA16(vf[ks][tt], af[ks], oacc[tt]); } }
#pragma unroll
            for (int x = 0; x < 4; ++x)
#pragma unroll
                for (int d = 0; d < 2; ++d) *(LAS u32x2*)(LST + (16 * (2 * li + d) + c16) * P128 + 16 * (4 * dvh + x) + 4 * q4) = pack4(Sacc[x][d]);
            float sq = 0.f;
#pragma unroll
            for (int tt = 0; tt < 4; ++tt) sq += (oacc[tt][0] * oacc[tt][0] + oacc[tt][1] * oacc[tt][1]) + (oacc[tt][2] * oacc[tt][2] + oacc[tt][3] * oacc[tt][3]);
            sq += sx<16>(sq); sq += sx32(sq, lane);
            if (q4 == 0) vossq[(16 * li + c16) * 2 + dvh] = sq;
            __syncthreads();
            const float rs = __builtin_amdgcn_rsqf((vossq[(16 * li + c16) * 2] + vossq[(16 * li + c16) * 2 + 1]) * (1.f / GDN_D) + EPS);
#pragma unroll
            for (int tt = 0; tt < 4; ++tt) { const int dv0 = 16 * (4 * dvh + tt) + 4 * q4; const f32x4 w = *(const f32x4*)(a.in[I_GNW] + dv0);
                const float g0 = silu_f(bf2f((unsigned)gg[tt] & 0xffffu)), g1 = silu_f(bf2f(((unsigned)gg[tt]) >> 16)), g2 = silu_f(bf2f((unsigned)(gg[tt] >> 32) & 0xffffu)), g3 = silu_f(bf2f((unsigned)(gg[tt] >> 48)));
                const f32x4 o = oacc[tt] * rs * w * (f32x4){g0, g1, g2, g3};
                *(u32x2*)(mixed + orow * DMIX + DM + h * 128 + dv0) = pack4(o); }
        }
    }
    const int c16 = lane_ & 15, q4 = lane_ >> 4;
    float* so = a.out + OFF_GDN_P + ((size_t)b * GDN_H + h) * (GDN_D * GDN_D);
#pragma unroll
    for (int x = 0; x < 4; ++x)
#pragma unroll
        for (int d = 0; d < 2; ++d)
#pragma unroll
            for (int r = 0; r < 4; ++r) so[(size_t)(16 * (4 * dvh + x) + 4 * q4 + r) * GDN_D + 16 * (2 * li + d) + c16] = Sacc[x][d][r];
    __syncthreads();
}
constexpr int S_C = 0, S_B = 17408, S_BT = 34816, S_XT = 53248, S_XWT = 71680, S_M = 90112, S_H = 108544, S_VEC = 143360;
static_assert(S_VEC + 6 * 256 <= LDSCTL_OFF, "SSD LDS map");
__device__ __forceinline__ void ssd_chunk_item(const Args& a, LAS unsigned char* lds, int b, int g, int hp, int tid_, int wave, int lane_) {
    const bf16* proj = ws_bf(a, WS_PROJ); bf16* mixed = mixed_buf(a); float* ssqo = ws_f(a, WS_SSQ);
    const int row0 = b * SEQ, h0 = 8 * g + 2 * hp;
    LAS bf16* LC = (LAS bf16*)(lds + S_C); LAS bf16* LB = (LAS bf16*)(lds + S_B); LAS bf16* LBT = (LAS bf16*)(lds + S_BT); LAS bf16* LXT = (LAS bf16*)(lds + S_XT); LAS bf16* LXW = (LAS bf16*)(lds + S_XWT);
    LAS bf16* LM = (LAS bf16*)(lds + S_M); LAS bf16* LH = (LAS bf16*)(lds + S_H);
    LAS float* vdt = (LAS float*)(lds + S_VEC); LAS float* vacs = vdt + 128;
    const int hh = wave >> 2, wq = wave & 3;
    const float A_h = -expf(a.in[I_SALOG][h0 + (lane_ >> 5 ? 1 : 0)]);
    f32x4 hacc[8];
#pragma unroll
    for (int nt = 0; nt < 8; ++nt) hacc[nt] = (f32x4){0.f, 0.f, 0.f, 0.f};
    for (int i = tid_; i < 2 * 64 * P128 / 2; i += NT) ((LAS unsigned*)LH)[i] = 0u;
    for (int ch = 0; ch < SEQ / 64; ++ch) {
        const int t0 = 64 * ch;
        int lane = lane_;
        asm volatile("" : "+v"(lane));
        const int tid = wave * 64 + lane, c16 = lane & 15, q4 = lane >> 4, oct = tid % 48, tg = tid / 48, seg = oct >> 4, c0 = 8 * (oct & 15);
        if (tid < 384) {
            const int chb = (seg == 0 ? h0 * 64 : (seg == 1 ? 1024 + g * 128 : 1280 + g * 128)) + c0;
            v4u R[11]; const bf16* src = (proj + (size_t)(row0 + t0 - 3) * PITCH + PC_XBC) + (unsigned)(8 * tg * PITCH + chb);
#pragma unroll
            for (int i = 0; i < 11; ++i) R[i] = (t0 + 8 * tg - 3 + i >= 0) ? *(const v4u*)(src + (size_t)i * PITCH) : (v4u){0u, 0u, 0u, 0u};
            float cw[4][8], cb[8];
#pragma unroll
            for (int j = 0; j < 4; ++j) { const f32x4 w0 = *(const f32x4*)(a.in[I_SCW] + j * SSD_CONV + chb), w1 = *(const f32x4*)(a.in[I_SCW] + j * SSD_CONV + chb + 4);
                cw[j][0] = w0.x; cw[j][1] = w0.y; cw[j][2] = w0.z; cw[j][3] = w0.w; cw[j][4] = w1.x; cw[j][5] = w1.y; cw[j][6] = w1.z; cw[j][7] = w1.w; }
            { const f32x4 b0 = *(const f32x4*)(a.in[I_SCB] + chb), b1 = *(const f32x4*)(a.in[I_SCB] + chb + 4); cb[0] = b0.x; cb[1] = b0.y; cb[2] = b0.z; cb[3] = b0.w; cb[4] = b1.x; cb[5] = b1.y; cb[6] = b1.z; cb[7] = b1.w; }
            unsigned outp[8][4]; float ssq[8];
            conv8x8(R, cw, cb, outp, ssq);
            if (seg >= 1) { LAS bf16* dst = (seg == 1 ? LB : LC) + (8 * tg) * P128 + c0;
#pragma unroll
                for (int l = 0; l < 8; ++l) *(LAS v4u*)(dst + l * P128) = (v4u){outp[l][0], outp[l][1], outp[l][2], outp[l][3]}; }
            if (seg <= 1) { LAS bf16* dst = (seg == 0 ? LXT : LBT) + c0 * P64 + 8 * tg;
#pragma unroll
                for (int c = 0; c < 8; ++c) *(LAS v4u*)(dst + c * P64) = tpack(outp, c); }
        } else if (wave == 6) {
#pragma unroll
            for (int e = 0; e < 2; ++e) { const float dtv = softplus_acc(bf2f(proj[(size_t)(row0 + t0 + lane) * PITCH + PC_DT + h0 + e]) + a.in[I_SDTB][h0 + e]);
                float ac = dtv * (-expf(a.in[I_SALOG][h0 + e]));
#pragma unroll
                for (int d = 1; d < 64; d <<= 1) { const float v = sup(ac, d, lane); if (lane >= d) ac += v; }
                vdt[64 * e + lane] = dtv; vacs[64 * e + lane] = ac; }
        }
        __syncthreads();
        { const int pr = tid >> 2, l0 = 16 * (tid & 3), e = pr >> 6; const float al = vacs[64 * e + 63];
            const v4u x0 = *(const LAS v4u*)(LXT + pr * P64 + l0), x1 = *(const LAS v4u*)(LXT + pr * P64 + l0 + 8); float xf[16]; { float t8[8]; unpack8(x0, t8);
#pragma unroll
                for (int i = 0; i < 8; ++i) xf[i] = t8[i]; unpack8(x1, t8);
#pragma unroll
                for (int i = 0; i < 8; ++i) xf[8 + i] = t8[i]; }
            unsigned o[8];
#pragma unroll
            for (int i = 0; i < 8; ++i) { const int l = l0 + 2 * i; const float s0 = vdt[64 * e + l] * __expf(al - vacs[64 * e + l]), s1 = vdt[64 * e + l + 1] * __expf(al - vacs[64 * e + l + 1]); o[i] = cvtpk(xf[2 * i] * s0, xf[2 * i + 1] * s1); }
            *(LAS v4u*)(LXW + pr * P64 + l0) = (v4u){o[0], o[1], o[2], o[3]}; *(LAS v4u*)(LXW + pr * P64 + l0 + 8) = (v4u){o[4], o[5], o[6], o[7]}; }
        f32x4 yacc[4];
#pragma unroll
        for (int pt = 0; pt < 4; ++pt) yacc[pt] = (f32x4){0.f, 0.f, 0.f, 0.f};
#pragma unroll
        for (int ks = 0; ks < 4; ++ks) { const bf16x8 cf = ldfrag(LC, P128, 16 * wq, 32 * ks, lane);
#pragma unroll
            for (int pt = 0; pt < 4; ++pt) yacc[pt] = MFMA16(ldfrag(LH + hh * 64 * P128, P128, 16 * pt, 32 * ks, lane), cf, yacc[pt]); }
        for (int job = wave; job < 10; job += 8) { int ti, tj; lower_pair(job, ti, tj);
            f32x4 acc = (f32x4){0.f, 0.f, 0.f, 0.f};
#pragma unroll
            for (int ks = 0; ks < 4; ++ks) acc = MFMA16(ldfrag(LB, P128, 16 * tj, 32 * ks, lane), ldfrag(LC, P128, 16 * ti, 32 * ks, lane), acc);
            const int l = 16 * ti + c16, s0 = 16 * tj + 4 * q4;
#pragma unroll
            for (int e = 0; e < 2; ++e) { const float al = vacs[64 * e + l], Dh = a.in[I_SD][h0 + e]; const f32x4 as = *(const LAS f32x4*)(vacs + 64 * e + s0), ds = *(const LAS f32x4*)(vdt + 64 * e + s0); f32x4 val;
#pragma unroll
                for (int r = 0; r < 4; ++r) val[r] = (s0 + r <= l) ? acc[r] * ds[r] * __expf(al - as[r]) + ((s0 + r == l) ? Dh : 0.f) : 0.f;
                *(LAS u32x2*)(LM + e * 64 * P64 + l * P64 + s0) = pack4(val); } }
        if (wave >= 2 && wave < 6) { const int e = (wave - 2) >> 1, up = (wave - 2) & 1; const int l = (up ? 32 : 0) + c16, s0 = (up ? 48 : 16) + 4 * q4;
            *(LAS u32x2*)(LM + e * 64 * P64 + l * P64 + s0) = (u32x2){0u, 0u}; }
        __syncthreads();
        {
            const float ea = __expf(vacs[64 * hh + 16 * wq + c16]);
#pragma unroll
            for (int pt = 0; pt < 4; ++pt) yacc[pt] = yacc[pt] * ea;
            for (int ks = 0; ks < (wq >= 2 ? 2 : 1); ++ks) { const bf16x8 mf = ldfrag(LM + hh * 64 * P64, P64, 16 * wq, 32 * ks, lane);
#pragma unroll
                for (int pt = 0; pt < 4; ++pt) yacc[pt] = MFMA16(ldfrag(LXT + hh * 64 * P64, P64, 16 * pt, 32 * ks, lane), mf, yacc[pt]); }
            const float el = __expf(vacs[64 * hh + 63]);
#pragma unroll
            for (int nt = 0; nt < 8; ++nt) hacc[nt] = hacc[nt] * el;
#pragma unroll
            for (int ks = 0; ks < 2; ++ks) { const bf16x8 xf = ldfrag(LXW + hh * 64 * P64, P64, 16 * wq, 32 * ks, lane);
#pragma unroll
                for (int nt = 0; nt < 8; ++nt) hacc[nt] = MFMA16(ldfrag(LBT, P64, 16 * nt, 32 * ks, lane), xf, hacc[nt]); }
#pragma unroll
            for (int nt = 0; nt < 8; ++nt) *(LAS u32x2*)(LH + hh * 64 * P128 + (16 * wq + c16) * P128 + 16 * nt + 4 * q4) = pack4(hacc[nt]);
            const size_t row = (size_t)(row0 + t0 + 16 * wq + c16); float sq = 0.f;
#pragma unroll
            for (int pt = 0; pt < 4; ++pt) { const int p0 = (h0 + hh) * 64 + 16 * pt + 4 * q4; const unsigned long long zz = *(const unsigned long long*)(proj + row * PITCH + PC_Z + p0);
                const f32x4 y = yacc[pt] * (f32x4){silu_f(bf2f((unsigned)zz & 0xffffu)), silu_f(bf2f(((unsigned)zz) >> 16)), silu_f(bf2f((unsigned)(zz >> 32) & 0xffffu)), silu_f(bf2f((unsigned)(zz >> 48)))};
                *(u32x2*)(mixed + row * DMIX + p0) = pack4(y); sq += (y[0] * y[0] + y[1] * y[1]) + (y[2] * y[2] + y[3] * y[3]); }
            sq += sx<16>(sq); sq += sx32(sq, lane);
            if (q4 == 0) ssqo[row * 16 + h0 + hh] = sq;
        }
        __syncthreads();
    }
    { const int c16 = lane_ & 15, q4 = lane_ >> 4; float* so = a.out + OFF_SSD_P + ((size_t)b * SSD_H + h0 + hh) * (SSD_P * SSD_N) + (size_t)(16 * wq + c16) * SSD_N + 4 * q4;
#pragma unroll
        for (int nt = 0; nt < 8; ++nt) *(f32x4*)(so + 16 * nt) = hacc[nt]; }
    (void)A_h;
    __syncthreads();
}
constexpr int SS_XS = 0, SS_XW = 49152, SS_ZS = 81920, SS_CBF = 98304, SS_DT = 107008, SS_CUM = 107520, SS_CBM = 108032, SS_MM = 108544;
__device__ __forceinline__ void ssd_sample_item(const Args& a, LAS unsigned char* lds, int sb, int tid, int wave, int lane) {
    const bf16* proj = ws_bf(a, WS_PROJ); bf16* mixed = mixed_buf(a); float* ssqo = ws_f(a, WS_SSQ);
    const int row0 = MP + sb * LS;
    LAS float* xs = (LAS float*)(lds + SS_XS);
    LAS float* xw = (LAS float*)(lds + SS_XW);
    LAS bf16* zs = (LAS bf16*)(lds + SS_ZS);
    LAS bf16* cbf = (LAS bf16*)(lds + SS_CBF);
    LAS float* dtv = (LAS float*)(lds + SS_DT); LAS float* cum = (LAS float*)(lds + SS_CUM); LAS float* cbm = (LAS float*)(lds + SS_CBM); LAS float* mm = (LAS float*)(lds + SS_MM);
    if (tid < 384) { const int ch = 4 * tid;
        f32x4 r[11];
#pragma unroll
        for (int j = 0; j < 3; ++j) r[j] = *(const f32x4*)(a.in[I_SSDC] + ((size_t)sb * 3 + j) * SSD_CONV + ch);
#pragma unroll
        for (int t = 0; t < 8; ++t) { const u32x2 v = *(const u32x2*)(proj + (size_t)(row0 + t) * PITCH + PC_XBC + ch); r[3 + t] = (f32x4){bf2f(v.x & 0xffffu), __uint_as_float(v.x & 0xffff0000u), bf2f(v.y & 0xffffu), __uint_as_float(v.y & 0xffff0000u)}; }
        f32x4 w[4];
#pragma unroll
        for (int j = 0; j < 4; ++j) w[j] = *(const f32x4*)(a.in[I_SCW] + j * SSD_CONV + ch);
        const f32x4 bias = *(const f32x4*)(a.in[I_SCB] + ch);
#pragma unroll
        for (int t = 0; t < 8; ++t) { f32x4 acc = bias + w[0] * r[t] + w[1] * r[t + 1] + w[2] * r[t + 2] + w[3] * r[t + 3];
            acc = (f32x4){silu_f(acc.x), silu_f(acc.y), silu_f(acc.z), silu_f(acc.w)};
            *(LAS f32x4*)(xs + t * SSD_CONV + ch) = acc;
            if (ch >= 1280) { const int g = (ch - 1280) >> 7, n = (ch - 1280) & 127; *(LAS u32x2*)(cbf + (g * 16 + t) * P128 + n) = pack4(acc); *(LAS u32x2*)(cbf + (g * 16 + 8 + t) * P128 + n) = (u32x2){0u, 0u}; } }
    } else { const int i = tid - 384, t = i >> 4, h = i & 15;
        dtv[i] = softplus_acc(bf2f(proj[(size_t)(row0 + t) * PITCH + PC_DT + h]) + a.in[I_SDTB][h]); }
    for (int i = tid; i < 8 * 128; i += NT) { const int t = i >> 7, c = i & 127; *(LAS v4u*)(zs + t * 1024 + 8 * c) = *(const v4u*)(proj + (size_t)(row0 + t) * PITCH + PC_Z + 8 * c); }
    __syncthreads();
    if (tid < 16) { const float A = -expf(a.in[I_SALOG][tid]); float c = 0.f;
#pragma unroll
        for (int t = 0; t < 8; ++t) { c += dtv[t * 16 + tid] * A; cum[tid * 8 + t] = c; } }
    if (tid >= 64 && tid < 192) { const int i = tid - 64, g = i >> 6, t = (i >> 3) & 7, s = i & 7; float acc = 0.f;
        const LAS float* cp = xs + t * SSD_CONV + 1280 + g * 128; const LAS float* bp = xs + s * SSD_CONV + 1024 + g * 128;
        for (int n = 0; n < 128; n += 4) { const f32x4 c4 = *(const LAS f32x4*)(cp + n), b4 = *(const LAS f32x4*)(bp + n); acc += (c4.x * b4.x + c4.y * b4.y) + (c4.z * b4.z + c4.w * b4.w); }
        cbm[i] = acc; }
    __syncthreads();
    for (int i = tid; i < 16 * 64; i += NT) { const int h = i >> 6, t = (i >> 3) & 7, s = i & 7;
        mm[i] = (s <= t) ? cbm[(h >> 3) * 64 + t * 8 + s] * dtv[s * 16 + h] * __expf(cum[h * 8 + t] - cum[h * 8 + s]) + (s == t ? a.in[I_SD][h] : 0.f) : 0.f; }
    for (int i = tid; i < 16 * 64 * 8; i += NT) { const int h = i >> 9, p = (i >> 3) & 63, s = i & 7; xw[i] = xs[s * SSD_CONV + h * 64 + p] * dtv[s * 16 + h] * __expf(cum[h * 8 + 7] - cum[h * 8 + s]); }
    __syncthreads();
#pragma unroll 1
    for (int e = 0; e < 2; ++e) { const int h = 2 * wave + e, g = h >> 3;
        int lane_l = lane; asm volatile("" : "+v"(lane_l)); const int c16 = lane_l & 15, q4 = lane_l >> 4;
        const float* sin = a.in[I_SSD] + ((size_t)sb * SSD_H + h) * (SSD_P * SSD_N); float* sout = a.out + OFF_SSD_S + ((size_t)sb * SSD_H + h) * (SSD_P * SSD_N);
        const float D8 = __expf(cum[h * 8 + 7]);
        f32x4 G[4];
#pragma unroll
        for (int pt = 0; pt < 4; ++pt) G[pt] = (f32x4){0.f, 0.f, 0.f, 0.f};
#pragma unroll 1
        for (int ks = 0; ks < 4; ++ks) { const int n0 = 32 * ks + 8 * q4;
            const bf16x8 cf = ldfrag(cbf + g * 16 * P128, P128, 0, 32 * ks, lane_l);
            f32x4 h0[4][2];
#pragma unroll
            for (int pt = 0; pt < 4; ++pt) { const f32x4* sp = (const f32x4*)(sin + (16 * pt + c16) * SSD_N + n0); h0[pt][0] = sp[0]; h0[pt][1] = sp[1]; }
            f32x4 Bv[8][2];
#pragma unroll
            for (int s = 0; s < 8; ++s) { const LAS f32x4* bp = (const LAS f32x4*)(xs + s * SSD_CONV + 1024 + g * 128 + n0); Bv[s][0] = bp[0]; Bv[s][1] = bp[1]; }
#pragma unroll
            for (int pt = 0; pt < 4; ++pt) { const f32x4 a0 = h0[pt][0], a1 = h0[pt][1];
                const u32x2 lo = pack4(a0), hi = pack4(a1); const v4u yv = (v4u){lo.x, lo.y, hi.x, hi.y};
                G[pt] = MFMA16(cf, __builtin_bit_cast(bf16x8, yv), G[pt]);
                const LAS f32x4* wp = (const LAS f32x4*)(xw + (h * 64 + 16 * pt + c16) * 8); const f32x4 w0 = wp[0], w1 = wp[1];
                f32x4 n0v = a0 * D8, n1v = a1 * D8;
#pragma unroll
                for (int s = 0; s < 8; ++s) { const float ws = s < 4 ? w0[s] : w1[s - 4]; n0v += Bv[s][0] * ws; n1v += Bv[s][1] * ws; }
                f32x4* op = (f32x4*)(sout + (16 * pt + c16) * SSD_N + n0); op[0] = n0v; op[1] = n1v; } }
        if (q4 < 2) {
            float sq[4] = {0.f, 0.f, 0.f, 0.f};
#pragma unroll
            for (int pt = 0; pt < 4; ++pt) { const int p = 16 * pt + c16; float xv[8];
#pragma unroll
                for (int s = 0; s < 8; ++s) xv[s] = xs[s * SSD_CONV + h * 64 + p];
#pragma unroll
                for (int r = 0; r < 4; ++r) { const int t = 4 * q4 + r; float y = __expf(cum[h * 8 + t]) * G[pt][r]; const LAS f32x4* mp = (const LAS f32x4*)(mm + (h * 8 + t) * 8); const f32x4 m0 = mp[0], m1 = mp[1];
                    y += (m0.x * xv[0] + m0.y * xv[1]) + (m0.z * xv[2] + m0.w * xv[3]) + (m1.x * xv[4] + m1.y * xv[5]) + (m1.z * xv[6] + m1.w * xv[7]);
                    y *= silu_f(bf2f(zs[t * 1024 + h * 64 + p])); sq[r] += y * y;
                    mixed[(size_t)(row0 + t) * DMIX + h * 64 + p] = (bf16)(cvtpk(y, 0.f) & 0xffffu); } }
#pragma unroll
            for (int r = 0; r < 4; ++r) { float v = sq[r]; v += sx<1>(v); v += sx<2>(v); v += sx<4>(v); v += sx<8>(v); if (c16 == 0) ssqo[(size_t)(row0 + 4 * q4 + r) * 16 + h] = v; }
        }
    }
    __syncthreads();
}
constexpr int GS_HEAD = 16384, GS_SMALL = 8 * GS_HEAD, GS_SMALL_PER = 1024;
static_assert(GS_SMALL + 8 * GS_SMALL_PER <= LDSCTL_OFF, "GDN sample LDS map");
__device__ __forceinline__ void gdn_sample_item(const Args& a, LAS unsigned char* lds, int sb, int tid, int wave, int lane) {
    const bf16* proj = ws_bf(a, WS_PROJ); bf16* mixed = mixed_buf(a);
    const int row0 = MP + sb * LS;
    for (int u = tid; u < 768; u += NT) { const int ch = 4 * u, which = ch >> 10, hd = (ch & 1023) >> 7, d = ch & 127;
        f32x4 r[11];
#pragma unroll
        for (int j = 0; j < 3; ++j) r[j] = *(const f32x4*)(a.in[I_GDNC] + ((size_t)sb * 3 + j) * GDN_CONV + ch);
#pragma unroll
        for (int t = 0; t < 8; ++t) { const u32x2 v = *(const u32x2*)(proj + (size_t)(row0 + t) * PITCH + PC_QKV + ch); r[3 + t] = (f32x4){bf2f(v.x & 0xffffu), __uint_as_float(v.x & 0xffff0000u), bf2f(v.y & 0xffffu), __uint_as_float(v.y & 0xffff0000u)}; }
        f32x4 w[4];
#pragma unroll
        for (int j = 0; j < 4; ++j) w[j] = *(const f32x4*)(a.in[I_GCW] + j * GDN_CONV + ch);
        LAS float* dst = (LAS float*)(lds + hd * GS_HEAD) + (which == 0 ? 1024 : (which == 1 ? 0 : 2048)) + d;
#pragma unroll
        for (int t = 0; t < 8; ++t) { f32x4 acc = w[0] * r[t] + w[1] * r[t + 1] + w[2] * r[t + 2] + w[3] * r[t + 3];
            *(LAS f32x4*)(dst + t * 128) = (f32x4){silu_f(acc.x), silu_f(acc.y), silu_f(acc.z), silu_f(acc.w)}; } }
    __syncthreads();
    const int h = wave;
    LAS float* Lk = (LAS float*)(lds + h * GS_HEAD); LAS float* Lq = Lk + 1024; LAS float* Lv = Lk + 2048; LAS float* LW = Lk + 3072;
    LAS float* sm = (LAS float*)(lds + GS_SMALL + h * GS_SMALL_PER);
#pragma unroll 1
    for (int t = 0; t < 8; ++t) { const float k0 = Lk[t * 128 + lane], k1 = Lk[t * 128 + 64 + lane], q0 = Lq[t * 128 + lane], q1 = Lq[t * 128 + 64 + lane];
        const float rk = 1.f / sqrtf(wave_sum(k0 * k0 + k1 * k1, lane) + 1e-6f), rq = (1.f / sqrtf(wave_sum(q0 * q0 + q1 * q1, lane) + 1e-6f)) * 0.08838834764831845f;
        Lk[t * 128 + lane] = k0 * rk; Lk[t * 128 + 64 + lane] = k1 * rk; Lq[t * 128 + lane] = q0 * rq; Lq[t * 128 + 64 + lane] = q1 * rq; }
    if (lane < 8) { const size_t r = (size_t)(row0 + lane) * PITCH; const float g = -expf(a.in[I_GALOG][h]) * softplus_acc(bf2f(proj[r + PC_ALPHA + h]) + a.in[I_GDTB][h]);
        float gc = g;
#pragma unroll
        for (int d = 1; d < 8; d <<= 1) { const float v = sup(gc, d, lane); if (lane >= d) gc += v; }
        sm[128 + lane] = gc; sm[136 + lane] = 1.f / (1.f + __expf(-bf2f(proj[r + PC_BETA + h]))); }
    { const int t = lane >> 3, s = lane & 7; float kk = 0.f, qk = 0.f;
#pragma unroll 4
        for (int d = 0; d < 128; d += 4) { const f32x4 ks4 = *(const LAS f32x4*)(Lk + s * 128 + d), kt4 = *(const LAS f32x4*)(Lk + t * 128 + d), qt4 = *(const LAS f32x4*)(Lq + t * 128 + d);
            kk += (kt4.x * ks4.x + kt4.y * ks4.y) + (kt4.z * ks4.z + kt4.w * ks4.w); qk += (qt4.x * ks4.x + qt4.y * ks4.y) + (qt4.z * ks4.z + qt4.w * ks4.w); }
        const float dec = __expf(sm[128 + t] - sm[128 + s]);
        sm[lane] = (s < t) ? sm[136 + t] * kk * dec : 0.f; sm[64 + lane] = (s <= t) ? qk * dec : 0.f; }
    if (lane < 8) { sm[144 + lane] = __expf(sm[128 + 7] - sm[128 + lane]);
        float tc[8];
#pragma unroll
        for (int l = 0; l < 8; ++l) { float acc = (l == lane) ? 1.f : 0.f;
#pragma unroll
            for (int s = 0; s < l; ++s) acc -= sm[l * 8 + s] * tc[s];
            tc[l] = acc; }
        const float be = sm[136 + lane], eg = __expf(sm[128 + lane]);
#pragma unroll
        for (int l = 0; l < 8; ++l) { sm[l * 8 + lane] = tc[l] * be; sm[152 + l * 8 + lane] = tc[l] * be * eg; } }
#pragma unroll 1
    for (int hf = 0; hf < 2; ++hf) { const int d = lane + 64 * hf; float kv[8], vv[8];
#pragma unroll
        for (int s = 0; s < 8; ++s) { kv[s] = Lk[s * 128 + d]; vv[s] = Lv[s * 128 + d]; }
#pragma unroll
        for (int t = 0; t < 8; ++t) { float w = 0.f, u = 0.f;
#pragma unroll
            for (int s = 0; s <= t; ++s) { w += sm[152 + t * 8 + s] * kv[s]; u += sm[t * 8 + s] * vv[s]; }
            LW[t * 128 + d] = w; Lv[t * 128 + d] = u; Lq[t * 128 + d] *= __expf(sm[128 + t]); } }
    const int dvq = lane & 31, rg = lane >> 5;
    const float* sin = a.in[I_GDN] + ((size_t)sb * GDN_H + h) * (GDN_D * GDN_D) + 4 * dvq; float* sout = a.out + OFF_GDN_S + ((size_t)sb * GDN_H + h) * (GDN_D * GDN_D) + 4 * dvq;
    f32x4 ws[8], qs[8];
#pragma unroll
    for (int t = 0; t < 8; ++t) { ws[t] = (f32x4){0.f, 0.f, 0.f, 0.f}; qs[t] = (f32x4){0.f, 0.f, 0.f, 0.f}; }
#pragma unroll 4
    for (int i = 0; i < 64; ++i) { const int dk = 2 * i + rg; const f32x4 s4 = *(const f32x4*)(sin + (size_t)dk * GDN_D);
#pragma unroll
        for (int t = 0; t < 8; ++t) { ws[t] += s4 * LW[t * 128 + dk]; qs[t] += s4 * Lq[t * 128 + dk]; } }
#pragma unroll
    for (int t = 0; t < 8; ++t)
#pragma unroll
        for (int j = 0; j < 4; ++j) { ws[t][j] += sx32(ws[t][j], lane); qs[t][j] += sx32(qs[t][j], lane); }
    f32x4 vn[8];
#pragma unroll
    for (int t = 0; t < 8; ++t) vn[t] = *(const LAS f32x4*)(Lv + t * 128 + 4 * dvq) - ws[t];
#pragma unroll
    for (int t = 0; t < 8; ++t) { f32x4 o = qs[t];
#pragma unroll
        for (int s = 0; s <= t; ++s) o += vn[s] * sm[64 + t * 8 + s];
        float sq = (o.x * o.x + o.y * o.y) + (o.z * o.z + o.w * o.w);
        sq += sx<1>(sq); sq += sx<2>(sq); sq += sx<4>(sq); sq += sx<8>(sq); sq += sx<16>(sq);
        const float rs = 1.f / sqrtf(sq * (1.f / GDN_D) + EPS); const f32x4 w = *(const f32x4*)(a.in[I_GNW] + 4 * dvq);
        const u32x2 gg = *(const u32x2*)(proj + (size_t)(row0 + t) * PITCH + PC_GATE + h * 128 + 4 * dvq);
        const f32x4 gate = (f32x4){silu_f(bf2f(gg.x & 0xffffu)), silu_f(__uint_as_float(gg.x & 0xffff0000u)), silu_f(bf2f(gg.y & 0xffffu)), silu_f(__uint_as_float(gg.y & 0xffff0000u))};
        if (rg == 0) *(u32x2*)(mixed + (size_t)(row0 + t) * DMIX + DM + h * 128 + 4 * dvq) = pack4(o * rs * w * gate); }
#pragma unroll
    for (int t = 0; t < 8; ++t) vn[t] = vn[t] * sm[144 + t];
    const float ge = __expf(sm[128 + 7]);
#pragma unroll 4
    for (int i = 0; i < 64; ++i) { const int dk = 2 * i + rg; f32x4 s4 = *(const f32x4*)(sin + (size_t)dk * GDN_D) * ge;
#pragma unroll
        for (int t = 0; t < 8; ++t) s4 += vn[t] * Lk[t * 128 + dk];
        *(f32x4*)(sout + (size_t)dk * GDN_D) = s4; }
    __syncthreads();
}
__device__ __forceinline__ void convstate_item(const Args& a, int s, int tid) {
    const bool prompt = s < NB_P; const int L = prompt ? SEQ : LS; const int row0 = prompt ? s * SEQ : MP + (s - NB_P) * LS; const bf16* proj = ws_bf(a, WS_PROJ);
    float* o1 = a.out + (prompt ? OFF_SSDC_P + (size_t)s * 3 * SSD_CONV : OFF_SSDC_S + (size_t)(s - NB_P) * 3 * SSD_CONV);
    float* o2 = a.out + (prompt ? OFF_GDNC_P + (size_t)s * 3 * GDN_CONV : OFF_GDNC_S + (size_t)(s - NB_P) * 3 * GDN_CONV);
    for (int idx = tid; idx < 3 * SSD_CONV; idx += NT) { const int j = idx / SSD_CONV, c = idx - j * SSD_CONV; o1[idx] = bf2f(proj[(size_t)(row0 + L - 3 + j) * PITCH + PC_XBC + c]); }
    for (int idx = tid; idx < 3 * GDN_CONV; idx += NT) { const int j = idx / GDN_CONV, c = idx - j * GDN_CONV; o2[idx] = bf2f(proj[(size_t)(row0 + L - 3 + j) * PITCH + PC_QKV + c]); }
}
constexpr int Q_GP = NB_P * GDN_H, Q_SP = Q_GP + NB_P * SSD_H / 2, Q_GS = Q_SP + NB_S, Q_SS = Q_GS + NB_S, Q_ALL = Q_SS + NSEQ;
__device__ __forceinline__ void p3_mixers(const Args& a, LAS unsigned char* lds, volatile LAS unsigned* misc, int rep, int tid_, int wave, int lane_) {
    unsigned* qctr = (unsigned*)(a.ws + WS_CTL) + CW_QUEUE + 64 * rep;
    for (;;) {
        if (tid_ == 0) misc[0] = __hip_atomic_fetch_add(qctr, 1u, __ATOMIC_RELAXED, __HIP_MEMORY_SCOPE_AGENT);
        __syncthreads();
        const int it = (int)misc[0];
        __syncthreads();
        if (it >= Q_ALL) break;
        int tid = tid_, lane = lane_;
        asm volatile("" : "+v"(tid), "+v"(lane));
#ifndef PROBE_DUP
#define PROBE_DUP 0
#endif
        if (it < Q_GP) {
#pragma unroll 1
            for (int dup = 0; dup < (PROBE_DUP == 1 ? 2 : 1); ++dup) gdn_chunk_item(a, lds, it >> 3, it & 7, tid, wave, lane); }
        else if (it < Q_SP) { const int j = it - Q_GP;
#pragma unroll 1
            for (int dup = 0; dup < (PROBE_DUP == 2 ? 2 : 1); ++dup) ssd_chunk_item(a, lds, j >> 3, (j >> 2) & 1, j & 3, tid, wave, lane); }
        else if (it < Q_GS) gdn_sample_item(a, lds, it - Q_SP, tid, wave, lane);
        else if (it < Q_SS) ssd_sample_item(a, lds, it - Q_GS, tid, wave, lane);
        else convstate_item(a, it - Q_SS, tid);
    }
}
__device__ __forceinline__ void p3b_ssdnorm(const Args& a, int gw, int NGW, int lane) {
    bf16* mixed = mixed_buf(a); const float* ssq = ws_f(a, WS_SSQ); const float* nw = a.in[I_SNW] + 16 * lane;
    for (int row = gw; row < M; row += NGW) {
        const f32x4* sp = (const f32x4*)(ssq + (size_t)row * 16 + 8 * (lane >> 5)); const f32x4 s0 = sp[0], s1 = sp[1];
        const float rs = 1.f / sqrtf(((s0.x + s0.y) + (s0.z + s0.w) + (s1.x + s1.y) + (s1.z + s1.w)) * (1.f / 512.f) + EPS);
        v4u* mp = (v4u*)(mixed + (size_t)row * DMIX + 16 * lane);
#pragma unroll
        for (int q = 0; q < 2; ++q) { v4u v = mp[q]; const f32x4 w0 = *(const f32x4*)(nw + 8 * q), w1 = *(const f32x4*)(nw + 8 * q + 4);
            v.x = pk2(bf2f(v.x & 0xffffu) * rs * w0.x, bf2f(v.x >> 16) * rs * w0.y); v.y = pk2(bf2f(v.y & 0xffffu) * rs * w0.z, bf2f(v.y >> 16) * rs * w0.w);
            v.z = pk2(bf2f(v.z & 0xffffu) * rs * w1.x, bf2f(v.z >> 16) * rs * w1.y); v.w = pk2(bf2f(v.w & 0xffffu) * rs * w1.z, bf2f(v.w >> 16) * rs * w1.w);
            mp[q] = v; }
    }
}
__device__ __forceinline__ void p5_mid(const Args& a, int gw, int NGW, int lane) {
    const float* mod = ws_f(a, WS_MOD); const float* T1 = ws_f(a, WS_T1); bf16* XN2 = ws_bf(a, WS_XN2); const float* wpost = a.in[I_NMPOST]; const float* wpre = a.in[I_NFPRE];
    for (int row = gw; row < M; row += NGW) {
        const f32x4* tr = (const f32x4*)(T1 + (size_t)row * DM) + lane; const f32x4* xr = (const f32x4*)x_row(a, row) + lane; const float* mr = mod + (size_t)seq_of_row(row) * NMOD;
        f32x4 v[4]; float s = 0.f;
#pragma unroll
        for (int j = 0; j < 4; ++j) { v[j] = tr[64 * j]; s += (v[j].x * v[j].x + v[j].y * v[j].y) + (v[j].z * v[j].z + v[j].w * v[j].w); }
        const float rs = 1.f / sqrtf(wave_sum(s, lane) * (1.f / DM) + EPS);
        float s2 = 0.f; f32x4* yo = (f32x4*)(a.out + OFF_Y + (size_t)row * DM) + lane;
#pragma unroll
        for (int j = 0; j < 4; ++j) { const int c = 4 * lane + 256 * j; const f32x4 w = *(const f32x4*)(wpost + c), g1 = *(const f32x4*)(mr + 2 * DM + c);
            v[j] = xr[64 * j] + g1 * (v[j] * rs * w); yo[64 * j] = v[j]; s2 += (v[j].x * v[j].x + v[j].y * v[j].y) + (v[j].z * v[j].z + v[j].w * v[j].w); }
        const float rs2 = 1.f / sqrtf(wave_sum(s2, lane) * (1.f / DM) + EPS);
        unsigned long long* o8 = (unsigned long long*)(XN2 + (size_t)row * DM) + lane;
#pragma unroll
        for (int j = 0; j < 4; ++j) { const int c = 4 * lane + 256 * j; const f32x4 w = *(const f32x4*)(wpre + c), sh = *(const f32x4*)(mr + 3 * DM + c), sc = *(const f32x4*)(mr + 4 * DM + c);
            const f32x4 h = v[j] * rs2 * w * (sc + 1.f) + sh;
            o8[64 * j] = (unsigned long long)pk2(h.x, h.y) | ((unsigned long long)pk2(h.z, h.w) << 32); }
    }
}
__device__ __forceinline__ void p8_final(const Args& a, int gw, int NGW, int lane) {
    const float* mod = ws_f(a, WS_MOD); const float* T2 = ws_f(a, WS_T2); const float* wpost = a.in[I_NFPOST];
    for (int row = gw; row < M; row += NGW) {
        const f32x4* tr = (const f32x4*)(T2 + (size_t)row * DM) + lane; const float* mr = mod + (size_t)seq_of_row(row) * NMOD;
        f32x4 v[4]; float s = 0.f;
#pragma unroll
        for (int j = 0; j < 4; ++j) { v[j] = tr[64 * j]; s += (v[j].x * v[j].x + v[j].y * v[j].y) + (v[j].z * v[j].z + v[j].w * v[j].w); }
        const float rs = 1.f / sqrtf(wave_sum(s, lane) * (1.f / DM) + EPS);
        f32x4* yo = (f32x4*)(a.out + OFF_Y + (size_t)row * DM) + lane;
#pragma unroll
        for (int j = 0; j < 4; ++j) { const int c = 4 * lane + 256 * j; const f32x4 w = *(const f32x4*)(wpost + c), g2 = *(const f32x4*)(mr + 5 * DM + c);
            yo[64 * j] = yo[64 * j] + g2 * (v[j] * rs * w); }
    }
}
#ifndef MK_N_LAUNCHES
#define MK_N_LAUNCHES 1
#endif
constexpr int NPH = 11;
constexpr int N_LAUNCHES = MK_N_LAUNCHES;
static_assert(N_LAUNCHES == 1, "one launch");
#ifndef PG8_SP2
#define PG8_SP2 true
#endif
#ifndef PG8_ALIGN
#define PG8_ALIGN true
#endif
__global__ void __launch_bounds__(NT, 2) hymba_fwd(Args args) {
    extern __shared__ __attribute__((aligned(16))) unsigned char lds_[];
    LAS unsigned char* lds = (LAS unsigned char*)lds_;
    volatile LAS unsigned* MISC = (volatile LAS unsigned*)(lds + MISC_OFF);
    const int tid0 = threadIdx.x, wave = __builtin_amdgcn_readfirstlane(tid0 >> 6);
#define PHASE_IDS int lane = (int)__builtin_amdgcn_mbcnt_hi(~0u, __builtin_amdgcn_mbcnt_lo(~0u, 0u)); asm volatile("" : "+v"(lane)); const int tid = wave * 64 + lane;
    const int G = gridDim.x, bid = blockIdx.x;
    const int gw = bid * NWAVES + wave, NGW = G * NWAVES;
    gu32* ctl = (gu32*)(args.ws + WS_CTL);
    for (int u = tid0; u < (LDS_BYTES - LDSCTL_OFF) / 4; u += NT) ((LAS unsigned*)(lds + LDSCTL_OFF))[u] = 0u;
    __syncthreads();
    XcdBarrier bar; bar.bar = (unsigned*)(ctl + CW_BAR); bar.x = 0; bar.st = nullptr;
    if (N_LAUNCHES == 1) bar = xcd_barrier_post((unsigned*)(ctl + CW_BAR), MISC + 8);
#define GRID_BAR(seam) do { if (N_LAUNCHES != 1) { if (wave == 0 && __builtin_amdgcn_mbcnt_lo(~0u, 0u) == 0u) __hip_atomic_store(ctl + CW_TMO, 0xBADBA0u | (unsigned)(seam), RLX_AGENT); } else { xcd_barrier(bar); } } while (0)
    const int lo = args.ph_lo, hi = args.ph_hi;
#define IN(k) (lo <= (k) && (k) < hi)
#ifndef PROBE_PHASE
#define PROBE_PHASE -1
#endif
#define REPS(k) for (int rep = 0; rep < ((k) == PROBE_PHASE ? 2 : 1); ++rep)
#define REP_BAR(k) do { if ((k) == PROBE_PHASE && rep == 0) GRID_BAR(k); } while (0)
#define BOTH(k) (IN(k) && IN((k) + 1))
    if (IN(0)) { REPS(0) { PHASE_IDS p0a_prologue(args, lds, gw, NGW, wave, lane); (void)tid; REP_BAR(0); } GRID_BAR(0);
        REPS(10) {
            if (bid < ADA_UNITS || G <= ADA_UNITS) { pg8::Gemm g{sc_buf(args), wada_t(args), 256, NMOD, DM}; pg8::StaticOrder S; S.init(256, NMOD, G, bid);
                pg8::EpiF32BiasRows E{ws_f(args, WS_MOD), NMOD, args.in[I_BADA], NSEQ};
                pg8::gemm_phase<pg8::EpiF32BiasRows, pg8::StaticOrder, PG8_ALIGN, PG8_SP2>(lds + RING_OFF, g, S, E); }
            if (bid >= ADA_UNITS || G <= ADA_UNITS) { PHASE_IDS (void)tid; const bool all = G <= ADA_UNITS; p0b_transposes(args, lds, (all ? bid : bid - ADA_UNITS) * NWAVES + wave, (all ? G : G - ADA_UNITS) * NWAVES, wave, lane); }
            REP_BAR(10); }
        if (BOTH(0)) GRID_BAR(0); }
    if (IN(1)) { REPS(1) { PHASE_IDS p1_xn(args, gw, NGW, lane); REP_BAR(1); } if (BOTH(1)) GRID_BAR(1); }
    if (IN(2)) { REPS(2) {
        pg8::Gemm g{xn_buf(args), win_t(args), M, IN_PAD, DM}; pg8::StaticOrder S; S.init(M, IN_PAD, G, bid);
        pg8::EpiBf16Clip E{ws_bf(args, WS_PROJ), PITCH, IN_DIM};
        pg8::gemm_phase<pg8::EpiBf16Clip, pg8::StaticOrder, PG8_ALIGN, PG8_SP2>(lds + RING_OFF, g, S, E); REP_BAR(2); }
        if (BOTH(2)) GRID_BAR(2);
    }
    if (IN(3)) { REPS(3) { PHASE_IDS p3_mixers(args, lds, MISC, rep, tid, wave, lane); REP_BAR(3); } if (BOTH(3)) GRID_BAR(3); }
    if (IN(4)) { PHASE_IDS p3b_ssdnorm(args, gw, NGW, lane); if (BOTH(4)) GRID_BAR(4); }
    if (IN(5)) { REPS(5) {
        pg8::Gemm g{mixed_buf(args), ws_bf(args, WS_WOUT), M, DM, DMIX}; pg8::StaticOrder S; S.init(M, DM, G, bid);
        pg8::EpiF32 E{ws_f(args, WS_T1), DM};
        pg8::gemm_phase<pg8::EpiF32, pg8::StaticOrder, PG8_ALIGN, PG8_SP2>(lds + RING_OFF, g, S, E); REP_BAR(5); }
        if (BOTH(5)) GRID_BAR(5);
    }
    if (IN(6)) { REPS(6) { PHASE_IDS p5_mid(args, gw, NGW, lane); REP_BAR(6); } if (BOTH(6)) GRID_BAR(6); }
    if (IN(7)) { REPS(7) {
        pg8::Gemm g{ws_bf(args, WS_XN2), ws_bf(args, WS_WGU), M, NGU, DM}; pg8::StaticOrder S; S.init(M, NGU, G, bid);
        pg8::EpiSwiGLU E{ws_bf(args, WS_ACT), DFF};
        pg8::gemm_phase<pg8::EpiSwiGLU, pg8::StaticOrder, PG8_ALIGN, PG8_SP2>(lds + RING_OFF, g, S, E); REP_BAR(7); }
        if (BOTH(7)) GRID_BAR(7);
    }
    if (IN(8)) { REPS(8) {
        pg8::Gemm g{ws_bf(args, WS_ACT), ws_bf(args, WS_WDN), M, DM, DFF}; pg8::StaticOrder S; S.init(M, DM, G, bid);
        pg8::EpiF32 E{ws_f(args, WS_T2), DM};
        pg8::gemm_phase<pg8::EpiF32, pg8::StaticOrder, PG8_ALIGN, PG8_SP2>(lds + RING_OFF, g, S, E); REP_BAR(8); }
        if (BOTH(8)) GRID_BAR(8);
    }
    if (IN(9)) { PHASE_IDS p8_final(args, gw, NGW, lane); }
#undef IN
#undef BOTH
}
extern "C" void kernel_launch(void* const* d_in, const int* in_sizes, int n_in, void* d_out, int out_size, void* d_ws, size_t ws_size, hipStream_t stream) {
    static int grid = 0;
    if (grid == 0) {
        if (n_in != 28 || in_sizes[0] != MP * DM || (size_t)out_size != OUT_TOTAL || ws_size < WS_END) {
            fprintf(stderr, "kernel_launch: shape/workspace mismatch: n_in %d in0 %d out %d ws %zu (need %zu); nothing launched\n", n_in, n_in > 0 ? in_sizes[0] : -1, out_size, ws_size, (size_t)WS_END); grid = -1; return; }
        int dev = 0, cus = 0, per_cu = 0;
        if (hipGetDevice(&dev) != hipSuccess || hipDeviceGetAttribute(&cus, hipDeviceAttributeMultiprocessorCount, dev) != hipSuccess) { fprintf(stderr, "kernel_launch: device query failed\n"); grid = -1; return; }
        if (hipFuncSetAttribute((const void*)hymba_fwd, hipFuncAttributeMaxDynamicSharedMemorySize, LDS_BYTES) != hipSuccess) { fprintf(stderr, "kernel_launch: hipFuncSetAttribute failed\n"); grid = -1; return; }
        if (hipOccupancyMaxActiveBlocksPerMultiprocessor(&per_cu, (const void*)hymba_fwd, NT, LDS_BYTES) != hipSuccess || per_cu < 1)
            fprintf(stderr, "kernel_launch: note: occupancy query reports %d workgroups per CU\n", per_cu);
        (void)hipGetLastError();
        grid = cus;
    }
    if (grid < 0) return;
    if (hipMemsetAsync((char*)d_ws + WS_CTL, 0, CTL_ZERO_BYTES, stream) != hipSuccess) { fprintf(stderr, "kernel_launch: memset failed\n"); return; }
    Args a{};
    for (int i = 0; i < 28; ++i) a.in[i] = (const float*)d_in[i];
    a.out = (float*)d_out; a.ws = (unsigned char*)d_ws;
    for (int li = 0; li < N_LAUNCHES; ++li) {
        a.ph_lo = (N_LAUNCHES == 1) ? 0 : li; a.ph_hi = (N_LAUNCHES == 1) ? 10 : li + 1; a.li = li;
        hipLaunchKernelGGL(hymba_fwd, dim3(grid), dim3(NT), LDS_BYTES, stream, a);
        const hipError_t le = hipPeekAtLastError();
        if (le != hipSuccess) { fprintf(stderr, "kernel_launch: launch %d failed: %s\n", li, hipGetErrorName(le)); break; }
    }
}
```
